# Optimizing an MI355X kernel written in HIP

```python
import math
import jax, jax.numpy as jnp
from jax import lax
import numpy as np

D_MODEL = 1024
BATCH = 2
SEQ = 8192
DEPTH = 2
DEC_BATCH = 32
DEC_SEQ = 8
PAST_LEN = 8192
PAGE_SIZE = 128

N_A_LAYERS = DEPTH // 2
N_B_LAYERS = DEPTH - N_A_LAYERS
D_RNN = D_MODEL
N_RG_BLOCKS = 8
RG_BLOCK = D_RNN // N_RG_BLOCKS
CONV_W = 4
RG_C = 8.0
N_HEADS = 16
HEAD_DIM = D_MODEL // N_HEADS
N_KV = 4
HPG = N_HEADS // N_KV
CMP_BLOCK = 64
N_SEL = 16
WINDOW = 512
D_PHI = 128
Q_BLOCK = 128
DN_ALPHA = (2.0 * DEPTH) ** 0.25
DN_BETA = (8.0 * DEPTH) ** -0.25
LN_EPS = 1e-5
NEG = -1e30
FORCED = 1e6

kernel_name = 'hawk_nsa_yoco_decoder_step'


def alibi_slopes():
    return jnp.asarray(2.0 ** (-8.0 * np.arange(1, N_HEADS + 1) / N_HEADS), jnp.float32)


def layer_norm(x, g, b):
    xf = x.astype(jnp.float32)
    mu = xf.mean(-1, keepdims=True)
    var = jnp.square(xf - mu).mean(-1, keepdims=True)
    return ((xf - mu) * lax.rsqrt(var + LN_EPS) * g.astype(jnp.float32) + b.astype(jnp.float32)).astype(x.dtype)


def ada_mod(c, w, b):
    m = jax.nn.silu(c) @ w + b
    shift, scale, gate = jnp.split(m[:, None, :], 3, axis=-1)
    return shift, scale, gate


def masked_softmax(s, mask):
    s = jnp.where(mask, s.astype(jnp.float32), NEG)
    p = jax.nn.softmax(s, axis=-1)
    return jnp.where(mask, p, 0.0)


def lru_combine(left, right):
    a1, b1 = left
    a2, b2 = right
    return a1 * a2, a2 * b1 + b2


def rglru_mixer(h, h0, conv0, w_in, conv_w, conv_b, w_r, b_r, w_i, b_i, lam, w_out):
    B, T, _ = h.shape
    xb, zg = jnp.split(h @ w_in, 2, axis=-1)
    xp = jnp.concatenate([conv0.astype(xb.dtype), xb], axis=1)
    xc = conv_b + xp[:, 0:T] * conv_w[0]
    for k in range(1, CONV_W):
        xc = xc + xp[:, k:k + T] * conv_w[k]
    xg = xc.reshape(B, T, N_RG_BLOCKS, RG_BLOCK)
    r = jax.nn.sigmoid((jnp.einsum('btnc,ncd->btnd', xg, w_r).reshape(B, T, D_RNN) + b_r).astype(jnp.float32))
    i = jax.nn.sigmoid((jnp.einsum('btnc,ncd->btnd', xg, w_i).reshape(B, T, D_RNN) + b_i).astype(jnp.float32))
    log_a = -RG_C * jax.nn.softplus(-lam.astype(jnp.float32)) * r
    a = jnp.exp(log_a)
    gain = jnp.sqrt(jnp.maximum(-jnp.expm1(2.0 * log_a), 0.0))
    b = gain * i * xc.astype(jnp.float32)
    b = b.at[:, 0].add(a[:, 0] * h0.astype(jnp.float32))
    _, hs = lax.associative_scan(lru_combine, (a, b), axis=1)
    y = (hs.astype(h.dtype) * jax.nn.silu(zg)) @ w_out
    return y, hs[:, -1], xp[:, -(CONV_W - 1):]


def compress_blocks(kv, phi_pe, w_phi1, b_phi1, w_phi2, b_phi2):
    B, L = kv.shape[:2]
    nc = L // CMP_BLOCK
    blk = kv.reshape(B, nc, CMP_BLOCK, N_KV, 2, HEAD_DIM) + phi_pe[None, None, :, None]
    hid = jax.nn.silu(jnp.einsum('bnlgcd,cldp->bngcp', blk, w_phi1) + b_phi1)
    return jnp.einsum('bngcp,cpd->bngcd', hid, w_phi2) + b_phi2


def nsa_query_side(h, w_in, b_gate):
    B, T, _ = h.shape
    hd = N_HEADS * HEAD_DIM
    u = h @ w_in
    q = u[..., :hd].reshape(B, T, N_HEADS, HEAD_DIM)
    z = u[..., hd:2 * hd]
    gl = (u[..., 2 * hd:] + b_gate).reshape(B, T, N_HEADS, 3)
    return q, z, gl


def nsa_attend(q, gate_logits, t, kc, vc, c_end, fetch_sel, n_sel_blocks, wk, wv, w_pos):
    B, Tq = q.shape[:2]
    dt = q.dtype
    slopes = alibi_slopes().reshape(N_KV, HPG)
    qg = q.reshape(B, Tq, N_KV, HPG, HEAD_DIM) * (HEAD_DIM ** -0.5)
    tf = t.astype(jnp.float32)
    s = jnp.einsum('bqghd,bngd->bqghn', qg, kc).astype(jnp.float32)
    dist = tf[:, None] - c_end.astype(jnp.float32)[None, :]
    s = s - slopes[None, None, :, :, None] * dist[None, :, None, None, :]
    mask = (c_end[None, :] <= t[:, None])[None, :, None, None, :]
    p_cmp = masked_softmax(s, mask)
    o_cmp = jnp.einsum('bqghn,bngd->bqghd', p_cmp.astype(dt), vc)
    nc = kc.shape[1]
    imp = jnp.pad(p_cmp.sum(axis=3), ((0, 0), (0, 0), (0, 0), (0, n_sel_blocks - nc)))
    j = jnp.arange(n_sel_blocks)
    cb = t // CMP_BLOCK
    forced = (j[None, :] == 0) | (j[None, :] == cb[:, None]) | (j[None, :] == cb[:, None] - 1)
    causal_blk = j[None, :] <= cb[:, None]
    score = jnp.where(forced[:, None, :], FORCED, jnp.where(causal_blk[:, None, :], imp, -1.0))
    _, idx = lax.top_k(score, min(N_SEL, n_sel_blocks))
    kv_sel, pos = fetch_sel(idx)
    kl = pos.shape[-2] * pos.shape[-1]
    s = jnp.einsum('bqghd,bqgkld->bqghkl', qg, kv_sel[..., 0, :]).astype(jnp.float32)
    dist = (t[None, :, None, None, None] - pos).astype(jnp.float32)
    s = s - slopes[None, None, :, :, None, None] * dist[:, :, :, None]
    mask = (pos <= t[None, :, None, None, None])[:, :, :, None]
    p_sel = masked_softmax(s.reshape(B, Tq, N_KV, HPG, kl), mask.reshape(B, Tq, N_KV, 1, kl))
    o_sel = jnp.einsum('bqghs,bqgsd->bqghd', p_sel.astype(dt),
                       kv_sel[..., 1, :].reshape(B, Tq, N_KV, kl, HEAD_DIM))
    s = jnp.einsum('bqghd,bsgd->bqghs', qg, wk).astype(jnp.float32)
    dist = tf[:, None] - w_pos.astype(jnp.float32)[None, :]
    s = s - slopes[None, None, :, :, None] * dist[None, :, None, None, :]
    dpos = t[:, None] - w_pos[None, :]
    mask = ((dpos >= 0) & (dpos <= WINDOW) & (w_pos >= 0)[None, :])[None, :, None, None, :]
    p_win = masked_softmax(s, mask)
    o_win = jnp.einsum('bqghs,bsgd->bqghd', p_win.astype(dt), wv)
    g = jax.nn.sigmoid(gate_logits.astype(jnp.float32)).astype(dt).reshape(B, Tq, N_KV, HPG, 3)
    o = g[..., 0:1] * o_cmp + g[..., 1:2] * o_sel + g[..., 2:3] * o_win
    return o.reshape(B, Tq, N_HEADS * HEAD_DIM)


def nsa_prompt(h, kv_sel, kv_win, kc, vc, c_end, w_in, b_gate, w_out):
    B, T, _ = h.shape
    q, z, gl = nsa_query_side(h, w_in, b_gate)
    nqb = T // Q_BLOCK
    win_pad = jnp.pad(kv_win, ((0, 0), (WINDOW, 0), (0, 0), (0, 0), (0, 0)))
    bidx = jnp.arange(B)[:, None, None, None, None]
    gidx = jnp.arange(N_KV)[None, None, :, None, None]
    offs = jnp.arange(CMP_BLOCK)

    def fetch(idx):
        pos = idx[..., None] * CMP_BLOCK + offs
        return kv_sel[bidx, pos, gidx], pos

    def one_block(args):
        qb, gb, start = args
        t = start + jnp.arange(Q_BLOCK)
        wkv = lax.dynamic_slice_in_dim(win_pad, start, WINDOW + Q_BLOCK, axis=1)
        w_pos = start - WINDOW + jnp.arange(WINDOW + Q_BLOCK)
        return nsa_attend(qb, gb, t, kc, vc, c_end, fetch, T // CMP_BLOCK,
                          wkv[..., 0, :], wkv[..., 1, :], w_pos)

    qb = q.reshape(B, nqb, Q_BLOCK, N_HEADS, HEAD_DIM).swapaxes(0, 1)
    gb = gl.reshape(B, nqb, Q_BLOCK, N_HEADS, 3).swapaxes(0, 1)
    starts = jnp.arange(nqb, dtype=jnp.int32) * Q_BLOCK
    o = lax.map(one_block, (qb, gb, starts))
    o = o.swapaxes(0, 1).reshape(B, T, N_HEADS * HEAD_DIM)
    return (o * jax.nn.silu(z)) @ w_out


def nsa_sample(h, new_sel, win_keys, past_len, kc, vc, c_end, cache_sel, page_table, w_in, b_gate, w_out):
    B, S, _ = h.shape
    q, z, gl = nsa_query_side(h, w_in, b_gate)
    t = past_len + jnp.arange(S)
    bidx = jnp.arange(B)[:, None, None, None, None]
    gidx = jnp.arange(N_KV)[None, None, :, None, None]
    offs = jnp.arange(CMP_BLOCK)

    def fetch(idx):
        pos = idx[..., None] * CMP_BLOCK + offs
        pp = jnp.minimum(pos, past_len - 1)
        phys = page_table[bidx, pp // PAGE_SIZE]
        past_rows = cache_sel[phys, pp % PAGE_SIZE, gidx]
        new_rows = new_sel[bidx, jnp.clip(pos - past_len, 0, S - 1), gidx]
        return jnp.where((pos < past_len)[..., None, None], past_rows, new_rows), pos

    wb = win_keys.shape[1] - S
    w_pos = past_len - wb + jnp.arange(wb + S)
    n_sb = -(-(past_len + S) // CMP_BLOCK)
    o = nsa_attend(q, gl, t, kc, vc, c_end, fetch, n_sb, win_keys[..., 0, :], win_keys[..., 1, :], w_pos)
    return (o * jax.nn.silu(z)) @ w_out


def setup_inputs(seed: int = 0) -> dict:
    key = jax.random.key(seed)
    ks = iter(jax.random.split(key, 48))

    def nrm(shape, s):
        return jax.random.normal(next(ks), shape, jnp.float32) * s

    n_pages = PAST_LEN // PAGE_SIZE
    n_phys = (5 * DEC_BATCH * n_pages) // 4
    wb = min(WINDOW, PAST_LEN)
    perm = jax.random.permutation(next(ks), n_phys)[:DEC_BATCH * n_pages]
    page_table = perm.reshape(DEC_BATCH, n_pages).astype(jnp.int32)
    a0 = jax.random.uniform(next(ks), (N_A_LAYERS, D_RNN), jnp.float32, 0.9, 0.999)
    lam_a = jnp.log(a0) - jnp.log1p(-a0)
    hd = N_HEADS * HEAD_DIM
    return {
        'x_prompt': nrm((BATCH, SEQ, D_MODEL), 1.0),
        'x_sample': nrm((DEC_BATCH, DEC_SEQ, D_MODEL), 1.0),
        'c_prompt': nrm((BATCH, D_MODEL), 1.0),
        'c_sample': nrm((DEC_BATCH, D_MODEL), 1.0),
        'state_h': nrm((N_A_LAYERS, DEC_BATCH, D_RNN), 0.5),
        'state_conv': nrm((N_A_LAYERS, DEC_BATCH, CONV_W - 1, D_RNN), 1.0),
        'cache_cmp': nrm((n_phys, PAGE_SIZE, N_KV, 2, HEAD_DIM), 1.0),
        'cache_sel': nrm((n_phys, PAGE_SIZE, N_KV, 2, HEAD_DIM), 1.0),
        'state_win': nrm((DEC_BATCH, wb, N_KV, 2, HEAD_DIM), 1.0),
        'page_table': page_table,
        'w_ada': nrm((DEPTH, D_MODEL, 3 * D_MODEL), 0.2 * D_MODEL ** -0.5),
        'b_ada': nrm((DEPTH, 3 * D_MODEL), 0.01),
        'ln_g': 1.0 + nrm((DEPTH, D_MODEL), 0.02),
        'ln_b': nrm((DEPTH, D_MODEL), 0.02),
        'w_in_a': nrm((N_A_LAYERS, D_MODEL, 2 * D_RNN), D_MODEL ** -0.5),
        'conv_w_a': nrm((N_A_LAYERS, CONV_W, D_RNN), CONV_W ** -0.5),
        'conv_b_a': nrm((N_A_LAYERS, D_RNN), 0.02),
        'w_r_a': nrm((N_A_LAYERS, N_RG_BLOCKS, RG_BLOCK, RG_BLOCK), RG_BLOCK ** -0.5),
        'b_r_a': nrm((N_A_LAYERS, D_RNN), 0.02),
        'w_i_a': nrm((N_A_LAYERS, N_RG_BLOCKS, RG_BLOCK, RG_BLOCK), RG_BLOCK ** -0.5),
        'b_i_a': nrm((N_A_LAYERS, D_RNN), 0.02),
        'lam_a': lam_a,
        'w_out_a': nrm((N_A_LAYERS, D_RNN, D_MODEL), DN_BETA * D_RNN ** -0.5),
        'w_kv': nrm((D_MODEL, 3 * N_KV * 2 * HEAD_DIM), D_MODEL ** -0.5),
        'phi_pe': nrm((CMP_BLOCK, 2, HEAD_DIM), 0.1),
        'w_phi1': nrm((2, CMP_BLOCK, HEAD_DIM, D_PHI), (CMP_BLOCK * HEAD_DIM) ** -0.5),
        'b_phi1': nrm((2, D_PHI), 0.02),
        'w_phi2': nrm((2, D_PHI, HEAD_DIM), D_PHI ** -0.5),
        'b_phi2': nrm((2, HEAD_DIM), 0.02),
        'w_in_b': nrm((N_B_LAYERS, D_MODEL, 2 * hd + 3 * N_HEADS), D_MODEL ** -0.5),
        'b_gate_b': nrm((N_B_LAYERS, 3 * N_HEADS), 0.1),
        'w_out_b': nrm((N_B_LAYERS, hd, D_MODEL), DN_BETA * hd ** -0.5),
    }


def reference(x_prompt, x_sample, c_prompt, c_sample, state_h, state_conv, cache_cmp, cache_sel, state_win,
              page_table, w_ada, b_ada, ln_g, ln_b, w_in_a, conv_w_a, conv_b_a, w_r_a, b_r_a, w_i_a, b_i_a,
              lam_a, w_out_a, w_kv, phi_pe, w_phi1, b_phi1, w_phi2, b_phi2, w_in_b, b_gate_b, w_out_b):
    Bp, T, _ = x_prompt.shape
    Bs, S, _ = x_sample.shape
    past_len = page_table.shape[1] * PAGE_SIZE
    xp, xs = x_prompt, x_sample
    hp_list, cp_list, hs_list, cs_list = [], [], [], []
    for layer in range(DEPTH):
        shp, scp, gp = ada_mod(c_prompt, w_ada[layer], b_ada[layer])
        shs, scs, gs = ada_mod(c_sample, w_ada[layer], b_ada[layer])
        mp = xp * (1.0 + scp) + shp
        ms = xs * (1.0 + scs) + shs
        if layer < N_A_LAYERS:
            a = layer
            fp, hp, cp = rglru_mixer(mp, jnp.zeros((Bp, D_RNN), xp.dtype),
                                     jnp.zeros((Bp, CONV_W - 1, D_RNN), xp.dtype),
                                     w_in_a[a], conv_w_a[a], conv_b_a[a], w_r_a[a], b_r_a[a],
                                     w_i_a[a], b_i_a[a], lam_a[a], w_out_a[a])
            fs, hs, cs = rglru_mixer(ms, state_h[a], state_conv[a],
                                     w_in_a[a], conv_w_a[a], conv_b_a[a], w_r_a[a], b_r_a[a],
                                     w_i_a[a], b_i_a[a], lam_a[a], w_out_a[a])
            hp_list.append(hp)
            cp_list.append(cp)
            hs_list.append(hs)
            cs_list.append(cs)
        else:
            if layer == N_A_LAYERS:
                kvp = (xp @ w_kv).reshape(Bp, T, 3, N_KV, 2, HEAD_DIM)
                kvs = (xs @ w_kv).reshape(Bs, S, 3, N_KV, 2, HEAD_DIM)
                new_cmp_p, new_sel_p, win_p = kvp[:, :, 0], kvp[:, :, 1], kvp[:, :, 2]
                new_cmp_s, new_sel_s, win_s = kvs[:, :, 0], kvs[:, :, 1], kvs[:, :, 2]
                nc_p = T // CMP_BLOCK
                comp_p = compress_blocks(new_cmp_p[:, :nc_p * CMP_BLOCK], phi_pe, w_phi1, b_phi1, w_phi2, b_phi2)
                c_end_p = (jnp.arange(nc_p) + 1) * CMP_BLOCK - 1
                past_cmp = cache_cmp[page_table].reshape(Bs, past_len, N_KV, 2, HEAD_DIM)
                full_cmp = jnp.concatenate([past_cmp, new_cmp_s.astype(past_cmp.dtype)], axis=1)
                nc_s = (past_len + S) // CMP_BLOCK
                comp_s = compress_blocks(full_cmp[:, :nc_s * CMP_BLOCK], phi_pe, w_phi1, b_phi1, w_phi2, b_phi2)
                c_end_s = (jnp.arange(nc_s) + 1) * CMP_BLOCK - 1
                win_keys_s = jnp.concatenate([state_win.astype(win_s.dtype), win_s], axis=1)
                new_win_p = win_p[:, -min(WINDOW, T):]
                new_win_s = win_keys_s[:, -state_win.shape[1]:]
            bl = layer - N_A_LAYERS
            fp = nsa_prompt(mp, new_sel_p, win_p, comp_p[..., 0, :], comp_p[..., 1, :], c_end_p,
                            w_in_b[bl], b_gate_b[bl], w_out_b[bl])
            fs = nsa_sample(ms, new_sel_s, win_keys_s, past_len, comp_s[..., 0, :], comp_s[..., 1, :], c_end_s,
                            cache_sel, page_table, w_in_b[bl], b_gate_b[bl], w_out_b[bl])
        xp = layer_norm(DN_ALPHA * xp + (1.0 + gp) * fp, ln_g[layer], ln_b[layer])
        xs = layer_norm(DN_ALPHA * xs + (1.0 + gs) * fs, ln_g[layer], ln_b[layer])
    new_h_p = jnp.stack(hp_list)
    new_conv_p = jnp.stack(cp_list)
    new_h_s = jnp.stack(hs_list)
    new_conv_s = jnp.stack(cs_list)
    return (xp, xs, new_cmp_p, new_sel_p, new_win_p, new_h_p, new_conv_p,
            new_cmp_s, new_sel_s, new_win_s, new_h_s, new_conv_s)
```

```cpp
#include <hip/hip_runtime.h>
#include <cstdio>
#include <cstdint>
#ifndef CFG_D
#define CFG_D 1024
#define CFG_BATCH 2
#define CFG_SEQ 8192
#define CFG_DECB 32
#define CFG_PAST 8192
#define CFG_NRG 8
#define CFG_NH 16
#define CFG_NKV 4
#endif
namespace nv {
constexpr int D = CFG_D, BATCH = CFG_BATCH, SEQ = CFG_SEQ, DECB = CFG_DECB, DSEQ = 8, PAST = CFG_PAST, PAGE = 128;
constexpr int NRG = CFG_NRG, RGB = D / NRG, NH = CFG_NH, HD = 64, NKV = CFG_NKV, HPG = NH / NKV;
static_assert(D == NH * HD && HPG == 4, "geometry");
constexpr int CMPB = 64, NSEL = 16, WIN = 512, DPHI = 128;
constexpr int MP = BATCH * SEQ, MS = DECB * DSEQ, M = MP + MS, NC = BATCH + DECB;
constexpr int NKVC = 3 * NKV * 2 * HD;
constexpr int KVG = NKV * 2 * HD;
constexpr int NU = 2 * D + 3 * NH;
constexpr int NCP = SEQ / CMPB, NCS = (PAST + DSEQ) / CMPB, NSBS = (PAST + DSEQ + CMPB - 1) / CMPB;
constexpr int NSBMAX = ((NCP > NSBS ? NCP : NSBS) + 7) / 8 * 8;
constexpr int NPAGES = PAST / PAGE;
constexpr int NSEQN = BATCH * NCP + DECB * NCS;
constexpr float ALPHA = 1.4142135623730951f;
constexpr float LN_EPS = 1e-5f;
static_assert(PAST >= WIN && SEQ >= WIN, "window geometry");

constexpr long O_YP = 0, O_YS = O_YP + (long)MP * D, O_CMPP = O_YS + (long)MS * D, O_SELP = O_CMPP + (long)MP * KVG,
    O_WINP = O_SELP + (long)MP * KVG, O_HP = O_WINP + (long)BATCH * WIN * KVG, O_CONVP = O_HP + (long)BATCH * D,
    O_CMPS = O_CONVP + (long)BATCH * 3 * D, O_SELS = O_CMPS + (long)MS * KVG, O_WINS = O_SELS + (long)MS * KVG,
    O_HS = O_WINS + (long)DECB * WIN * KVG, O_CONVS = O_HS + (long)DECB * D, O_END = O_CONVS + (long)DECB * 3 * D;

enum { I_XP, I_XS, I_CP, I_CS, I_STH, I_STC, I_CCMP, I_CSEL, I_SWIN, I_PT, I_WADA, I_BADA, I_LNG, I_LNB, I_WINA, I_CONVW, I_CONVB,
       I_WR, I_BR, I_WI, I_BI, I_LAM, I_WOUTA, I_WKV, I_PE, I_WPHI1, I_BPHI1, I_WPHI2, I_BPHI2, I_WINB, I_BGATE, I_WOUTB, I_N };

struct WS {
    float *mod, *mA, *u0, *xc, *ga, *gb, *fbuf, *x1, *kv, *u, *hid, *comp, *pc, *ocmp, *osel, *owin, *obuf; int* idx;
};
constexpr long al(long x) { return (x + 63) / 64 * 64; }
constexpr long W_MOD = 0, W_MA = W_MOD + al(2L * NC * 3 * D), W_U0 = W_MA + al((long)M * D), W_XC = W_U0 + al((long)M * 2 * D),
    W_GA = W_XC + al((long)M * D), W_GB = W_GA + al((long)M * D), W_F = W_GB + al((long)M * D), W_X1 = W_F + al((long)M * D),
    W_KV = W_X1 + al((long)M * D), W_U = W_KV + al((long)M * NKVC), W_HID = W_U + al((long)M * NU),
    W_COMP = W_HID + al((long)NSEQN * NKV * 2 * DPHI), W_PC = W_COMP + al((long)NSEQN * NKV * 2 * HD),
    W_OCMP = W_PC + al((long)M * NH * NSBMAX), W_OSEL = W_OCMP + al((long)M * D), W_OWIN = W_OSEL + al((long)M * D),
    W_OBUF = W_OWIN + al((long)M * D), W_IDX = W_OBUF + al((long)M * D), W_END = W_IDX + al((long)M * NKV * NSEL);

struct Params { const float* in[I_N]; float* out; float* ws; };

#ifdef HOST_EMU
#define NV_DEV static inline
#else
#define NV_DEV __device__ __forceinline__
#endif

NV_DEV float silu_f(float x) { return x / (1.0f + expf(-x)); }
NV_DEV float sigm_f(float x) { return 1.0f / (1.0f + expf(-x)); }
NV_DEV int cond_of(int row) { return row < MP ? row / SEQ : BATCH + (row - MP) / DSEQ; }
NV_DEV int pos_of(int row) { return row < MP ? row % SEQ : PAST + (row - MP) % DSEQ; }
NV_DEV float slope_of(int H) { return exp2f(-8.0f * (float)(H + 1) / (float)NH); }

NV_DEV void ph_ada(const Params& p, long gtid, long gsz) {
    float* mod = p.ws + W_MOD;
    for (long it = gtid; it < 2L * NC * 3 * D; it += gsz) {
        const int n = (int)(it % (3 * D)); const int ci = (int)((it / (3 * D)) % NC); const int layer = (int)(it / (3L * D * NC));
        const float* c = ci < BATCH ? p.in[I_CP] + (long)ci * D : p.in[I_CS] + (long)(ci - BATCH) * D;
        const float* w = p.in[I_WADA] + (long)layer * D * 3 * D;
        float acc = 0.f;
        for (int k = 0; k < D; ++k) acc += silu_f(c[k]) * w[(long)k * 3 * D + n];
        mod[it] = acc + p.in[I_BADA][layer * 3 * D + n];
    }
}
NV_DEV void ph_mod(const Params& p, int layer, long gtid, long gsz) {
    const float* mod = p.ws + W_MOD + (long)layer * NC * 3 * D; float* mA = p.ws + W_MA;
    for (long it = gtid; it < (long)M * D; it += gsz) {
        const int row = (int)(it / D), k = (int)(it % D); const int ci = cond_of(row);
        float x;
        if (layer == 0) x = row < MP ? p.in[I_XP][it] : p.in[I_XS][it - (long)MP * D];
        else x = (p.ws + W_X1)[it];
        mA[it] = x * (1.0f + mod[(long)ci * 3 * D + D + k]) + mod[(long)ci * 3 * D + k];
    }
}
NV_DEV void gemm_naive(const float* A, int lda, const float* W, int ldw, float* C, int ldc, int Mr, int N, int K, long gtid, long gsz) {
    for (long it = gtid; it < (long)(Mr / 4) * N; it += gsz) {
        const int n = (int)(it % N); const long r0 = (it / N) * 4;
        float a0 = 0.f, a1 = 0.f, a2 = 0.f, a3 = 0.f;
        const float* A0 = A + r0 * lda;
        for (int k = 0; k < K; ++k) { const float w = W[(long)k * ldw + n];
            a0 += A0[k] * w; a1 += A0[lda + k] * w; a2 += A0[2 * lda + k] * w; a3 += A0[3 * lda + k] * w; }
        C[r0 * ldc + n] = a0; C[(r0 + 1) * ldc + n] = a1; C[(r0 + 2) * ldc + n] = a2; C[(r0 + 3) * ldc + n] = a3;
    }
}
NV_DEV void ph_conv(const Params& p, long gtid, long gsz) {
    const float* u0 = p.ws + W_U0; float* xc = p.ws + W_XC;
    for (long it = gtid; it < (long)M * D; it += gsz) {
        const int row = (int)(it / D), d = (int)(it % D);
        const int t = row < MP ? row % SEQ : (row - MP) % DSEQ;
        float acc = p.in[I_CONVB][d];
        for (int k = 0; k < 4; ++k) { const int j = t - 3 + k;
            float v;
            if (j >= 0) v = u0[(long)(row - t + j) * 2 * D + d];
            else v = row < MP ? 0.f : p.in[I_STC][((long)((row - MP) / DSEQ) * 3 + (3 + j)) * D + d];
            acc += v * p.in[I_CONVW][k * D + d]; }
        xc[it] = acc;
    }
}
NV_DEV void ph_gates(const Params& p, long gtid, long gsz) {
    const float* xc = p.ws + W_XC; float* ga = p.ws + W_GA; float* gb = p.ws + W_GB;
    for (long it = gtid; it < (long)M * D; it += gsz) {
        const int row = (int)(it / D), d = (int)(it % D); const int n = d / RGB, dd = d % RGB;
        const float* x = xc + (long)row * D + n * RGB;
        const float* wr = p.in[I_WR] + (long)n * RGB * RGB + dd; const float* wi = p.in[I_WI] + (long)n * RGB * RGB + dd;
        float ar = 0.f, ai = 0.f;
        for (int c = 0; c < RGB; ++c) { ar += x[c] * wr[(long)c * RGB]; ai += x[c] * wi[(long)c * RGB]; }
        const float r = sigm_f(ar + p.in[I_BR][d]), i = sigm_f(ai + p.in[I_BI][d]);
        const float lam = p.in[I_LAM][d];
        const float sp = (-lam > 20.f) ? -lam : log1pf(expf(-lam));
        const float log_a = -8.0f * sp * r;
        const float a = expf(log_a);
        const float gain = sqrtf(fmaxf(-expm1f(2.0f * log_a), 0.f));
        float b = gain * i * xc[it];
        const int t = row < MP ? row % SEQ : (row - MP) % DSEQ;
        if (t == 0 && row >= MP) b += a * p.in[I_STH][(long)((row - MP) / DSEQ) * D + d];
        ga[it] = a; gb[it] = b;
    }
}
NV_DEV void ph_scan(const Params& p, long gtid, long gsz) {
    const float* ga = p.ws + W_GA; float* gb = p.ws + W_GB;
    for (long it = gtid; it < (long)NC * D; it += gsz) {
        const int sq = (int)(it / D), d = (int)(it % D);
        const long row0 = sq < BATCH ? (long)sq * SEQ : MP + (long)(sq - BATCH) * DSEQ; const int T = sq < BATCH ? SEQ : DSEQ;
        float h = 0.f;
        for (int t = 0; t < T; ++t) { const long o = (row0 + t) * D + d; h = ga[o] * h + gb[o]; gb[o] = h; }
        if (sq < BATCH) p.out[O_HP + (long)sq * D + d] = h; else p.out[O_HS + (long)(sq - BATCH) * D + d] = h;
    }
}
NV_DEV void ph_gated(const Params& p, long gtid, long gsz) {
    const float* hs = p.ws + W_GB; const float* u0 = p.ws + W_U0; float* mA = p.ws + W_MA;
    for (long it = gtid; it < (long)M * D; it += gsz) { const long row = it / D; const int d = (int)(it % D);
        mA[it] = hs[it] * silu_f(u0[row * 2 * D + D + d]); }
}
NV_DEV void ph_ln(const Params& p, int layer, long gtid, long gsz) {
    const float* mod = p.ws + W_MOD + (long)layer * NC * 3 * D; const float* f = p.ws + W_F;
    for (long row = gtid; row < M; row += gsz) {
        const int ci = cond_of((int)row);
        const float* x = layer == 0 ? (row < MP ? p.in[I_XP] + row * D : p.in[I_XS] + (row - MP) * D) : p.ws + W_X1 + row * D;
        const float* gt = mod + (long)ci * 3 * D + 2 * D; const float* fr = f + row * D;
        float s = 0.f;
        for (int k = 0; k < D; ++k) s += ALPHA * x[k] + (1.0f + gt[k]) * fr[k];
        const float mu = s / D; float v = 0.f;
        for (int k = 0; k < D; ++k) { const float e = ALPHA * x[k] + (1.0f + gt[k]) * fr[k] - mu; v += e * e; }
        const float rstd = 1.0f / sqrtf(v / D + LN_EPS);
        float* dst = layer == 0 ? p.ws + W_X1 + row * D : (row < MP ? p.out + O_YP + row * D : p.out + O_YS + (row - MP) * D);
        const float* lg = p.in[I_LNG] + layer * D; const float* lb = p.in[I_LNB] + layer * D;
        for (int k = 0; k < D; ++k) dst[k] = (ALPHA * x[k] + (1.0f + gt[k]) * fr[k] - mu) * rstd * lg[k] + lb[k];
    }
}
NV_DEV void ph_outputs(const Params& p, long gtid, long gsz) {
    const float* kv = p.ws + W_KV; const float* u0 = p.ws + W_U0;
    for (long it = gtid; it < (long)MP * KVG; it += gsz) { const long row = it / KVG; const int c = (int)(it % KVG);
        p.out[O_CMPP + it] = kv[row * NKVC + c]; p.out[O_SELP + it] = kv[row * NKVC + KVG + c]; }
    for (long it = gtid; it < (long)BATCH * WIN * KVG; it += gsz) { const int c = (int)(it % KVG); const int j = (int)((it / KVG) % WIN); const int b = (int)(it / ((long)KVG * WIN));
        p.out[O_WINP + it] = kv[((long)b * SEQ + SEQ - WIN + j) * NKVC + 2 * KVG + c]; }
    for (long it = gtid; it < (long)MS * KVG; it += gsz) { const long row = MP + it / KVG; const int c = (int)(it % KVG);
        p.out[O_CMPS + it] = kv[row * NKVC + c]; p.out[O_SELS + it] = kv[row * NKVC + KVG + c]; }
    for (long it = gtid; it < (long)DECB * WIN * KVG; it += gsz) { const int c = (int)(it % KVG); const int j = (int)((it / KVG) % WIN); const int bs = (int)(it / ((long)KVG * WIN));
        const int jj = j + DSEQ;
        p.out[O_WINS + it] = jj < WIN ? p.in[I_SWIN][((long)bs * WIN + jj) * KVG + c] : kv[((long)MP + bs * DSEQ + (jj - WIN)) * NKVC + 2 * KVG + c]; }
    for (long it = gtid; it < (long)BATCH * 3 * D; it += gsz) { const int d = (int)(it % D); const int j = (int)((it / D) % 3); const int b = (int)(it / (3 * D));
        p.out[O_CONVP + it] = u0[((long)b * SEQ + SEQ - 3 + j) * 2 * D + d]; }
    for (long it = gtid; it < (long)DECB * 3 * D; it += gsz) { const int d = (int)(it % D); const int j = (int)((it / D) % 3); const int bs = (int)(it / (3 * D));
        p.out[O_CONVS + it] = u0[((long)MP + bs * DSEQ + DSEQ - 3 + j) * 2 * D + d]; }
}
NV_DEV const float* cmp_src_row(const Params& p, int sn, int l, int& ok) {
    ok = 1;
    if (sn < BATCH * NCP) { const int b = sn / NCP, n = sn % NCP; return p.ws + W_KV + ((long)b * SEQ + n * CMPB + l) * NKVC; }
    const int r = sn - BATCH * NCP; const int bs = r / NCS, n = r % NCS; const int pos = n * CMPB + l;
    if (pos < PAST) { const int pg = ((const int*)p.in[I_PT])[bs * NPAGES + pos / PAGE]; return p.in[I_CCMP] + ((long)pg * PAGE + pos % PAGE) * KVG; }
    return p.ws + W_KV + ((long)MP + bs * DSEQ + (pos - PAST)) * NKVC;
}
NV_DEV void ph_comp1(const Params& p, long gtid, long gsz) {
    float* hid = p.ws + W_HID;
    for (long it = gtid; it < (long)NSEQN * NKV * 2 * DPHI; it += gsz) {
        const int pp = (int)(it % DPHI); const int c = (int)((it / DPHI) % 2); const int g = (int)((it / (2 * DPHI)) % NKV); const int sn = (int)(it / (2L * DPHI * NKV));
        float acc = 0.f;
        for (int l = 0; l < CMPB; ++l) { int ok; const float* src = cmp_src_row(p, sn, l, ok) + g * 2 * HD + c * HD;
            const float* pe = p.in[I_PE] + ((long)l * 2 + c) * HD; const float* w = p.in[I_WPHI1] + (((long)c * CMPB + l) * HD) * DPHI + pp;
            for (int d = 0; d < HD; ++d) acc += (src[d] + pe[d]) * w[(long)d * DPHI]; }
        hid[it] = silu_f(acc + p.in[I_BPHI1][c * DPHI + pp]);
    }
}
NV_DEV void ph_comp2(const Params& p, long gtid, long gsz) {
    const float* hid = p.ws + W_HID; float* comp = p.ws + W_COMP;
    for (long it = gtid; it < (long)NSEQN * NKV * 2 * HD; it += gsz) {
        const int d = (int)(it % HD); const int c = (int)((it / HD) % 2); const long sgc = it / HD;
        const float* h = hid + sgc * DPHI; const float* w = p.in[I_WPHI2] + (long)c * DPHI * HD + d;
        float acc = 0.f;
        for (int q = 0; q < DPHI; ++q) acc += h[q] * w[(long)q * HD];
        comp[it] = acc + p.in[I_BPHI2][c * HD + d];
    }
}
NV_DEV void ph_cmp_attn(const Params& p, long gtid, long gsz) {
    const float* u = p.ws + W_U; const float* comp = p.ws + W_COMP; float* pc = p.ws + W_PC; float* ocmp = p.ws + W_OCMP;
    for (long it = gtid; it < (long)M * NH; it += gsz) {
        const int row = (int)(it / NH), H = (int)(it % NH); const int g = H / HPG; const int t = pos_of(row);
        const int nc = row < MP ? NCP : NCS; const long sn0 = row < MP ? (long)(row / SEQ) * NCP : (long)BATCH * NCP + (long)((row - MP) / DSEQ) * NCS;
        const float sl = slope_of(H);
        float q[HD];
        for (int d = 0; d < HD; ++d) q[d] = u[(long)row * NU + H * HD + d] * 0.125f;
        float* pr = pc + ((long)row * NH + H) * NSBMAX;
        float m = -3.0e38f; int nvalid = 0;
        for (int n = 0; n < nc; ++n) { const int ce = n * CMPB + CMPB - 1;
            if (ce <= t) { const float* k = comp + ((sn0 + n) * NKV + g) * 2 * HD; float s = 0.f;
                for (int d = 0; d < HD; ++d) s += q[d] * k[d];
                s -= sl * (float)(t - ce); pr[n] = s; m = fmaxf(m, s); ++nvalid; } }
        float l = 0.f;
        for (int n = 0; n < nvalid; ++n) l += expf(pr[n] - m);
        float o[HD];
        for (int d = 0; d < HD; ++d) o[d] = 0.f;
        for (int n = 0; n < nvalid; ++n) { const float pn = expf(pr[n] - m) / l; pr[n] = pn;
            const float* v = comp + ((sn0 + n) * NKV + g) * 2 * HD + HD;
            for (int d = 0; d < HD; ++d) o[d] += pn * v[d]; }
        for (int n = nvalid; n < NSBMAX; ++n) pr[n] = 0.f;
        for (int d = 0; d < HD; ++d) ocmp[(long)row * D + H * HD + d] = o[d];
    }
}
NV_DEV void ph_topk(const Params& p, long gtid, long gsz) {
    float* pc = p.ws + W_PC; int* idx = (int*)(p.ws + W_IDX);
    for (long it = gtid; it < (long)M * NKV; it += gsz) {
        const int row = (int)(it / NKV), g = (int)(it % NKV); const int t = pos_of(row); const int cb = t / CMPB;
        const int nsb = row < MP ? NCP : NSBS; const int kk = nsb < NSEL ? nsb : NSEL;
        float* p0 = pc + ((long)row * NH + g * HPG) * NSBMAX;
        for (int j = 0; j < nsb; ++j) { const float imp = ((p0[j] + p0[NSBMAX + j]) + p0[2 * NSBMAX + j]) + p0[3 * NSBMAX + j];
            const bool forced = (j == 0) || (j == cb) || (j == cb - 1);
            p0[j] = forced ? 1.0e6f : (j <= cb ? imp : -1.0f); }
        for (int k = 0; k < NSEL; ++k) {
            if (k >= kk) { idx[it * NSEL + k] = -1; continue; }
            float best = -4.0f; int bj = 0;
            for (int j = 0; j < nsb; ++j) if (p0[j] > best) { best = p0[j]; bj = j; }
            p0[bj] = -5.0f; idx[it * NSEL + k] = bj; }
    }
}
NV_DEV void ph_sel(const Params& p, long gtid, long gsz) {
    const float* u = p.ws + W_U; const float* kv = p.ws + W_KV; const int* idx = (const int*)(p.ws + W_IDX); float* osel = p.ws + W_OSEL;
    for (long it = gtid; it < (long)M * NH; it += gsz) {
        const int row = (int)(it / NH), H = (int)(it % NH); const int g = H / HPG; const int t = pos_of(row); const float sl = slope_of(H);
        float q[HD], o[HD];
        for (int d = 0; d < HD; ++d) { q[d] = u[(long)row * NU + H * HD + d] * 0.125f; o[d] = 0.f; }
        float m = -3.0e38f, l = 0.f;
        for (int k = 0; k < NSEL; ++k) { const int blk = idx[((long)row * NKV + g) * NSEL + k]; if (blk < 0) continue;
            for (int j = 0; j < CMPB; ++j) { const int pos = blk * CMPB + j; if (pos > t) continue;
                const float* kr;
                if (row < MP) kr = kv + ((long)(row / SEQ) * SEQ + pos) * NKVC + KVG + g * 2 * HD;
                else { const int bs = (row - MP) / DSEQ;
                    if (pos < PAST) { const int pg = ((const int*)p.in[I_PT])[bs * NPAGES + pos / PAGE]; kr = p.in[I_CSEL] + ((long)pg * PAGE + pos % PAGE) * KVG + g * 2 * HD; }
                    else { int r = pos - PAST; if (r > DSEQ - 1) r = DSEQ - 1; kr = kv + ((long)MP + bs * DSEQ + r) * NKVC + KVG + g * 2 * HD; } }
                float s = 0.f;
                for (int d = 0; d < HD; ++d) s += q[d] * kr[d];
                s -= sl * (float)(t - pos);
                const float mn = fmaxf(m, s); const float sc = expf(m - mn), pe = expf(s - mn);
                l = l * sc + pe;
                for (int d = 0; d < HD; ++d) o[d] = o[d] * sc + pe * kr[HD + d];
                m = mn; } }
        const float inv = 1.0f / l;
        for (int d = 0; d < HD; ++d) osel[(long)row * D + H * HD + d] = o[d] * inv;
    }
}
NV_DEV void ph_win(const Params& p, long gtid, long gsz) {
    const float* u = p.ws + W_U; const float* kv = p.ws + W_KV; float* owin = p.ws + W_OWIN;
    for (long it = gtid; it < (long)M * NH; it += gsz) {
        const int row = (int)(it / NH), H = (int)(it % NH); const int g = H / HPG; const int t = pos_of(row); const float sl = slope_of(H);
        float q[HD], o[HD];
        for (int d = 0; d < HD; ++d) { q[d] = u[(long)row * NU + H * HD + d] * 0.125f; o[d] = 0.f; }
        float m = -3.0e38f, l = 0.f;
        const int p0 = t - WIN > 0 ? t - WIN : 0;
        for (int pos = p0; pos <= t; ++pos) {
            const float* kr;
            if (row < MP) kr = kv + ((long)(row / SEQ) * SEQ + pos) * NKVC + 2 * KVG + g * 2 * HD;
            else { const int bs = (row - MP) / DSEQ; const int j = pos - (PAST - WIN);
                if (j < WIN) kr = p.in[I_SWIN] + ((long)bs * WIN + j) * KVG + g * 2 * HD;
                else kr = kv + ((long)MP + bs * DSEQ + (j - WIN)) * NKVC + 2 * KVG + g * 2 * HD; }
            float s = 0.f;
            for (int d = 0; d < HD; ++d) s += q[d] * kr[d];
            s -= sl * (float)(t - pos);
            const float mn = fmaxf(m, s); const float sc = expf(m - mn), pe = expf(s - mn);
            l = l * sc + pe;
            for (int d = 0; d < HD; ++d) o[d] = o[d] * sc + pe * kr[HD + d];
            m = mn; }
        const float inv = 1.0f / l;
        for (int d = 0; d < HD; ++d) owin[(long)row * D + H * HD + d] = o[d] * inv;
    }
}
NV_DEV void ph_combine(const Params& p, long gtid, long gsz) {
    const float* u = p.ws + W_U; float* obuf = p.ws + W_OBUF;
    for (long it = gtid; it < (long)M * D; it += gsz) { const long row = it / D; const int c = (int)(it % D); const int H = c / HD;
        const float* gl = u + row * NU + 2 * D + H * 3; const float* bg = p.in[I_BGATE] + H * 3;
        const float g0 = sigm_f(gl[0] + bg[0]), g1 = sigm_f(gl[1] + bg[1]), g2 = sigm_f(gl[2] + bg[2]);
        const float o = g0 * (p.ws + W_OCMP)[it] + g1 * (p.ws + W_OSEL)[it] + g2 * (p.ws + W_OWIN)[it];
        obuf[it] = o * silu_f(u[row * NU + D + c]); }
}

constexpr int N_PH = 21;
template <int PH> NV_DEV void run_phase(const Params& p, long gtid, long gsz) {
    if constexpr (PH == 0) ph_ada(p, gtid, gsz);
    else if constexpr (PH == 1) ph_mod(p, 0, gtid, gsz);
    else if constexpr (PH == 2) gemm_naive(p.ws + W_MA, D, p.in[I_WINA], 2 * D, p.ws + W_U0, 2 * D, M, 2 * D, D, gtid, gsz);
    else if constexpr (PH == 3) ph_conv(p, gtid, gsz);
    else if constexpr (PH == 4) ph_gates(p, gtid, gsz);
    else if constexpr (PH == 5) ph_scan(p, gtid, gsz);
    else if constexpr (PH == 6) ph_gated(p, gtid, gsz);
    else if constexpr (PH == 7) gemm_naive(p.ws + W_MA, D, p.in[I_WOUTA], D, p.ws + W_F, D, M, D, D, gtid, gsz);
    else if constexpr (PH == 8) ph_ln(p, 0, gtid, gsz);
    else if constexpr (PH == 9) gemm_naive(p.ws + W_X1, D, p.in[I_WKV], NKVC, p.ws + W_KV, NKVC, M, NKVC, D, gtid, gsz);
    else if constexpr (PH == 10) ph_mod(p, 1, gtid, gsz);
    else if constexpr (PH == 11) gemm_naive(p.ws + W_MA, D, p.in[I_WINB], NU, p.ws + W_U, NU, M, NU, D, gtid, gsz);
    else if constexpr (PH == 12) { ph_outputs(p, gtid, gsz); ph_comp1(p, gtid, gsz); }
    else if constexpr (PH == 13) ph_comp2(p, gtid, gsz);
    else if constexpr (PH == 14) ph_cmp_attn(p, gtid, gsz);
    else if constexpr (PH == 15) ph_topk(p, gtid, gsz);
    else if constexpr (PH == 16) ph_sel(p, gtid, gsz);
    else if constexpr (PH == 17) ph_win(p, gtid, gsz);
    else if constexpr (PH == 18) ph_combine(p, gtid, gsz);
    else if constexpr (PH == 19) gemm_naive(p.ws + W_OBUF, D, p.in[I_WOUTB], D, p.ws + W_F, D, M, D, D, gtid, gsz);
    else if constexpr (PH == 20) ph_ln(p, 1, gtid, gsz);
}
}

#define XB_TMO      128
#define XB_XCNT(j)  (256  + 64 * (j))
#define XB_XSUB(j)  (1280 + 64 * (j))
#define XB_XGEN(j)  (2304 + 64 * (j))
#define XB_TOP      3328
#define XB_TOPGEN   3392
#define XCD_BAR_WORDS 3456
#define XB_SPIN_CAP (1u << 18)
#define LAS __attribute__((address_space(3)))

__device__ __forceinline__ unsigned xb_ld(unsigned* p)              { return __hip_atomic_load(p, __ATOMIC_RELAXED, __HIP_MEMORY_SCOPE_AGENT); }
__device__ __forceinline__ unsigned xb_add(unsigned* p, unsigned v) { return __hip_atomic_fetch_add(p, v, __ATOMIC_RELAXED, __HIP_MEMORY_SCOPE_AGENT); }
__device__ __forceinline__ unsigned xb_xcc_id() { return (unsigned)__builtin_amdgcn_s_getreg((3 << 11) | 20) & 0xFu; }
#define XB_SPIN(cond, bar) do { unsigned _sp = 0; while (cond) { __builtin_amdgcn_s_sleep(1); \
    if ((++_sp & 255u) == 0u) { if (xb_ld(&(bar)[XB_TMO])) break; if (_sp > XB_SPIN_CAP) { atomicAdd(&(bar)[XB_TMO], 1u); break; } } } } while (0)

struct XcdBarrier {
    unsigned* bar; unsigned x;
    volatile LAS unsigned* st;
};

__device__ __forceinline__ XcdBarrier xcd_barrier_post(unsigned* bar, volatile LAS unsigned* st) {
    XcdBarrier b; b.bar = bar; b.x = xb_xcc_id(); b.st = st;
    if (threadIdx.x == 0) (void)xb_add(&bar[XB_XCNT(b.x)], 1u);
    return b;
}
__device__ __forceinline__ void xcd_barrier_complete(unsigned* bar, unsigned x, unsigned& nloc, unsigned& nx) {
    const unsigned G = gridDim.x * gridDim.y * gridDim.z;
    unsigned sum, cnt, mine, sp = 0u;
    for (;;) {
        sum = 0u; cnt = 0u; mine = 0u;
#pragma unroll
        for (unsigned j = 0; j < 16; ++j) { const unsigned c = xb_ld(&bar[XB_XCNT(j)]); sum += c; cnt += (c > 0u) ? 1u : 0u; mine = (j == x) ? c : mine; }
        if (sum == G) break;
        __builtin_amdgcn_s_sleep(1);
        if ((++sp & 255u) == 0u) { if (xb_ld(&bar[XB_TMO])) break; if (sp > XB_SPIN_CAP) { atomicAdd(&bar[XB_TMO], 1u); break; } }
    }
    nloc = mine > 0u ? mine : 1u; nx = cnt > 0u ? cnt : 1u;
}

__device__ __forceinline__ void xcd_barrier(const XcdBarrier& b) {
    asm volatile("s_waitcnt vmcnt(0)" ::: "memory");
    __syncthreads();
    if (threadIdx.x == 0) {
        unsigned* bar = b.bar;
        __builtin_amdgcn_s_waitcnt(0);
        unsigned nloc = b.st[0], nx = b.st[1];
        if (nloc == 0u) { xcd_barrier_complete(bar, b.x, nloc, nx); b.st[0] = nloc; b.st[1] = nx; }
        const unsigned old = xb_add(&bar[XB_XSUB(b.x)], 1u);
        const unsigned gen = old / nloc;
        if (old + 1u == (gen + 1u) * nloc) {
            __builtin_amdgcn_fence(__ATOMIC_RELEASE, "agent");
            asm volatile("s_waitcnt vmcnt(0)" ::: "memory");
            const unsigned og = xb_add(&bar[XB_TOP], 1u);
            const unsigned tg = og / nx;
            if (og + 1u == (tg + 1u) * nx) xb_add(&bar[XB_TOPGEN], 1u);
            else XB_SPIN(xb_ld(&bar[XB_TOPGEN]) == tg, bar);
            __builtin_amdgcn_fence(__ATOMIC_ACQUIRE, "agent");
            xb_add(&bar[XB_XGEN(b.x)], 1u);
            asm volatile("s_waitcnt vmcnt(0)" ::: "memory");
        } else {
            XB_SPIN(xb_ld(&bar[XB_XGEN(b.x)]) == gen, bar);
            __builtin_amdgcn_fence(__ATOMIC_ACQUIRE, "agent");
            asm volatile("s_waitcnt vmcnt(0)" ::: "memory");
        }
    }
    __syncthreads();
}

constexpr int NTHREADS = 512;
constexpr int LDS_BYTES = 147456;
constexpr int MISC_OFF = 131072 + 320;
constexpr size_t CTL_BYTES = 1u << 20;
constexpr size_t WS_CTL_OFF = ((size_t)nv::W_END * 4 + 4095) / 4096 * 4096;
constexpr int CW_BAR = 4096;
struct Args { nv::Params p; unsigned char* ctl; };

template <int PH> __device__ __forceinline__ void run_naive_phases(const nv::Params& p, const XcdBarrier& bar, long gtid, long gsz) {
    nv::run_phase<PH>(p, gtid, gsz);
    if constexpr (PH + 1 < nv::N_PH) { xcd_barrier(bar); run_naive_phases<PH + 1>(p, bar, gtid, gsz); }
}

__global__ void __launch_bounds__(NTHREADS, 2) mk_fwd(Args args) {
    extern __shared__ __attribute__((aligned(16))) unsigned char lds[];
    LAS unsigned char* L = (LAS unsigned char*)lds;
    volatile LAS unsigned* MISC = (volatile LAS unsigned*)(L + MISC_OFF);
    for (int u = threadIdx.x; u < 32; u += NTHREADS) MISC[u] = 0u;
    __syncthreads();
    XcdBarrier bar = xcd_barrier_post((unsigned*)(args.ctl) + CW_BAR, MISC + 8);
    const long gtid = (long)blockIdx.x * NTHREADS + threadIdx.x, gsz = (long)gridDim.x * NTHREADS;
    run_naive_phases<0>(args.p, bar, gtid, gsz);
}

extern "C" void kernel_launch(void* const* d_in, const int* in_sizes, int n_in,
                              void* d_out, int out_size, void* d_ws, size_t ws_size,
                              hipStream_t stream) {
    static int grid = 0;
    if (grid == 0) {
        if (n_in != nv::I_N || out_size != (int)nv::O_END || ws_size < WS_CTL_OFF + CTL_BYTES) { fprintf(stderr, "kernel_launch: unexpected sizes n_in %d out %d ws %zu\n", n_in, out_size, ws_size); grid = -1; return; }
        int dev = 0, cus = 0, per_cu = 0;
        if (hipGetDevice(&dev) != hipSuccess || hipDeviceGetAttribute(&cus, hipDeviceAttributeMultiprocessorCount, dev) != hipSuccess) { grid = -1; return; }
        if (hipFuncSetAttribute((const void*)mk_fwd, hipFuncAttributeMaxDynamicSharedMemorySize, LDS_BYTES) != hipSuccess) { fprintf(stderr, "kernel_launch: hipFuncSetAttribute failed\n"); grid = -1; return; }
        if (hipOccupancyMaxActiveBlocksPerMultiprocessor(&per_cu, (const void*)mk_fwd, NTHREADS, LDS_BYTES) != hipSuccess || per_cu < 1) fprintf(stderr, "kernel_launch: occupancy query reports %d\n", per_cu);
        (void)hipGetLastError();
        grid = cus;
    }
    if (grid < 0) return;
    unsigned char* ctl = (unsigned char*)d_ws + WS_CTL_OFF;
    if (hipMemsetAsync(ctl, 0, CTL_BYTES, stream) != hipSuccess) return;
    Args a{};
    for (int i = 0; i < nv::I_N; ++i) a.p.in[i] = (const float*)d_in[i];
    a.p.out = (float*)d_out; a.p.ws = (float*)d_ws; a.ctl = ctl;
    hipLaunchKernelGGL(mk_fwd, dim3(grid), dim3(NTHREADS), LDS_BYTES, stream, a);
}
```

```cpp
#include <hip/hip_runtime.h>
#include <cstdio>
#include <cstdint>
#ifndef CFG_D
#define CFG_D 1024
#define CFG_BATCH 2
#define CFG_SEQ 8192
#define CFG_DECB 32
#define CFG_PAST 8192
#define CFG_NRG 8
#define CFG_NH 16
#define CFG_NKV 4
#endif
namespace nv {
constexpr int D = CFG_D, BATCH = CFG_BATCH, SEQ = CFG_SEQ, DECB = CFG_DECB, DSEQ = 8, PAST = CFG_PAST, PAGE = 128;
constexpr int NRG = CFG_NRG, RGB = D / NRG, NH = CFG_NH, HD = 64, NKV = CFG_NKV, HPG = NH / NKV;
static_assert(D == NH * HD && HPG == 4, "geometry");
constexpr int CMPB = 64, NSEL = 16, WIN = 512, DPHI = 128;
constexpr int MP = BATCH * SEQ, MS = DECB * DSEQ, M = MP + MS, NC = BATCH + DECB;
constexpr int NKVC = 3 * NKV * 2 * HD;
constexpr int KVG = NKV * 2 * HD;
constexpr int NU = 2 * D + 3 * NH;
constexpr int NCP = SEQ / CMPB, NCS = (PAST + DSEQ) / CMPB, NSBS = (PAST + DSEQ + CMPB - 1) / CMPB;
constexpr int NSBMAX = ((NCP > NSBS ? NCP : NSBS) + 7) / 8 * 8;
constexpr int NPAGES = PAST / PAGE;
constexpr int NSEQN = BATCH * NCP + DECB * NCS;
constexpr float ALPHA = 1.4142135623730951f;
constexpr float LN_EPS = 1e-5f;
static_assert(PAST >= WIN && SEQ >= WIN, "window geometry");

constexpr long O_YP = 0, O_YS = O_YP + (long)MP * D, O_CMPP = O_YS + (long)MS * D, O_SELP = O_CMPP + (long)MP * KVG,
    O_WINP = O_SELP + (long)MP * KVG, O_HP = O_WINP + (long)BATCH * WIN * KVG, O_CONVP = O_HP + (long)BATCH * D,
    O_CMPS = O_CONVP + (long)BATCH * 3 * D, O_SELS = O_CMPS + (long)MS * KVG, O_WINS = O_SELS + (long)MS * KVG,
    O_HS = O_WINS + (long)DECB * WIN * KVG, O_CONVS = O_HS + (long)DECB * D, O_END = O_CONVS + (long)DECB * 3 * D;

enum { I_XP, I_XS, I_CP, I_CS, I_STH, I_STC, I_CCMP, I_CSEL, I_SWIN, I_PT, I_WADA, I_BADA, I_LNG, I_LNB, I_WINA, I_CONVW, I_CONVB,
       I_WR, I_BR, I_WI, I_BI, I_LAM, I_WOUTA, I_WKV, I_PE, I_WPHI1, I_BPHI1, I_WPHI2, I_BPHI2, I_WINB, I_BGATE, I_WOUTB, I_N };

struct WS {
    float *mod, *mA, *u0, *xc, *ga, *gb, *fbuf, *x1, *kv, *u, *hid, *comp, *pc, *ocmp, *osel, *owin, *obuf; int* idx;
};
constexpr long al(long x) { return (x + 63) / 64 * 64; }
constexpr long W_MOD = 0, W_MA = W_MOD + al(2L * NC * 3 * D), W_U0 = W_MA + al((long)M * D), W_XC = W_U0 + al((long)M * 2 * D),
    W_GA = W_XC + al((long)M * D), W_GB = W_GA + al((long)M * D), W_F = W_GB + al((long)M * D), W_X1 = W_F + al((long)M * D),
    W_KV = W_X1 + al((long)M * D), W_U = W_KV + al((long)M * NKVC), W_HID = W_U + al((long)M * NU),
    W_COMP = W_HID + al((long)NSEQN * NKV * 2 * DPHI), W_PC = W_COMP + al((long)NSEQN * NKV * 2 * HD),
    W_OCMP = W_PC + al((long)M * NH * NSBMAX), W_OSEL = W_OCMP + al((long)M * D), W_OWIN = W_OSEL + al((long)M * D),
    W_OBUF = W_OWIN + al((long)M * D), W_IDX = W_OBUF + al((long)M * D), W_END = W_IDX + al((long)M * NKV * NSEL);

constexpr long W_BFA = W_END, W_BFB = W_BFA + al((long)M * D / 2), W_END2 = W_BFB + al((long)M * D / 2);
struct Params { const float* in[I_N]; float* out; float* ws; };
static inline
#ifndef HOST_EMU
__device__
#endif
unsigned short f2bf_rne(float f) { unsigned u; __builtin_memcpy(&u, &f, 4); return (unsigned short)((u + 0x7fffu + ((u >> 16) & 1u)) >> 16); }

#ifdef HOST_EMU
#define NV_DEV static inline
#else
#define NV_DEV __device__ __forceinline__
#endif

NV_DEV float silu_f(float x) { return x / (1.0f + expf(-x)); }
NV_DEV float sigm_f(float x) { return 1.0f / (1.0f + expf(-x)); }
NV_DEV int cond_of(int row) { return row < MP ? row / SEQ : BATCH + (row - MP) / DSEQ; }
NV_DEV int pos_of(int row) { return row < MP ? row % SEQ : PAST + (row - MP) % DSEQ; }
NV_DEV float slope_of(int H) { return exp2f(-8.0f * (float)(H + 1) / (float)NH); }

NV_DEV void ph_ada(const Params& p, long gtid, long gsz) {
    float* mod = p.ws + W_MOD;
    for (long it = gtid; it < 2L * NC * 3 * D; it += gsz) {
        const int n = (int)(it % (3 * D)); const int ci = (int)((it / (3 * D)) % NC); const int layer = (int)(it / (3L * D * NC));
        const float* c = ci < BATCH ? p.in[I_CP] + (long)ci * D : p.in[I_CS] + (long)(ci - BATCH) * D;
        const float* w = p.in[I_WADA] + (long)layer * D * 3 * D;
        float acc = 0.f;
        for (int k = 0; k < D; ++k) acc += silu_f(c[k]) * w[(long)k * 3 * D + n];
        mod[it] = acc + p.in[I_BADA][layer * 3 * D + n];
    }
}
NV_DEV void ph_mod(const Params& p, int layer, long gtid, long gsz) {
    const float* mod = p.ws + W_MOD + (long)layer * NC * 3 * D; float* mA = p.ws + W_MA;
    for (long it = gtid; it < (long)M * D; it += gsz) {
        const int row = (int)(it / D), k = (int)(it % D); const int ci = cond_of(row);
        float x;
        if (layer == 0) x = row < MP ? p.in[I_XP][it] : p.in[I_XS][it - (long)MP * D];
        else x = (p.ws + W_X1)[it];
        const float v = x * (1.0f + mod[(long)ci * 3 * D + D + k]) + mod[(long)ci * 3 * D + k];
        mA[it] = v; ((unsigned short*)(p.ws + W_BFA))[it] = f2bf_rne(v);
    }
}
NV_DEV void gemm_naive(const float* A, int lda, const float* W, int ldw, float* C, int ldc, int Mr, int N, int K, long gtid, long gsz) {
    for (long it = gtid; it < (long)(Mr / 4) * N; it += gsz) {
        const int n = (int)(it % N); const long r0 = (it / N) * 4;
        float a0 = 0.f, a1 = 0.f, a2 = 0.f, a3 = 0.f;
        const float* A0 = A + r0 * lda;
        for (int k = 0; k < K; ++k) { const float w = W[(long)k * ldw + n];
            a0 += A0[k] * w; a1 += A0[lda + k] * w; a2 += A0[2 * lda + k] * w; a3 += A0[3 * lda + k] * w; }
        C[r0 * ldc + n] = a0; C[(r0 + 1) * ldc + n] = a1; C[(r0 + 2) * ldc + n] = a2; C[(r0 + 3) * ldc + n] = a3;
    }
}
NV_DEV void ph_conv(const Params& p, long gtid, long gsz) {
    const float* u0 = p.ws + W_U0; float* xc = p.ws + W_XC;
    for (long it = gtid; it < (long)M * D; it += gsz) {
        const int row = (int)(it / D), d = (int)(it % D);
        const int t = row < MP ? row % SEQ : (row - MP) % DSEQ;
        float acc = p.in[I_CONVB][d];
        for (int k = 0; k < 4; ++k) { const int j = t - 3 + k;
            float v;
            if (j >= 0) v = u0[(long)(row - t + j) * 2 * D + d];
            else v = row < MP ? 0.f : p.in[I_STC][((long)((row - MP) / DSEQ) * 3 + (3 + j)) * D + d];
            acc += v * p.in[I_CONVW][k * D + d]; }
        xc[it] = acc;
    }
}
NV_DEV void ph_gates(const Params& p, long gtid, long gsz) {
    const float* xc = p.ws + W_XC; float* ga = p.ws + W_GA; float* gb = p.ws + W_GB;
    for (long it = gtid; it < (long)M * D; it += gsz) {
        const int row = (int)(it / D), d = (int)(it % D); const int n = d / RGB, dd = d % RGB;
        const float* x = xc + (long)row * D + n * RGB;
        const float* wr = p.in[I_WR] + (long)n * RGB * RGB + dd; const float* wi = p.in[I_WI] + (long)n * RGB * RGB + dd;
        float ar = 0.f, ai = 0.f;
        for (int c = 0; c < RGB; ++c) { ar += x[c] * wr[(long)c * RGB]; ai += x[c] * wi[(long)c * RGB]; }
        const float r = sigm_f(ar + p.in[I_BR][d]), i = sigm_f(ai + p.in[I_BI][d]);
        const float lam = p.in[I_LAM][d];
        const float sp = (-lam > 20.f) ? -lam : log1pf(expf(-lam));
        const float log_a = -8.0f * sp * r;
        const float a = expf(log_a);
        const float gain = sqrtf(fmaxf(-expm1f(2.0f * log_a), 0.f));
        float b = gain * i * xc[it];
        const int t = row < MP ? row % SEQ : (row - MP) % DSEQ;
        if (t == 0 && row >= MP) b += a * p.in[I_STH][(long)((row - MP) / DSEQ) * D + d];
        ga[it] = a; gb[it] = b;
    }
}
NV_DEV void ph_scan(const Params& p, long gtid, long gsz) {
    const float* ga = p.ws + W_GA; float* gb = p.ws + W_GB;
    for (long it = gtid; it < (long)NC * D; it += gsz) {
        const int sq = (int)(it / D), d = (int)(it % D);
        const long row0 = sq < BATCH ? (long)sq * SEQ : MP + (long)(sq - BATCH) * DSEQ; const int T = sq < BATCH ? SEQ : DSEQ;
        float h = 0.f;
        for (int t = 0; t < T; ++t) { const long o = (row0 + t) * D + d; h = ga[o] * h + gb[o]; gb[o] = h; }
        if (sq < BATCH) p.out[O_HP + (long)sq * D + d] = h; else p.out[O_HS + (long)(sq - BATCH) * D + d] = h;
    }
}
NV_DEV void ph_gated(const Params& p, long gtid, long gsz) {
    const float* hs = p.ws + W_GB; const float* u0 = p.ws + W_U0; float* mA = p.ws + W_MA;
    for (long it = gtid; it < (long)M * D; it += gsz) { const long row = it / D; const int d = (int)(it % D);
        const float v = hs[it] * silu_f(u0[row * 2 * D + D + d]); mA[it] = v; ((unsigned short*)(p.ws + W_BFA))[it] = f2bf_rne(v); }
}
NV_DEV void ph_ln(const Params& p, int layer, long gtid, long gsz) {
    const float* mod = p.ws + W_MOD + (long)layer * NC * 3 * D; const float* f = p.ws + W_F;
    for (long row = gtid; row < M; row += gsz) {
        const int ci = cond_of((int)row);
        const float* x = layer == 0 ? (row < MP ? p.in[I_XP] + row * D : p.in[I_XS] + (row - MP) * D) : p.ws + W_X1 + row * D;
        const float* gt = mod + (long)ci * 3 * D + 2 * D; const float* fr = f + row * D;
        float s = 0.f;
        for (int k = 0; k < D; ++k) s += ALPHA * x[k] + (1.0f + gt[k]) * fr[k];
        const float mu = s / D; float v = 0.f;
        for (int k = 0; k < D; ++k) { const float e = ALPHA * x[k] + (1.0f + gt[k]) * fr[k] - mu; v += e * e; }
        const float rstd = 1.0f / sqrtf(v / D + LN_EPS);
        float* dst = layer == 0 ? p.ws + W_X1 + row * D : (row < MP ? p.out + O_YP + row * D : p.out + O_YS + (row - MP) * D);
        const float* lg = p.in[I_LNG] + layer * D; const float* lb = p.in[I_LNB] + layer * D;
        for (int k = 0; k < D; ++k) { const float v = (ALPHA * x[k] + (1.0f + gt[k]) * fr[k] - mu) * rstd * lg[k] + lb[k]; dst[k] = v;
            if (layer == 0) ((unsigned short*)(p.ws + W_BFB))[row * D + k] = f2bf_rne(v); }
    }
}
NV_DEV void ph_outputs(const Params& p, long gtid, long gsz) {
    const float* kv = p.ws + W_KV; const float* u0 = p.ws + W_U0;
    for (long it = gtid; it < (long)MP * KVG; it += gsz) { const long row = it / KVG; const int c = (int)(it % KVG);
        p.out[O_CMPP + it] = kv[row * NKVC + c]; p.out[O_SELP + it] = kv[row * NKVC + KVG + c]; }
    for (long it = gtid; it < (long)BATCH * WIN * KVG; it += gsz) { const int c = (int)(it % KVG); const int j = (int)((it / KVG) % WIN); const int b = (int)(it / ((long)KVG * WIN));
        p.out[O_WINP + it] = kv[((long)b * SEQ + SEQ - WIN + j) * NKVC + 2 * KVG + c]; }
    for (long it = gtid; it < (long)MS * KVG; it += gsz) { const long row = MP + it / KVG; const int c = (int)(it % KVG);
        p.out[O_CMPS + it] = kv[row * NKVC + c]; p.out[O_SELS + it] = kv[row * NKVC + KVG + c]; }
    for (long it = gtid; it < (long)DECB * WIN * KVG; it += gsz) { const int c = (int)(it % KVG); const int j = (int)((it / KVG) % WIN); const int bs = (int)(it / ((long)KVG * WIN));
        const int jj = j + DSEQ;
        p.out[O_WINS + it] = jj < WIN ? p.in[I_SWIN][((long)bs * WIN + jj) * KVG + c] : kv[((long)MP + bs * DSEQ + (jj - WIN)) * NKVC + 2 * KVG + c]; }
    for (long it = gtid; it < (long)BATCH * 3 * D; it += gsz) { const int d = (int)(it % D); const int j = (int)((it / D) % 3); const int b = (int)(it / (3 * D));
        p.out[O_CONVP + it] = u0[((long)b * SEQ + SEQ - 3 + j) * 2 * D + d]; }
    for (long it = gtid; it < (long)DECB * 3 * D; it += gsz) { const int d = (int)(it % D); const int j = (int)((it / D) % 3); const int bs = (int)(it / (3 * D));
        p.out[O_CONVS + it] = u0[((long)MP + bs * DSEQ + DSEQ - 3 + j) * 2 * D + d]; }
}
NV_DEV const float* cmp_src_row(const Params& p, int sn, int l, int& ok) {
    ok = 1;
    if (sn < BATCH * NCP) { const int b = sn / NCP, n = sn % NCP; return p.ws + W_KV + ((long)b * SEQ + n * CMPB + l) * NKVC; }
    const int r = sn - BATCH * NCP; const int bs = r / NCS, n = r % NCS; const int pos = n * CMPB + l;
    if (pos < PAST) { const int pg = ((const int*)p.in[I_PT])[bs * NPAGES + pos / PAGE]; return p.in[I_CCMP] + ((long)pg * PAGE + pos % PAGE) * KVG; }
    return p.ws + W_KV + ((long)MP + bs * DSEQ + (pos - PAST)) * NKVC;
}
NV_DEV void ph_comp1(const Params& p, long gtid, long gsz) {
    float* hid = p.ws + W_HID;
    for (long it = gtid; it < (long)NSEQN * NKV * 2 * DPHI; it += gsz) {
        const int pp = (int)(it % DPHI); const int c = (int)((it / DPHI) % 2); const int g = (int)((it / (2 * DPHI)) % NKV); const int sn = (int)(it / (2L * DPHI * NKV));
        float acc = 0.f;
        for (int l = 0; l < CMPB; ++l) { int ok; const float* src = cmp_src_row(p, sn, l, ok) + g * 2 * HD + c * HD;
            const float* pe = p.in[I_PE] + ((long)l * 2 + c) * HD; const float* w = p.in[I_WPHI1] + (((long)c * CMPB + l) * HD) * DPHI + pp;
            for (int d = 0; d < HD; ++d) acc += (src[d] + pe[d]) * w[(long)d * DPHI]; }
        hid[it] = silu_f(acc + p.in[I_BPHI1][c * DPHI + pp]);
    }
}
NV_DEV void ph_comp2(const Params& p, long gtid, long gsz) {
    const float* hid = p.ws + W_HID; float* comp = p.ws + W_COMP;
    for (long it = gtid; it < (long)NSEQN * NKV * 2 * HD; it += gsz) {
        const int d = (int)(it % HD); const int c = (int)((it / HD) % 2); const long sgc = it / HD;
        const float* h = hid + sgc * DPHI; const float* w = p.in[I_WPHI2] + (long)c * DPHI * HD + d;
        float acc = 0.f;
        for (int q = 0; q < DPHI; ++q) acc += h[q] * w[(long)q * HD];
        comp[it] = acc + p.in[I_BPHI2][c * HD + d];
    }
}
NV_DEV void ph_cmp_attn(const Params& p, long gtid, long gsz) {
    const float* u = p.ws + W_U; const float* comp = p.ws + W_COMP; float* pc = p.ws + W_PC; float* ocmp = p.ws + W_OCMP;
    for (long it = gtid; it < (long)M * NH; it += gsz) {
        const int row = (int)(it / NH), H = (int)(it % NH); const int g = H / HPG; const int t = pos_of(row);
        const int nc = row < MP ? NCP : NCS; const long sn0 = row < MP ? (long)(row / SEQ) * NCP : (long)BATCH * NCP + (long)((row - MP) / DSEQ) * NCS;
        const float sl = slope_of(H);
        float q[HD];
        for (int d = 0; d < HD; ++d) q[d] = u[(long)row * NU + H * HD + d] * 0.125f;
        float* pr = pc + ((long)row * NH + H) * NSBMAX;
        float m = -3.0e38f; int nvalid = 0;
        for (int n = 0; n < nc; ++n) { const int ce = n * CMPB + CMPB - 1;
            if (ce <= t) { const float* k = comp + ((sn0 + n) * NKV + g) * 2 * HD; float s = 0.f;
                for (int d = 0; d < HD; ++d) s += q[d] * k[d];
                s -= sl * (float)(t - ce); pr[n] = s; m = fmaxf(m, s); ++nvalid; } }
        float l = 0.f;
        for (int n = 0; n < nvalid; ++n) l += expf(pr[n] - m);
        float o[HD];
        for (int d = 0; d < HD; ++d) o[d] = 0.f;
        for (int n = 0; n < nvalid; ++n) { const float pn = expf(pr[n] - m) / l; pr[n] = pn;
            const float* v = comp + ((sn0 + n) * NKV + g) * 2 * HD + HD;
            for (int d = 0; d < HD; ++d) o[d] += pn * v[d]; }
        for (int n = nvalid; n < NSBMAX; ++n) pr[n] = 0.f;
        for (int d = 0; d < HD; ++d) ocmp[(long)row * D + H * HD + d] = o[d];
    }
}
NV_DEV void ph_topk(const Params& p, long gtid, long gsz) {
    float* pc = p.ws + W_PC; int* idx = (int*)(p.ws + W_IDX);
    for (long it = gtid; it < (long)M * NKV; it += gsz) {
        const int row = (int)(it / NKV), g = (int)(it % NKV); const int t = pos_of(row); const int cb = t / CMPB;
        const int nsb = row < MP ? NCP : NSBS; const int kk = nsb < NSEL ? nsb : NSEL;
        float* p0 = pc + ((long)row * NH + g * HPG) * NSBMAX;
        for (int j = 0; j < nsb; ++j) { const float imp = ((p0[j] + p0[NSBMAX + j]) + p0[2 * NSBMAX + j]) + p0[3 * NSBMAX + j];
            const bool forced = (j == 0) || (j == cb) || (j == cb - 1);
            p0[j] = forced ? 1.0e6f : (j <= cb ? imp : -1.0f); }
        for (int k = 0; k < NSEL; ++k) {
            if (k >= kk) { idx[it * NSEL + k] = -1; continue; }
            float best = -4.0f; int bj = 0;
            for (int j = 0; j < nsb; ++j) if (p0[j] > best) { best = p0[j]; bj = j; }
            p0[bj] = -5.0f; idx[it * NSEL + k] = bj; }
    }
}
NV_DEV void ph_sel(const Params& p, long gtid, long gsz) {
    const float* u = p.ws + W_U; const float* kv = p.ws + W_KV; const int* idx = (const int*)(p.ws + W_IDX); float* osel = p.ws + W_OSEL;
    for (long it = gtid; it < (long)M * NH; it += gsz) {
        const int row = (int)(it / NH), H = (int)(it % NH); const int g = H / HPG; const int t = pos_of(row); const float sl = slope_of(H);
        float q[HD], o[HD];
        for (int d = 0; d < HD; ++d) { q[d] = u[(long)row * NU + H * HD + d] * 0.125f; o[d] = 0.f; }
        float m = -3.0e38f, l = 0.f;
        for (int k = 0; k < NSEL; ++k) { const int blk = idx[((long)row * NKV + g) * NSEL + k]; if (blk < 0) continue;
            for (int j = 0; j < CMPB; ++j) { const int pos = blk * CMPB + j; if (pos > t) continue;
                const float* kr;
                if (row < MP) kr = kv + ((long)(row / SEQ) * SEQ + pos) * NKVC + KVG + g * 2 * HD;
                else { const int bs = (row - MP) / DSEQ;
                    if (pos < PAST) { const int pg = ((const int*)p.in[I_PT])[bs * NPAGES + pos / PAGE]; kr = p.in[I_CSEL] + ((long)pg * PAGE + pos % PAGE) * KVG + g * 2 * HD; }
                    else { int r = pos - PAST; if (r > DSEQ - 1) r = DSEQ - 1; kr = kv + ((long)MP + bs * DSEQ + r) * NKVC + KVG + g * 2 * HD; } }
                float s = 0.f;
                for (int d = 0; d < HD; ++d) s += q[d] * kr[d];
                s -= sl * (float)(t - pos);
                const float mn = fmaxf(m, s); const float sc = expf(m - mn), pe = expf(s - mn);
                l = l * sc + pe;
                for (int d = 0; d < HD; ++d) o[d] = o[d] * sc + pe * kr[HD + d];
                m = mn; } }
        const float inv = 1.0f / l;
        for (int d = 0; d < HD; ++d) osel[(long)row * D + H * HD + d] = o[d] * inv;
    }
}
NV_DEV void ph_win(const Params& p, long gtid, long gsz) {
    const float* u = p.ws + W_U; const float* kv = p.ws + W_KV; float* owin = p.ws + W_OWIN;
    for (long it = gtid; it < (long)M * NH; it += gsz) {
        const int row = (int)(it / NH), H = (int)(it % NH); const int g = H / HPG; const int t = pos_of(row); const float sl = slope_of(H);
        float q[HD], o[HD];
        for (int d = 0; d < HD; ++d) { q[d] = u[(long)row * NU + H * HD + d] * 0.125f; o[d] = 0.f; }
        float m = -3.0e38f, l = 0.f;
        const int p0 = t - WIN > 0 ? t - WIN : 0;
        for (int pos = p0; pos <= t; ++pos) {
            const float* kr;
            if (row < MP) kr = kv + ((long)(row / SEQ) * SEQ + pos) * NKVC + 2 * KVG + g * 2 * HD;
            else { const int bs = (row - MP) / DSEQ; const int j = pos - (PAST - WIN);
                if (j < WIN) kr = p.in[I_SWIN] + ((long)bs * WIN + j) * KVG + g * 2 * HD;
                else kr = kv + ((long)MP + bs * DSEQ + (j - WIN)) * NKVC + 2 * KVG + g * 2 * HD; }
            float s = 0.f;
            for (int d = 0; d < HD; ++d) s += q[d] * kr[d];
            s -= sl * (float)(t - pos);
            const float mn = fmaxf(m, s); const float sc = expf(m - mn), pe = expf(s - mn);
            l = l * sc + pe;
            for (int d = 0; d < HD; ++d) o[d] = o[d] * sc + pe * kr[HD + d];
            m = mn; }
        const float inv = 1.0f / l;
        for (int d = 0; d < HD; ++d) owin[(long)row * D + H * HD + d] = o[d] * inv;
    }
}
NV_DEV void ph_combine(const Params& p, long gtid, long gsz) {
    const float* u = p.ws + W_U; float* obuf = p.ws + W_OBUF;
    for (long it = gtid; it < (long)M * D; it += gsz) { const long row = it / D; const int c = (int)(it % D); const int H = c / HD;
        const float* gl = u + row * NU + 2 * D + H * 3; const float* bg = p.in[I_BGATE] + H * 3;
        const float g0 = sigm_f(gl[0] + bg[0]), g1 = sigm_f(gl[1] + bg[1]), g2 = sigm_f(gl[2] + bg[2]);
        const float o = g0 * (p.ws + W_OCMP)[it] + g1 * (p.ws + W_OSEL)[it] + g2 * (p.ws + W_OWIN)[it];
        const float v = o * silu_f(u[row * NU + D + c]); obuf[it] = v; ((unsigned short*)(p.ws + W_BFA))[it] = f2bf_rne(v); }
}

constexpr int N_PH = 21;
template <int PH> NV_DEV void run_phase(const Params& p, long gtid, long gsz) {
    if constexpr (PH == 0) ph_ada(p, gtid, gsz);
    else if constexpr (PH == 1) ph_mod(p, 0, gtid, gsz);
    else if constexpr (PH == 2) gemm_naive(p.ws + W_MA, D, p.in[I_WINA], 2 * D, p.ws + W_U0, 2 * D, M, 2 * D, D, gtid, gsz);
    else if constexpr (PH == 3) ph_conv(p, gtid, gsz);
    else if constexpr (PH == 4) ph_gates(p, gtid, gsz);
    else if constexpr (PH == 5) ph_scan(p, gtid, gsz);
    else if constexpr (PH == 6) ph_gated(p, gtid, gsz);
    else if constexpr (PH == 7) gemm_naive(p.ws + W_MA, D, p.in[I_WOUTA], D, p.ws + W_F, D, M, D, D, gtid, gsz);
    else if constexpr (PH == 8) ph_ln(p, 0, gtid, gsz);
    else if constexpr (PH == 9) gemm_naive(p.ws + W_X1, D, p.in[I_WKV], NKVC, p.ws + W_KV, NKVC, M, NKVC, D, gtid, gsz);
    else if constexpr (PH == 10) ph_mod(p, 1, gtid, gsz);
    else if constexpr (PH == 11) gemm_naive(p.ws + W_MA, D, p.in[I_WINB], NU, p.ws + W_U, NU, M, NU, D, gtid, gsz);
    else if constexpr (PH == 12) { ph_outputs(p, gtid, gsz); ph_comp1(p, gtid, gsz); }
    else if constexpr (PH == 13) ph_comp2(p, gtid, gsz);
    else if constexpr (PH == 14) ph_cmp_attn(p, gtid, gsz);
    else if constexpr (PH == 15) ph_topk(p, gtid, gsz);
    else if constexpr (PH == 16) ph_sel(p, gtid, gsz);
    else if constexpr (PH == 17) ph_win(p, gtid, gsz);
    else if constexpr (PH == 18) ph_combine(p, gtid, gsz);
    else if constexpr (PH == 19) gemm_naive(p.ws + W_OBUF, D, p.in[I_WOUTB], D, p.ws + W_F, D, M, D, D, gtid, gsz);
    else if constexpr (PH == 20) ph_ln(p, 1, gtid, gsz);
}
}

#define XB_TMO      128
#define XB_XCNT(j)  (256  + 64 * (j))
#define XB_XSUB(j)  (1280 + 64 * (j))
#define XB_XGEN(j)  (2304 + 64 * (j))
#define XB_TOP      3328
#define XB_TOPGEN   3392
#define XCD_BAR_WORDS 3456
#define XB_SPIN_CAP (1u << 18)
#define LAS __attribute__((address_space(3)))

__device__ __forceinline__ unsigned xb_ld(unsigned* p)              { return __hip_atomic_load(p, __ATOMIC_RELAXED, __HIP_MEMORY_SCOPE_AGENT); }
__device__ __forceinline__ unsigned xb_add(unsigned* p, unsigned v) { return __hip_atomic_fetch_add(p, v, __ATOMIC_RELAXED, __HIP_MEMORY_SCOPE_AGENT); }
__device__ __forceinline__ unsigned xb_xcc_id() { return (unsigned)__builtin_amdgcn_s_getreg((3 << 11) | 20) & 0xFu; }
#define XB_SPIN(cond, bar) do { unsigned _sp = 0; while (cond) { __builtin_amdgcn_s_sleep(1); \
    if ((++_sp & 255u) == 0u) { if (xb_ld(&(bar)[XB_TMO])) break; if (_sp > XB_SPIN_CAP) { atomicAdd(&(bar)[XB_TMO], 1u); break; } } } } while (0)

struct XcdBarrier {
    unsigned* bar; unsigned x;
    volatile LAS unsigned* st;
};

__device__ __forceinline__ XcdBarrier xcd_barrier_post(unsigned* bar, volatile LAS unsigned* st) {
    XcdBarrier b; b.bar = bar; b.x = xb_xcc_id(); b.st = st;
    if (threadIdx.x == 0) (void)xb_add(&bar[XB_XCNT(b.x)], 1u);
    return b;
}
__device__ __forceinline__ void xcd_barrier_complete(unsigned* bar, unsigned x, unsigned& nloc, unsigned& nx) {
    const unsigned G = gridDim.x * gridDim.y * gridDim.z;
    unsigned sum, cnt, mine, sp = 0u;
    for (;;) {
        sum = 0u; cnt = 0u; mine = 0u;
#pragma unroll
        for (unsigned j = 0; j < 16; ++j) { const unsigned c = xb_ld(&bar[XB_XCNT(j)]); sum += c; cnt += (c > 0u) ? 1u : 0u; mine = (j == x) ? c : mine; }
        if (sum == G) break;
        __builtin_amdgcn_s_sleep(1);
        if ((++sp & 255u) == 0u) { if (xb_ld(&bar[XB_TMO])) break; if (sp > XB_SPIN_CAP) { atomicAdd(&bar[XB_TMO], 1u); break; } }
    }
    nloc = mine > 0u ? mine : 1u; nx = cnt > 0u ? cnt : 1u;
}

__device__ __forceinline__ void xcd_barrier(const XcdBarrier& b) {
    asm volatile("s_waitcnt vmcnt(0)" ::: "memory");
    __syncthreads();
    if (threadIdx.x == 0) {
        unsigned* bar = b.bar;
        __builtin_amdgcn_s_waitcnt(0);
        unsigned nloc = b.st[0], nx = b.st[1];
        if (nloc == 0u) { xcd_barrier_complete(bar, b.x, nloc, nx); b.st[0] = nloc; b.st[1] = nx; }
        const unsigned old = xb_add(&bar[XB_XSUB(b.x)], 1u);
        const unsigned gen = old / nloc;
        if (old + 1u == (gen + 1u) * nloc) {
            __builtin_amdgcn_fence(__ATOMIC_RELEASE, "agent");
            asm volatile("s_waitcnt vmcnt(0)" ::: "memory");
            const unsigned og = xb_add(&bar[XB_TOP], 1u);
            const unsigned tg = og / nx;
            if (og + 1u == (tg + 1u) * nx) xb_add(&bar[XB_TOPGEN], 1u);
            else XB_SPIN(xb_ld(&bar[XB_TOPGEN]) == tg, bar);
            __builtin_amdgcn_fence(__ATOMIC_ACQUIRE, "agent");
            xb_add(&bar[XB_XGEN(b.x)], 1u);
            asm volatile("s_waitcnt vmcnt(0)" ::: "memory");
        } else {
            XB_SPIN(xb_ld(&bar[XB_XGEN(b.x)]) == gen, bar);
            __builtin_amdgcn_fence(__ATOMIC_ACQUIRE, "agent");
            asm volatile("s_waitcnt vmcnt(0)" ::: "memory");
        }
    }
    __syncthreads();
}

__device__ __forceinline__ int opaque_tid() { int t = threadIdx.x; asm volatile("" : "+v"(t)); return t; }

namespace pg8 {
#define PG8_LAS __attribute__((address_space(3)))
typedef unsigned short bf16_t;
typedef short bf16x8 __attribute__((ext_vector_type(8)));
typedef float f32x4 __attribute__((ext_vector_type(4)));
typedef unsigned u32x4 __attribute__((ext_vector_type(4)));
constexpr int BM = 256, BK = 64, HALF = 128, HTB = HALF * BK * 2  , STAGE_BYTES = 8 * HTB, NXCD = 8, WGM = 8;

__host__ __device__ __forceinline__ int lds_byte(int r, int c) { const int st = (r >> 4) * 2 + (c >> 5), rr = r & 15, cc = c & 31, ob = rr * 64 + cc * 2; return st * 1024 + (ob ^ (((ob >> 9) & 1) << 5)); }
__host__ __device__ __forceinline__ void stage_rc(int b, int& R, int& C) { const int st = b / 1024, sb = b % 1024, swz = sb ^ (((sb >> 9) & 1) << 5); R = (st >> 1) * 16 + swz / 64; C = (st & 1) * 32 + (swz % 64) / 2; }
__host__ __device__ __forceinline__ int perm32(int rho) { const int n = rho >> 4, i = rho & 15; return 8 * (i >> 2) + 4 * n + (i & 3); }

struct Unit { int pm, pn; };
struct Gemm { const bf16_t* A; const bf16_t* Bt; int M, N, K; const bf16_t* A2; int nsplit; };

struct StaticOrder {
    int nM, nN, nwg, G, c;
    __host__ __device__ void init(int M, int N, int G_, int c_) { nM = M / BM; nN = N / BM; nwg = nM * nN; G = G_; c = c_; }
    __host__ __device__ bool next(int i, Unit& u) const {
        const long L = (long)i * G + c; if (L >= nwg) return false;
        int wgid = (int)L; { const int q = nwg / NXCD, r = nwg % NXCD, xcd = wgid % NXCD, off = wgid / NXCD; wgid = (xcd < r ? xcd * (q + 1) : r * (q + 1) + (xcd - r) * q) + off; }
        const int nig = WGM * nN, gid = wgid / nig, fm = gid * WGM, gsz = (nM - fm) < WGM ? (nM - fm) : WGM;
        u.pm = fm + ((wgid % nig) % gsz); u.pn = (wgid % nig) / gsz; return true;
    }
    __device__ __forceinline__ void a_ready(const Unit&) const {}
    __device__ __forceinline__ void done(const Unit&) const {}
};

__device__ __forceinline__ unsigned cvt_pk_bf16(float lo, float hi) { unsigned r; asm volatile("v_cvt_pk_bf16_f32 %0, %1, %2" : "=v"(r) : "v"(lo), "v"(hi)); return r; }
typedef float f32x2 __attribute__((ext_vector_type(2)));
template <class Epi, class Sched, bool ALIGN_EPI = false, bool SP2 = false>
__device__ __forceinline__ void gemm_phase(PG8_LAS unsigned char* lds, const Gemm g, const Sched& S, const Epi& E) {
    const int tid = opaque_tid(), wid = __builtin_amdgcn_readfirstlane(tid >> 6), lane = tid & 63, wr = wid >> 2, wc = wid & 3, fr = lane & 15, fq = lane >> 4;
    const int K = g.K, nt = K / BK;
    unsigned voffA[2], voffB[2];
#pragma unroll
    for (int i = 0; i < 2; ++i) { int R, C; stage_rc(tid * 16 + i * 8192, R, C); const int Rb = Epi::PERM ? ((R & ~31) + perm32(R & 31)) : R;
        voffA[i] = (unsigned)(R * K + C) * 2u; voffB[i] = (unsigned)(Rb * K + C) * 2u; }
    const size_t kstep = (size_t)(BK * 2);
    const size_t hstep = (size_t)HALF * K * 2;
    const size_t tstep = 2 * hstep;
    const unsigned ldsw = (unsigned)wid * 1024u;
    const int aoff = lds_byte(wr * 64 + fr, fq * 8), boff = lds_byte(wc * 32 + fr, fq * 8);
#define PG8_SA(b, h) (((b) * 2 + (h)) * HTB)
#define PG8_SB(b, h) ((4 + (b) * 2 + (h)) * HTB)
#define PG8_STAGE(bufoff, gbase, voff) do { _Pragma("unroll") for (int _i = 0; _i < 2; ++_i) \
        __builtin_amdgcn_global_load_lds((const unsigned*)((const char*)(gbase) + (voff)[_i]), (PG8_LAS unsigned*)(lds + (bufoff) + ldsw + _i * 8192), 16, 0, 0); } while (0)
#define PG8_LDA(dst, b, h) do { _Pragma("unroll") for (int m = 0; m < 4; ++m) _Pragma("unroll") for (int k = 0; k < 2; ++k) dst[m][k] = *(const PG8_LAS bf16x8*)(lds + PG8_SA(b, h) + aoff + m * 2048 + k * 1024); } while (0)
#define PG8_LDB(dst, b, h) do { _Pragma("unroll") for (int n = 0; n < 2; ++n) _Pragma("unroll") for (int k = 0; k < 2; ++k) dst[n][k] = *(const PG8_LAS bf16x8*)(lds + PG8_SB(b, h) + boff + n * 2048 + k * 1024); } while (0)
#define PG8_MMA(ai, bj, At, Bt) do { __builtin_amdgcn_s_setprio(1); _Pragma("unroll") for (int m = 0; m < 4; ++m) _Pragma("unroll") for (int n = 0; n < 2; ++n) _Pragma("unroll") for (int k = 0; k < 2; ++k) \
        acc[ai][bj][m][n] = __builtin_amdgcn_mfma_f32_16x16x32_bf16(Bt[n][k], At[m][k], acc[ai][bj][m][n], 0, 0, 0); __builtin_amdgcn_s_setprio(0); } while (0)
#define PG8_WAIT_V(n) asm volatile("s_waitcnt vmcnt(" #n ")" ::: "memory")
#define PG8_WAIT_L(n) asm volatile("s_waitcnt lgkmcnt(" #n ")" ::: "memory")
#define PG8_BAR __builtin_amdgcn_s_barrier()
#define PG8_SCHED __builtin_amdgcn_sched_barrier(0)
    Unit cur, nxt; int ui = 0;
    if (!S.next(0, cur)) return;
    f32x4 acc[2][2][4][2];
#pragma unroll
    for (int a = 0; a < 2; ++a)
#pragma unroll
        for (int b = 0; b < 2; ++b)
#pragma unroll
            for (int m = 0; m < 4; ++m)
#pragma unroll
                for (int n = 0; n < 2; ++n) acc[a][b][m][n] = (f32x4){0.f, 0.f, 0.f, 0.f};
    bf16x8 At[4][2], B0[2][2], B1[2][2];
    const char* cA = (const char*)(cur.pn < g.nsplit ? g.A : g.A2) + (size_t)cur.pm * tstep; const char* cB = (const char*)g.Bt + (size_t)cur.pn * tstep;
    S.a_ready(cur);
    if constexpr (SP2) {
        PG8_STAGE(PG8_SB(0, 0), cB, voffB); PG8_STAGE(PG8_SB(0, 1), cB + hstep, voffB); PG8_STAGE(PG8_SA(0, 0), cA, voffA); PG8_STAGE(PG8_SA(0, 1), cA + hstep, voffA);
        if (wr == 1) PG8_BAR;
        PG8_WAIT_V(2); PG8_BAR;
        PG8_STAGE(PG8_SB(1, 0), cB + kstep, voffB); PG8_STAGE(PG8_SA(1, 0), cA + kstep, voffA); PG8_STAGE(PG8_SB(1, 1), cB + hstep + kstep, voffB);
        PG8_WAIT_V(6); PG8_BAR;
    } else {
        PG8_STAGE(PG8_SB(0, 0), cB, voffB); PG8_STAGE(PG8_SA(0, 0), cA, voffA); PG8_STAGE(PG8_SB(0, 1), cB + hstep, voffB); PG8_STAGE(PG8_SA(0, 1), cA + hstep, voffA);
        if (wr == 1) PG8_BAR;
        PG8_WAIT_V(4); PG8_BAR;
        PG8_STAGE(PG8_SB(1, 0), cB + kstep, voffB); PG8_STAGE(PG8_SA(1, 0), cA + kstep, voffA); PG8_STAGE(PG8_SB(1, 1), cB + hstep + kstep, voffB);
        PG8_WAIT_V(6); PG8_BAR;
    }
    for (;;) {
        const bool has_next = S.next(ui + 1, nxt);
        const char* nA = has_next ? (const char*)(nxt.pn < g.nsplit ? g.A : g.A2) + (size_t)nxt.pm * tstep : cA; const char* nB = has_next ? (const char*)g.Bt + (size_t)nxt.pn * tstep : cB;
        for (int t = 0; t < nt; t += 2) {
            const bool last = (t == nt - 2);
            const char* a1 = cA + (size_t)(t + 1) * kstep;
            const char* a2 = last ? nA : cA + (size_t)(t + 2) * kstep; const char* b2 = last ? nB : cB + (size_t)(t + 2) * kstep;
            const char* a3 = a2 + kstep; const char* b3 = b2 + kstep;
            if (last && has_next) S.a_ready(nxt);
            if constexpr (SP2) {
            PG8_LDB(B0, 0, 0); PG8_LDB(B1, 0, 1); PG8_SCHED; PG8_LDA(At, 0, 0); PG8_STAGE(PG8_SA(1, 1), a1 + hstep, voffA);
            PG8_WAIT_V(8); PG8_WAIT_L(0); PG8_BAR; PG8_MMA(0, 0, At, B0); PG8_MMA(0, 1, At, B1); PG8_BAR; PG8_SCHED;
            PG8_LDA(At, 0, 1); PG8_STAGE(PG8_SB(0, 0), b2, voffB); PG8_STAGE(PG8_SB(0, 1), b2 + hstep, voffB); PG8_STAGE(PG8_SA(0, 0), a2, voffA);
            PG8_WAIT_V(8); PG8_WAIT_L(0); PG8_BAR; PG8_MMA(1, 0, At, B0); PG8_MMA(1, 1, At, B1); PG8_BAR; PG8_SCHED;
            PG8_LDB(B0, 1, 0); PG8_LDB(B1, 1, 1); PG8_SCHED; PG8_LDA(At, 1, 0); PG8_STAGE(PG8_SA(0, 1), a2 + hstep, voffA);
            PG8_WAIT_V(8); PG8_WAIT_L(0); PG8_BAR; PG8_MMA(0, 0, At, B0); PG8_MMA(0, 1, At, B1); PG8_BAR; PG8_SCHED;
            PG8_LDA(At, 1, 1); PG8_STAGE(PG8_SB(1, 0), b3, voffB); PG8_STAGE(PG8_SB(1, 1), b3 + hstep, voffB); PG8_STAGE(PG8_SA(1, 0), a3, voffA);
            PG8_WAIT_V(8); PG8_WAIT_L(0); PG8_BAR; PG8_MMA(1, 0, At, B0); PG8_MMA(1, 1, At, B1); PG8_BAR; PG8_SCHED;
            } else {
            PG8_LDB(B0, 0, 0); PG8_SCHED; PG8_LDA(At, 0, 0); PG8_STAGE(PG8_SA(1, 1), a1 + hstep, voffA);
            PG8_WAIT_L(8); PG8_BAR; PG8_WAIT_L(0); PG8_MMA(0, 0, At, B0); PG8_BAR; PG8_SCHED;
            PG8_LDB(B1, 0, 1); PG8_STAGE(PG8_SB(0, 0), b2, voffB);
            PG8_BAR; PG8_WAIT_L(0); PG8_MMA(0, 1, At, B1); PG8_BAR;
            PG8_LDA(At, 0, 1); PG8_STAGE(PG8_SA(0, 0), a2, voffA);
            PG8_BAR; PG8_WAIT_L(0); PG8_MMA(1, 0, At, B0); PG8_BAR; PG8_SCHED;
            PG8_STAGE(PG8_SB(0, 1), b2 + hstep, voffB);
            PG8_WAIT_V(6); PG8_BAR; PG8_MMA(1, 1, At, B1); PG8_BAR;
            PG8_LDB(B0, 1, 0); PG8_SCHED; PG8_LDA(At, 1, 0); PG8_STAGE(PG8_SA(0, 1), a2 + hstep, voffA);
            PG8_WAIT_L(8); PG8_BAR; PG8_WAIT_L(0); PG8_MMA(0, 0, At, B0); PG8_BAR; PG8_SCHED;
            PG8_LDB(B1, 1, 1); PG8_STAGE(PG8_SB(1, 0), b3, voffB);
            PG8_BAR; PG8_WAIT_L(0); PG8_MMA(0, 1, At, B1); PG8_BAR;
            PG8_LDA(At, 1, 1); PG8_STAGE(PG8_SA(1, 0), a3, voffA);
            PG8_BAR; PG8_WAIT_L(0); PG8_MMA(1, 0, At, B0); PG8_BAR; PG8_SCHED;
            PG8_STAGE(PG8_SB(1, 1), b3 + hstep, voffB);
            PG8_WAIT_V(6); PG8_BAR; PG8_MMA(1, 1, At, B1); PG8_BAR;
            }
        }
        if constexpr (ALIGN_EPI) { if (wr == 0) PG8_BAR; }
        if constexpr (!Epi::AFTER_DRAIN) { E(acc, cur, wr, wc, fr, fq); S.done(cur); }
        if (!has_next) break;
#pragma unroll
        for (int a = 0; a < 2; ++a)
#pragma unroll
            for (int b = 0; b < 2; ++b)
#pragma unroll
                for (int m = 0; m < 4; ++m)
#pragma unroll
                    for (int n = 0; n < 2; ++n) acc[a][b][m][n] = (f32x4){0.f, 0.f, 0.f, 0.f};
        cur = nxt; cA = nA; cB = nB; ++ui;
        if constexpr (ALIGN_EPI) { if (wr == 1) PG8_BAR; }
    }
    PG8_WAIT_V(0);
    if constexpr (!ALIGN_EPI) { if (wr == 0) PG8_BAR; }
    PG8_BAR;
    if constexpr (Epi::AFTER_DRAIN) { E.fused(acc, cur, wr, wc, fr, fq, lds, wid, lane); S.done(cur); }
#undef PG8_SA
#undef PG8_SB
#undef PG8_STAGE
#undef PG8_LDA
#undef PG8_LDB
#undef PG8_MMA
#undef PG8_WAIT_V
#undef PG8_WAIT_L
#undef PG8_BAR
#undef PG8_SCHED
}
}

#define GAS __attribute__((address_space(1)))
typedef unsigned short bf16;
typedef unsigned v4u __attribute__((ext_vector_type(4)));
typedef float f32x4 __attribute__((ext_vector_type(4)));
#define LDS_WAIT() asm volatile("s_waitcnt lgkmcnt(0)" ::: "memory")
#define VM_WAIT() asm volatile("s_waitcnt vmcnt(0)" ::: "memory")
__device__ __forceinline__ unsigned f2bf(float f) { unsigned u = __builtin_bit_cast(unsigned, f); return (u + 0x7fffu + ((u >> 16) & 1u)) >> 16; }
__device__ __forceinline__ unsigned pk2(float lo, float hi) { return f2bf(lo) | (f2bf(hi) << 16); }

namespace pg8 {
struct EpiF32Split {
    static constexpr bool PERM = false, AFTER_DRAIN = false;
    float* C0; int ldc0, n0; float* C1; int ldc1, n1;
    __device__ __forceinline__ void operator()(const f32x4 (&acc)[2][2][4][2], const Unit& u, int wr, int wc, int fr, int fq) const {
#pragma unroll
        for (int ai = 0; ai < 2; ++ai)
#pragma unroll
            for (int m = 0; m < 4; ++m) { const size_t row = (size_t)u.pm * BM + ai * HALF + wr * 64 + m * 16 + fr;
#pragma unroll
                for (int bj = 0; bj < 2; ++bj)
#pragma unroll
                    for (int n = 0; n < 2; ++n) { const int col = u.pn * BM + bj * HALF + wc * 32 + n * 16 + 4 * fq;
                        if (col < n0) *(f32x4*)(C0 + row * ldc0 + col) = acc[ai][bj][m][n];
                        else if (col - n0 < n1) *(f32x4*)(C1 + row * ldc1 + (col - n0)) = acc[ai][bj][m][n]; } }
    }
};
}

__device__ __forceinline__ void wt_transpose_item(const float* W, int K, int N, bf16* WT, int row_off, LAS float* scr, int item, int lane) {
    const int nblk = (N + 31) / 32, kb = item / nblk, nb = item % nblk, k0 = 64 * kb, n0 = 32 * nb;
    const bool okn = n0 + (lane & 31) < N;
#pragma unroll 8
    for (int i = 0; i < 32; ++i) { const int kk = 2 * i + (lane >> 5); scr[kk * 33 + (lane & 31)] = okn ? W[(size_t)(k0 + kk) * N + n0 + (lane & 31)] : 0.f; }
    LDS_WAIT(); asm volatile("" ::: "memory");
    const int c = lane & 7;
#pragma unroll
    for (int j = 0; j < 4; ++j) { const int n = (lane >> 3) + 8 * j; const LAS float* s = scr + (8 * c) * 33 + n;
        v4u o; o.x = pk2(s[0 * 33], s[1 * 33]); o.y = pk2(s[2 * 33], s[3 * 33]); o.z = pk2(s[4 * 33], s[5 * 33]); o.w = pk2(s[6 * 33], s[7 * 33]);
        *(GAS v4u*)(WT + (size_t)(row_off + n0 + n) * K + k0 + 8 * c) = o; }
    LDS_WAIT(); asm volatile("" ::: "memory");
}

namespace rg {
typedef short bf16x8 __attribute__((ext_vector_type(8)));
constexpr int TC = 128, NCHUNK = nv::SEQ / TC;
constexpr int A_STRIDE = 272;
constexpr int X_STRIDE = 132;
constexpr int LDS_A = 0, LDS_X = 128 * A_STRIDE;
constexpr int NUNIT_P = nv::BATCH * NCHUNK * 8, NUNIT_S = (nv::MS / 128) * 8;
static_assert(nv::RGB == 128 && nv::NRG == 8 && nv::MS % 128 == 0 && nv::SEQ % TC == 0, "rg geometry");

__device__ __forceinline__ float sigm(float x) { return 1.0f / (1.0f + __expf(-x)); }

template <int PASS>
__device__ __forceinline__ void rg_pass(const nv::Params& p, LAS unsigned char* L, float* agg) {
    using namespace nv;
    const int tid = opaque_tid(), wave = __builtin_amdgcn_readfirstlane(tid >> 6), lane = tid & 63;
    const int n = blockIdx.x & 7;
    const int l15 = lane & 15, q = lane >> 4;
    const int cl = 16 * wave + l15, ch = n * 128 + cl;
    const float* u0 = p.ws + W_U0;
    LAS float* X = (LAS float*)(L + LDS_X);
    bf16x8 Br[4], Bi[4];
#pragma unroll
    for (int ks = 0; ks < 4; ++ks)
#pragma unroll
        for (int j = 0; j < 8; ++j) { const int k = 32 * ks + 8 * q + j;
            Br[ks][j] = (short)f2bf(p.in[I_WR][((size_t)n * 128 + k) * 128 + cl]); Bi[ks][j] = (short)f2bf(p.in[I_WI][((size_t)n * 128 + k) * 128 + cl]); }
    const float br = p.in[I_BR][ch], bi = p.in[I_BI][ch];
    const float lam = p.in[I_LAM][ch];
    const float sp8 = 8.0f * ((-lam > 20.f) ? -lam : log1pf(expf(-lam)));
    const int nunits = PASS == 1 ? NUNIT_P : NUNIT_P + NUNIT_S;
    for (int u = blockIdx.x; u < nunits; u += gridDim.x) {
        const bool samp = u >= NUNIT_P;
        int row0, b = 0, chunk = 0;
        if (!samp) { const int cidx = u >> 3; b = cidx / NCHUNK; chunk = cidx % NCHUNK; row0 = b * SEQ + chunk * TC; }
        else row0 = MP + ((u - NUNIT_P) >> 3) * 128;
        {
            const int c = tid & 127, rq = tid >> 7; const int chn = n * 128 + c;
            const float w0 = p.in[I_CONVW][chn], w1 = p.in[I_CONVW][D + chn], w2 = p.in[I_CONVW][2 * D + chn], w3 = p.in[I_CONVW][3 * D + chn], cb = p.in[I_CONVB][chn];
            LAS unsigned short* Abf = (LAS unsigned short*)(L + LDS_A);
            for (int i = 0; i < 32; ++i) {
                const int rl = rq * 32 + i, row = row0 + rl;
                int t, srow; if (!samp) { t = chunk * TC + rl; srow = b * SEQ; } else { t = rl & 7; srow = row - t; }
                float v[4];
#pragma unroll
                for (int k = 0; k < 4; ++k) { const int tt = t - 3 + k;
                    if (tt >= 0) v[k] = u0[(size_t)(srow + tt) * 2048 + chn];
                    else v[k] = samp ? p.in[I_STC][((size_t)((row - MP) >> 3) * 3 + (3 + tt)) * D + chn] : 0.f; }
                const float acc = cb + v[0] * w0 + v[1] * w1 + v[2] * w2 + v[3] * w3;
                X[rl * X_STRIDE + c] = acc; Abf[rl * (A_STRIDE / 2) + c] = (unsigned short)f2bf(acc);
            }
        }
        __syncthreads();
        float hin = 0.f;
        if (PASS == 2 && !samp) {
            float Ap = 1.f, Bp = 0.f;
            const float2* ag = (const float2*)agg + ((size_t)b * NCHUNK) * 1024 + ch;
#pragma unroll
            for (int i = 0; i < 16; ++i) { const int cc = 16 * q + i; const int cs = cc < chunk ? cc : 0; const float2 ab = ag[(size_t)cs * 1024];
                const float a_ = cc < chunk ? ab.x : 1.f, b_ = cc < chunk ? ab.y : 0.f; Bp = a_ * Bp + b_; Ap = a_ * Ap; }
#pragma unroll
            for (int qq = 0; qq < 4; ++qq) { const float a_ = __shfl(Ap, 16 * qq + l15), b_ = __shfl(Bp, 16 * qq + l15); hin = a_ * hin + b_; }
        }
        f32x4 accr[8], acci[8];
#pragma unroll
        for (int rt = 0; rt < 8; ++rt) { accr[rt] = (f32x4){0.f, 0.f, 0.f, 0.f}; acci[rt] = (f32x4){0.f, 0.f, 0.f, 0.f}; }
#pragma unroll
        for (int ks = 0; ks < 4; ++ks)
#pragma unroll
            for (int rt = 0; rt < 8; ++rt) { const bf16x8 a = *(const LAS bf16x8*)(L + LDS_A + (16 * rt + l15) * A_STRIDE + (32 * ks + 8 * q) * 2);
                accr[rt] = __builtin_amdgcn_mfma_f32_16x16x32_bf16(a, Br[ks], accr[rt], 0, 0, 0);
                acci[rt] = __builtin_amdgcn_mfma_f32_16x16x32_bf16(a, Bi[ks], acci[rt], 0, 0, 0); }
        float carA = 1.f, carB = hin;
#pragma unroll
        for (int rt = 0; rt < 8; ++rt) {
            float a[4], bb[4];
#pragma unroll
            for (int j = 0; j < 4; ++j) { const int rl = 16 * rt + 4 * q + j; const float xc = X[rl * X_STRIDE + cl];
                const float r = sigm(accr[rt][j] + br), ii = sigm(acci[rt][j] + bi);
                const float la = -sp8 * r; a[j] = expf(la); const float gain = sqrtf(fmaxf(-expm1f(2.0f * la), 0.f)); bb[j] = gain * ii * xc; }
            float As = a[0], Bs = bb[0];
#pragma unroll
            for (int j = 1; j < 4; ++j) { Bs = a[j] * Bs + bb[j]; As *= a[j]; }
            if (!samp) {
                float Ai = As, Bq = Bs;
                { const float pa = __shfl_up(Ai, 16), pb = __shfl_up(Bq, 16); if (q >= 1) { Bq = Ai * pb + Bq; Ai = pa * Ai; } }
                { const float pa = __shfl_up(Ai, 32), pb = __shfl_up(Bq, 32); if (q >= 2) { Bq = Ai * pb + Bq; Ai = pa * Ai; } }
                float Ae = __shfl_up(Ai, 16), Be = __shfl_up(Bq, 16); if (q == 0) { Ae = 1.f; Be = 0.f; }
                const float At = __shfl(Ai, 48 + l15), Bt = __shfl(Bq, 48 + l15);
                if (PASS == 2) {
                    float h = Ae * carB + Be;
#pragma unroll
                    for (int j = 0; j < 4; ++j) { h = a[j] * h + bb[j]; X[(16 * rt + 4 * q + j) * X_STRIDE + cl] = h; }
                    if (rt == 7 && q == 3 && chunk == NCHUNK - 1) p.out[O_HP + (size_t)b * D + ch] = h;
                    carB = At * carB + Bt;
                } else { carB = At * carB + Bt; carA = At * carA; }
            } else if (PASS == 2) {
                const int bs = ((row0 - MP) >> 3) + 2 * rt + (q >> 1);
                const float h0 = p.in[I_STH][(size_t)bs * D + ch];
                const float pa = __shfl_up(As, 16), pb = __shfl_up(Bs, 16);
                float h = (q & 1) ? pa * h0 + pb : h0;
#pragma unroll
                for (int j = 0; j < 4; ++j) { h = a[j] * h + bb[j]; X[(16 * rt + 4 * q + j) * X_STRIDE + cl] = h; }
                if (q & 1) p.out[O_HS + (size_t)bs * D + ch] = h;
            }
        }
        if (PASS == 1) { if (q == 3) ((float2*)agg)[((size_t)b * NCHUNK + chunk) * 1024 + ch] = make_float2(carA, carB); }
        if (PASS == 2) {
            __syncthreads();
            bf16* gA = (bf16*)(p.ws + W_BFA);
            for (int it = tid; it < 2048; it += 512) { const int rl = it >> 4, g8 = it & 15;
                const f32x4 h0 = *(const LAS f32x4*)(X + rl * X_STRIDE + 8 * g8), h1 = *(const LAS f32x4*)(X + rl * X_STRIDE + 8 * g8 + 4);
                const float* zp = u0 + (size_t)(row0 + rl) * 2048 + 1024 + n * 128 + 8 * g8;
                const f32x4 z0 = *(const f32x4*)zp, z1 = *(const f32x4*)(zp + 4);
                v4u o; o.x = pk2(h0[0] * z0[0] * sigm(z0[0]), h0[1] * z0[1] * sigm(z0[1])); o.y = pk2(h0[2] * z0[2] * sigm(z0[2]), h0[3] * z0[3] * sigm(z0[3]));
                o.z = pk2(h1[0] * z1[0] * sigm(z1[0]), h1[1] * z1[1] * sigm(z1[1])); o.w = pk2(h1[2] * z1[2] * sigm(z1[2]), h1[3] * z1[3] * sigm(z1[3]));
                *(GAS v4u*)(gA + (size_t)(row0 + rl) * 1024 + n * 128 + 8 * g8) = o; }
        }
        __syncthreads();
    }
}
}

namespace at {
using namespace nv;
typedef short bf16x8 __attribute__((ext_vector_type(8)));
typedef short s16x4 __attribute__((ext_vector_type(4)));
typedef short v4i16_t __attribute__((ext_vector_type(4)));
typedef unsigned v2u __attribute__((ext_vector_type(2)));
constexpr float LOG2E = 1.4426950408889634f, C2 = 0.125f * LOG2E;
constexpr int KS = 144, VS = 160, KVB = 64 * KS + 64 * VS;
constexpr int TQ = 64;
constexpr int L_KV = 0, L_OT = 2 * KVB, OT_RS = 528, OT_W = 8 * OT_RS, L_UNI = L_OT + 8 * OT_W;
static_assert(L_UNI + 64 <= 131072, "attention LDS map");
constexpr float NEGF = -1.0e30f;
constexpr int NT_P = BATCH * NKV * (SEQ / TQ), NT_S = DECB * NKV;

__device__ __forceinline__ s16x4 vtr(const LAS unsigned char* p) { return __builtin_bit_cast(s16x4, __builtin_amdgcn_ds_read_tr16_b64_v4i16((LAS v4i16_t*)p)); }
__device__ __forceinline__ bf16x8 cvt8(const f32x4 a, const f32x4 b) { v4u o; o.x = pk2(a[0], a[1]); o.y = pk2(a[2], a[3]); o.z = pk2(b[0], b[1]); o.w = pk2(b[2], b[3]); return __builtin_bit_cast(bf16x8, o); }

struct TileCtx {
    int b, g, t0;
    size_t rowbase;
    size_t sn0;
};

template <int KIND> __device__ __forceinline__ void stage_load(const Params& p, const TileCtx& c, const bf16* kvb, int kb, int boff, bf16x8& kr, bf16x8& vr, int tid) {
    const int key = tid >> 3, chn = tid & 7;
    if constexpr (KIND == 0) {
        const bf16* s = kvb + ((size_t)c.b * SEQ + kb * 64 + key) * NKVC + boff + c.g * 128 + 8 * chn;
        kr = *(const bf16x8*)s; vr = *(const bf16x8*)(s + 64);
    } else {
        const float* s;
        if constexpr (KIND == 1) s = p.ws + W_COMP + ((c.sn0 + kb * 64 + key) * NKV + c.g) * 128;
        else if constexpr (KIND == 2) { const int pos = kb * 64 + key;
            if (pos < PAST) { const int pg = ((const int*)p.in[I_PT])[c.b * NPAGES + (pos >> 7)]; s = p.in[I_CSEL] + ((size_t)pg * PAGE + (pos & 127)) * KVG + c.g * 128; }
            else { int r = pos - PAST; r = r > DSEQ - 1 ? DSEQ - 1 : r; s = p.ws + W_KV + ((size_t)MP + c.b * DSEQ + r) * NKVC + KVG + c.g * 128; } }
        else { int j = kb * 64 + key; j = j > WIN + DSEQ - 1 ? WIN + DSEQ - 1 : j;
            if (j < WIN) s = p.in[I_SWIN] + ((size_t)c.b * WIN + j) * KVG + c.g * 128;
            else s = p.ws + W_KV + ((size_t)MP + c.b * DSEQ + (j - WIN)) * NKVC + 2 * KVG + c.g * 128; }
        const f32x4 k0 = *(const f32x4*)(s + 8 * chn), k1 = *(const f32x4*)(s + 8 * chn + 4), v0 = *(const f32x4*)(s + 64 + 8 * chn), v1 = *(const f32x4*)(s + 64 + 8 * chn + 4);
        kr = cvt8(k0, k1); vr = cvt8(v0, v1);
    }
}
__device__ __forceinline__ void stage_write(LAS unsigned char* buf, const bf16x8 kr, const bf16x8 vr, int tid) {
    const int key = tid >> 3, chn = tid & 7;
    *(LAS bf16x8*)(buf + key * KS + chn * 16) = kr; *(LAS bf16x8*)(buf + 64 * KS + key * VS + chn * 16) = vr;
}

__device__ __forceinline__ void qk_block(const LAS unsigned char* buf, const bf16x8 (&qf)[2][2], f32x4 (&s)[4][2], int l15, int qd) {
#pragma unroll
    for (int kt = 0; kt < 4; ++kt)
#pragma unroll
        for (int ct = 0; ct < 2; ++ct) s[kt][ct] = (f32x4){0.f, 0.f, 0.f, 0.f};
#pragma unroll
    for (int ks = 0; ks < 2; ++ks) {
        bf16x8 kf[4];
#pragma unroll
        for (int kt = 0; kt < 4; ++kt) kf[kt] = *(const LAS bf16x8*)(buf + (16 * kt + l15) * KS + (32 * ks + 8 * qd) * 2);
#pragma unroll
        for (int kt = 0; kt < 4; ++kt)
#pragma unroll
            for (int ct = 0; ct < 2; ++ct) s[kt][ct] = __builtin_amdgcn_mfma_f32_16x16x32_bf16(kf[kt], qf[ct][ks], s[kt][ct], 0, 0, 0);
    }
}
__device__ __forceinline__ void pv_block(const LAS unsigned char* buf, const bf16x8 (&pf)[2][2], f32x4 (&O)[4][2], int l15, int qd) {
    const LAS unsigned char* vb = buf + 64 * KS + (4 * qd + (l15 >> 2)) * VS + (l15 & 3) * 8;
#pragma unroll
    for (int kk = 0; kk < 2; ++kk)
#pragma unroll
        for (int dt = 0; dt < 4; ++dt) {
            const s16x4 lo = vtr(vb + (32 * kk) * VS + dt * 32), hi = vtr(vb + (32 * kk + 16) * VS + dt * 32);
            const bf16x8 vf = (bf16x8){lo[0], lo[1], lo[2], lo[3], hi[0], hi[1], hi[2], hi[3]};
#pragma unroll
            for (int ct = 0; ct < 2; ++ct) O[dt][ct] = __builtin_amdgcn_mfma_f32_16x16x32_bf16(vf, pf[ct][kk], O[dt][ct], 0, 0, 0);
        }
}

template <int BR> __device__ __forceinline__ void online_step(const LAS unsigned char* buf, const bf16x8 (&qf)[2][2], f32x4 (&O)[4][2], float (&m)[2], float (&l)[2],
                                                              const float (&sl2)[2], int t, int pos0, bool lane_on, int l15, int qd) {
    f32x4 s[4][2];
    qk_block(buf, qf, s, l15, qd);
    bf16x8 pf[2][2];
#pragma unroll
    for (int ct = 0; ct < 2; ++ct) {
        float mloc = NEGF;
#pragma unroll
        for (int kt = 0; kt < 4; ++kt)
#pragma unroll
            for (int r = 0; r < 4; ++r) { const int dist = t - (pos0 + 16 * kt + 4 * qd + r);
                const bool ok = lane_on && dist >= 0 && (BR == 2 ? dist <= WIN : true);
                const float v = ok ? s[kt][ct][r] - sl2[ct] * (float)dist : NEGF; s[kt][ct][r] = v; mloc = fmaxf(mloc, v); }
        mloc = fmaxf(mloc, __shfl_xor(mloc, 16)); mloc = fmaxf(mloc, __shfl_xor(mloc, 32));
        const float mn = fmaxf(m[ct], mloc), alpha = __builtin_amdgcn_exp2f(m[ct] - mn);
        m[ct] = mn; float ls = 0.f;
#pragma unroll
        for (int kt = 0; kt < 4; ++kt)
#pragma unroll
            for (int r = 0; r < 4; ++r) { const float v = s[kt][ct][r]; const float pe = v > -1.0e29f ? __builtin_amdgcn_exp2f(v - mn) : 0.f; s[kt][ct][r] = pe; ls += pe; }
        l[ct] = l[ct] * alpha + ls;
#pragma unroll
        for (int dt = 0; dt < 4; ++dt) O[dt][ct] *= alpha;
        pf[ct][0] = cvt8(s[0][ct], s[1][ct]); pf[ct][1] = cvt8(s[2][ct], s[3][ct]);
    }
    pv_block(buf, pf, O, l15, qd);
}

template <bool ACC> __device__ __forceinline__ void ot_merge(LAS unsigned char* ot, const f32x4 (&O)[4][2], const float (&sc)[2], int l15, int qd) {
    const int hs = l15 >> 3, tq8 = l15 & 7;
#pragma unroll
    for (int ct = 0; ct < 2; ++ct)
#pragma unroll
        for (int dt = 0; dt < 4; ++dt) { LAS v2u* q = (LAS v2u*)(ot + tq8 * OT_RS + ((2 * ct + hs) * 64 + 16 * dt + 4 * qd) * 2);
            f32x4 v = O[dt][ct] * sc[ct];
            if (ACC) { const v2u o = *q; v[0] += __uint_as_float(o.x << 16); v[1] += __uint_as_float(o.x & 0xffff0000u); v[2] += __uint_as_float(o.y << 16); v[3] += __uint_as_float(o.y & 0xffff0000u); }
            *q = (v2u){pk2(v[0], v[1]), pk2(v[2], v[3])}; }
}

template <bool SAMP> __device__ __forceinline__ void attn_tile(const Params& p, LAS unsigned char* L, const TileCtx& c, const bf16* qb, const bf16* kvb) {
    const int tid = opaque_tid(), wave = __builtin_amdgcn_readfirstlane(tid >> 6), lane = tid & 63, l15 = lane & 15, qd = lane >> 4;
    const int hs = l15 >> 3, tq8 = l15 & 7;
    const bool wave_on = SAMP ? (wave == 0) : true;
    const int tq = SAMP ? tq8 : 8 * wave + tq8;
    const int t = c.t0 + tq;
    const size_t qrow = c.rowbase + tq;
    const float* u = p.ws + W_U;
    LAS unsigned char* ot = L + L_OT + wave * OT_W;
    LAS unsigned* uni = (LAS unsigned*)(L + L_UNI);
    if (tid < 4) uni[tid] = 0u;
    bf16x8 qf[2][2]; float sl2[2];
#pragma unroll
    for (int ct = 0; ct < 2; ++ct) { const int H = c.g * 4 + 2 * ct + hs;
#pragma unroll
        for (int ks = 0; ks < 2; ++ks) qf[ct][ks] = *(const bf16x8*)(qb + qrow * 1024 + H * 64 + 32 * ks + 8 * qd);
        sl2[ct] = exp2f(-8.0f * (float)(H + 1) / (float)NH) * LOG2E; }
    auto gate = [&](int ct, int x) -> float { const int H = c.g * 4 + 2 * ct + hs; return 1.0f / (1.0f + __expf(-(u[qrow * NU + 2 * D + H * 3 + x] + p.in[I_BGATE][H * 3 + x]))); };
    f32x4 O[4][2]; float m[2], l[2];
    LAS unsigned char* buf0 = L + L_KV; LAS unsigned char* buf1 = L + L_KV + KVB;
    { bf16x8 kr, vr; stage_load<1>(p, c, kvb, 0, 0, kr, vr, tid); stage_write(buf0, kr, vr, tid); stage_load<1>(p, c, kvb, 1, 0, kr, vr, tid); stage_write(buf1, kr, vr, tid); }
    __syncthreads();
    unsigned long long selLo = 0ull, selHi = 0ull;
#define AT_SETBIT(n) do { const int _n = (n); if (_n < 64) selLo |= 1ull << _n; else selHi |= 1ull << (_n - 64); } while (0)
    const int cb = t >> 6;
    if (wave_on) {
        const int nvalid = (t + 1) >> 6;
#pragma unroll
        for (int ct = 0; ct < 2; ++ct) { m[ct] = NEGF; l[ct] = 0.f; }
#pragma unroll
        for (int kb = 0; kb < 2; ++kb) { f32x4 s[4][2]; qk_block(kb ? buf1 : buf0, qf, s, l15, qd);
#pragma unroll
            for (int ct = 0; ct < 2; ++ct) { float mloc = NEGF;
#pragma unroll
                for (int kt = 0; kt < 4; ++kt)
#pragma unroll
                    for (int r = 0; r < 4; ++r) { const int n = 64 * kb + 16 * kt + 4 * qd + r; const bool ok = n < nvalid;
                        const float v = ok ? s[kt][ct][r] - sl2[ct] * (float)(t - (64 * n + 63)) : NEGF; s[kt][ct][r] = v; mloc = fmaxf(mloc, v); }
                mloc = fmaxf(mloc, __shfl_xor(mloc, 16)); mloc = fmaxf(mloc, __shfl_xor(mloc, 32));
                const float mn = fmaxf(m[ct], mloc); float ls = 0.f;
#pragma unroll
                for (int kt = 0; kt < 4; ++kt)
#pragma unroll
                    for (int r = 0; r < 4; ++r) { const float v = s[kt][ct][r]; ls += v > -1.0e29f ? __builtin_amdgcn_exp2f(v - mn) : 0.f; }
                l[ct] = l[ct] * __builtin_amdgcn_exp2f(m[ct] - mn) + ls; m[ct] = mn; } }
        float rl[2];
#pragma unroll
        for (int ct = 0; ct < 2; ++ct) { float ls = l[ct]; ls += __shfl_xor(ls, 16); ls += __shfl_xor(ls, 32); rl[ct] = ls > 0.f ? 1.0f / ls : 0.f; }
        float imp[2][4][4];
#pragma unroll
        for (int kb = 0; kb < 2; ++kb) { f32x4 s[4][2]; qk_block(kb ? buf1 : buf0, qf, s, l15, qd);
#pragma unroll
            for (int kt = 0; kt < 4; ++kt)
#pragma unroll
                for (int r = 0; r < 4; ++r) { const int n = 64 * kb + 16 * kt + 4 * qd + r; const bool ok = n < nvalid; const float dist = (float)(t - (64 * n + 63));
                    const float p0 = ok ? __builtin_amdgcn_exp2f(s[kt][0][r] - sl2[0] * dist - m[0]) * rl[0] : 0.f;
                    const float p1 = ok ? __builtin_amdgcn_exp2f(s[kt][1][r] - sl2[1] * dist - m[1]) * rl[1] : 0.f;
                    const float ps = p0 + p1; imp[kb][kt][r] = ps + __shfl_xor(ps, 8); } }
        int npick;
        if (SAMP) { selLo |= 1ull; selHi |= 1ull << 63; npick = NSEL - 3; }
        else { selLo |= 1ull; AT_SETBIT(cb); if (cb >= 1) AT_SETBIT(cb - 1); npick = NSEL - (cb == 0 ? 1 : (cb == 1 ? 2 : 3)); }
#pragma unroll
        for (int kb = 0; kb < 2; ++kb)
#pragma unroll
            for (int kt = 0; kt < 4; ++kt)
#pragma unroll
                for (int r = 0; r < 4; ++r) { const int n = 64 * kb + 16 * kt + 4 * qd + r;
                    const bool excl = (n == 0) || (n == cb) || (n == cb - 1) || (n > cb); if (excl) imp[kb][kt][r] = -2.f; }
        for (int it = 0; it < NSEL - 1; ++it) {
            float bv = -2.f; int bn = 1 << 20;
#pragma unroll
            for (int kb = 0; kb < 2; ++kb)
#pragma unroll
                for (int kt = 0; kt < 4; ++kt)
#pragma unroll
                    for (int r = 0; r < 4; ++r) { const int n = 64 * kb + 16 * kt + 4 * qd + r; const float v = imp[kb][kt][r]; if (v > bv) { bv = v; bn = n; } }
#pragma unroll
            for (int sh = 16; sh <= 32; sh <<= 1) { const float ov = __shfl_xor(bv, sh); const int on = __shfl_xor(bn, sh); if (ov > bv || (ov == bv && on < bn)) { bv = ov; bn = on; } }
            const bool take = it < npick && bv >= 0.f;
            if (take) AT_SETBIT(bn & 127);
#pragma unroll
            for (int kb = 0; kb < 2; ++kb)
#pragma unroll
                for (int kt = 0; kt < 4; ++kt)
#pragma unroll
                    for (int r = 0; r < 4; ++r) { const int n = 64 * kb + 16 * kt + 4 * qd + r; if (n == bn) imp[kb][kt][r] = -2.f; }
        }
        if (qd == 0 && hs == 0) { __hip_atomic_fetch_or(uni + 0, (unsigned)selLo, __ATOMIC_RELAXED, __HIP_MEMORY_SCOPE_WORKGROUP); __hip_atomic_fetch_or(uni + 1, (unsigned)(selLo >> 32), __ATOMIC_RELAXED, __HIP_MEMORY_SCOPE_WORKGROUP);
            __hip_atomic_fetch_or(uni + 2, (unsigned)selHi, __ATOMIC_RELAXED, __HIP_MEMORY_SCOPE_WORKGROUP); __hip_atomic_fetch_or(uni + 3, (unsigned)(selHi >> 32), __ATOMIC_RELAXED, __HIP_MEMORY_SCOPE_WORKGROUP); }
        {
#pragma unroll
            for (int ct = 0; ct < 2; ++ct) rl[ct] *= gate(ct, 0);
#pragma unroll
            for (int dt = 0; dt < 4; ++dt)
#pragma unroll
                for (int ct = 0; ct < 2; ++ct) O[dt][ct] = (f32x4){0.f, 0.f, 0.f, 0.f};
#pragma unroll
            for (int kb = 0; kb < 2; ++kb) { f32x4 s[4][2]; qk_block(kb ? buf1 : buf0, qf, s, l15, qd); bf16x8 pf[2][2];
#pragma unroll
                for (int ct = 0; ct < 2; ++ct) {
#pragma unroll
                    for (int kt = 0; kt < 4; ++kt)
#pragma unroll
                        for (int r = 0; r < 4; ++r) { const int n = 64 * kb + 16 * kt + 4 * qd + r; const bool ok = n < nvalid;
                            s[kt][ct][r] = ok ? __builtin_amdgcn_exp2f(s[kt][ct][r] - sl2[ct] * (float)(t - (64 * n + 63)) - m[ct]) * rl[ct] : 0.f; }
                    pf[ct][0] = cvt8(s[0][ct], s[1][ct]); pf[ct][1] = cvt8(s[2][ct], s[3][ct]); }
                pv_block(kb ? buf1 : buf0, pf, O, l15, qd); }
            const float one[2] = {1.f, 1.f}; ot_merge<false>(ot, O, one, l15, qd);
        }
    }
    __syncthreads();
    const unsigned long long unLo = ((unsigned long long)__builtin_amdgcn_readfirstlane(uni[1]) << 32) | (unsigned)__builtin_amdgcn_readfirstlane(uni[0]);
    const unsigned long long unHi = ((unsigned long long)__builtin_amdgcn_readfirstlane(uni[3]) << 32) | (unsigned)__builtin_amdgcn_readfirstlane(uni[2]);
#pragma unroll
    for (int ct = 0; ct < 2; ++ct) { m[ct] = NEGF; l[ct] = 0.f; }
#pragma unroll
    for (int dt = 0; dt < 4; ++dt)
#pragma unroll
        for (int ct = 0; ct < 2; ++ct) O[dt][ct] = (f32x4){0.f, 0.f, 0.f, 0.f};
    {
        auto next_bit = [&](int from) -> int {
            if (from < 64) { const unsigned long long x = unLo & (~0ull << from); if (x) return __builtin_ctzll(x); }
            const unsigned long long y = from <= 64 ? unHi : (from < 128 ? unHi & (~0ull << (from - 64)) : 0ull);
            return y ? 64 + __builtin_ctzll(y) : 128; };
        int cur = next_bit(0), pb = 0;
        const int last = SAMP ? 129 : 128;
        bf16x8 kr, vr;
        if (cur < last) { stage_load<SAMP ? 2 : 0>(p, c, kvb, cur, KVG, kr, vr, tid); stage_write(buf0, kr, vr, tid); }
        __syncthreads();
        while (cur < last) {
            int nxt = cur < 128 ? next_bit(cur + 1) : 129;
            if (!SAMP && nxt == 128) nxt = 129;
            const bool has_next = nxt <= 128;
            if (has_next) stage_load<SAMP ? 2 : 0>(p, c, kvb, nxt, KVG, kr, vr, tid);
            if (wave_on) {
                const bool bit = cur >= 128 ? true : (((cur < 64 ? selLo >> cur : selHi >> (cur - 64)) & 1ull) != 0ull);
                if (__builtin_amdgcn_ballot_w64(bit) != 0ull) online_step<1>(pb ? buf1 : buf0, qf, O, m, l, sl2, t, cur * 64, bit, l15, qd);
            }
            if (has_next) stage_write(pb ? buf0 : buf1, kr, vr, tid);
            __syncthreads();
            pb ^= 1; cur = has_next ? nxt : last;
        }
    }
    if (wave_on) { float sc[2];
#pragma unroll
        for (int ct = 0; ct < 2; ++ct) { float ls = l[ct]; ls += __shfl_xor(ls, 16); ls += __shfl_xor(ls, 32); sc[ct] = ls > 0.f ? gate(ct, 1) / ls : 0.f; }
        ot_merge<true>(ot, O, sc, l15, qd); }
#pragma unroll
    for (int ct = 0; ct < 2; ++ct) { m[ct] = NEGF; l[ct] = 0.f; }
#pragma unroll
    for (int dt = 0; dt < 4; ++dt)
#pragma unroll
        for (int ct = 0; ct < 2; ++ct) O[dt][ct] = (f32x4){0.f, 0.f, 0.f, 0.f};
    {
        const int kb0 = SAMP ? 0 : (c.t0 >= WIN ? (c.t0 - WIN) >> 6 : 0), kb1 = SAMP ? (WIN + DSEQ - 1) >> 6 : (c.t0 + TQ - 1) >> 6;
        const int wpos0 = SAMP ? PAST - WIN : 0;
        bf16x8 kr, vr; int pb = 0;
        stage_load<SAMP ? 3 : 0>(p, c, kvb, kb0, 2 * KVG, kr, vr, tid); stage_write(buf0, kr, vr, tid);
        __syncthreads();
        for (int kb = kb0; kb <= kb1; ++kb) {
            if (kb < kb1) stage_load<SAMP ? 3 : 0>(p, c, kvb, kb + 1, 2 * KVG, kr, vr, tid);
            if (wave_on) {
                const int pos0 = wpos0 + kb * 64;
                const int tlo = c.t0 + (SAMP ? 0 : 8 * wave), thi = tlo + 7;
                if (pos0 <= thi && pos0 + 63 >= tlo - WIN) online_step<2>(pb ? buf1 : buf0, qf, O, m, l, sl2, t, pos0, true, l15, qd);
            }
            if (kb < kb1) stage_write(pb ? buf0 : buf1, kr, vr, tid);
            __syncthreads();
            pb ^= 1;
        }
    }
    if (wave_on) { float sc[2];
#pragma unroll
        for (int ct = 0; ct < 2; ++ct) { float ls = l[ct]; ls += __shfl_xor(ls, 16); ls += __shfl_xor(ls, 32); sc[ct] = ls > 0.f ? gate(ct, 2) / ls : 0.f; }
        ot_merge<true>(ot, O, sc, l15, qd);
        asm volatile("s_waitcnt lgkmcnt(0)" ::: "memory");
        bf16* oA = (bf16*)(p.ws + W_BFA);
#pragma unroll
        for (int i = 0; i < 4; ++i) { const int it = lane + 64 * i; const int rr = it >> 5, ch = it & 31;
            const v4u ov = *(const LAS v4u*)(ot + rr * OT_RS + ch * 16);
            const size_t grow = c.rowbase + (SAMP ? rr : 8 * wave + rr); const int col = c.g * 256 + ch * 8;
            const float* zp = u + grow * NU + D + col; const f32x4 z0 = *(const f32x4*)zp, z1 = *(const f32x4*)(zp + 4);
            float o[8] = {__uint_as_float(ov.x << 16), __uint_as_float(ov.x & 0xffff0000u), __uint_as_float(ov.y << 16), __uint_as_float(ov.y & 0xffff0000u),
                          __uint_as_float(ov.z << 16), __uint_as_float(ov.z & 0xffff0000u), __uint_as_float(ov.w << 16), __uint_as_float(ov.w & 0xffff0000u)};
            const float zz[8] = {z0[0], z0[1], z0[2], z0[3], z1[0], z1[1], z1[2], z1[3]};
#pragma unroll
            for (int e = 0; e < 8; ++e) o[e] *= zz[e] / (1.0f + __expf(-zz[e]));
            v4u w; w.x = pk2(o[0], o[1]); w.y = pk2(o[2], o[3]); w.z = pk2(o[4], o[5]); w.w = pk2(o[6], o[7]);
            *(GAS v4u*)(oA + grow * 1024 + col) = w; }
    }
    __syncthreads();
#undef AT_SETBIT
}

__device__ __forceinline__ void attn_prep(const Params& p, bf16* qb, bf16* kvb, long gtid, long gsz) {
    const float* u = p.ws + W_U; const float* kv = p.ws + W_KV;
    for (long it = gtid; it < (long)M * 128; it += gsz) { const long row = it >> 7; const int c8 = (int)(it & 127) * 8;
        const f32x4 a = *(const f32x4*)(u + row * NU + c8), b = *(const f32x4*)(u + row * NU + c8 + 4);
        *(GAS v4u*)(qb + row * 1024 + c8) = __builtin_bit_cast(v4u, cvt8(a * C2, b * C2)); }
    for (long it = gtid; it < (long)M * 192; it += gsz) { const long row = it / 192; const int c8 = (int)(it % 192) * 8;
        const f32x4 a = *(const f32x4*)(kv + row * NKVC + c8), b = *(const f32x4*)(kv + row * NKVC + c8 + 4);
        *(GAS v4u*)(kvb + row * NKVC + c8) = __builtin_bit_cast(v4u, cvt8(a, b)); }
}

__device__ __forceinline__ void attn_phase(const Params& p, LAS unsigned char* L, const bf16* qb, const bf16* kvb) {
    const int G = gridDim.x, k = blockIdx.x;
    for (int r = 0; r * G < NT_P; ++r) {
        const int cnt = NT_P - r * G < G ? NT_P - r * G : G;
        if (k >= cnt) break;
        const int T = r * G + ((r & 1) ? cnt - 1 - k : k);
        TileCtx c; const int bg = T / (SEQ / TQ), qblk = T % (SEQ / TQ);
        c.b = bg / NKV; c.g = bg % NKV; c.t0 = qblk * TQ; c.rowbase = (size_t)c.b * SEQ + c.t0; c.sn0 = (size_t)c.b * NCP;
        attn_tile<false>(p, L, c, qb, kvb);
    }
    for (int T = k; T < NT_S; T += G) {
        TileCtx c; c.b = T / NKV; c.g = T % NKV; c.t0 = PAST; c.rowbase = (size_t)MP + (size_t)c.b * DSEQ; c.sn0 = (size_t)BATCH * NCP + (size_t)c.b * NCS;
        attn_tile<true>(p, L, c, qb, kvb);
    }
}
}

namespace cp {
using namespace nv;
typedef short bf16x8 __attribute__((ext_vector_type(8)));
constexpr int AS = 144, HS = 272;
constexpr int L_A = 0, A_BUF = 2 * 64 * AS, L_H = 2 * A_BUF, L_END = L_H + 2 * 64 * HS;
static_assert(L_END <= 131072 && NCS * CMPB <= PAST, "compress geometry");

template <int NB>
__device__ __forceinline__ void comp_unit(const Params& p, LAS unsigned char* L, int sn_first, const bf16* w1t, const bf16* w2t, const float* bias1, int tid) {
    constexpr int RT = NB / 4, TPB = 512 / NB, NV4 = NB / 4;
    const int wave = __builtin_amdgcn_readfirstlane(tid >> 6), lane = tid & 63, l15 = lane & 15, qd = lane >> 4;
    const int c = wave >> 2, pq = wave & 3;
    const int blk = tid / TPB, ck = tid % TPB, eo = ck * NB;
    const int sg = eo >> 7, sc = (eo >> 6) & 1, sd0 = eo & 63;
    const float* src; size_t tstride;
    { const int sn = sn_first + blk;
      if (sn < BATCH * NCP) { const int b = sn / NCP, n = sn % NCP; src = p.ws + W_KV + ((size_t)b * SEQ + (size_t)n * CMPB) * NKVC + eo; tstride = NKVC; }
      else { const int r = sn - BATCH * NCP, bs = r / NCS, n = r % NCS, pos0 = n * CMPB; const int pg = ((const int*)p.in[I_PT])[bs * NPAGES + (pos0 >> 7)];
             src = p.in[I_CCMP] + ((size_t)pg * PAGE + (pos0 & 127)) * KVG + eo; tstride = KVG; } }
    const unsigned dstoff = (unsigned)((sc * 64 + blk * 4 + sg) * AS + sd0 * 2);
    f32x4 ra[NV4], rb[NV4];
    auto ld = [&](f32x4 (&r)[NV4], int l) {
#pragma unroll
        for (int i = 0; i < NV4; ++i) r[i] = *(const f32x4*)(src + (size_t)l * tstride + 4 * i); };
    auto st = [&](const f32x4 (&r)[NV4], int buf) {
        LAS unsigned char* d = L + L_A + buf * A_BUF + dstoff;
        if constexpr (NB == 16) { *(LAS bf16x8*)d = at::cvt8(r[0], r[1]); *(LAS bf16x8*)(d + 16) = at::cvt8(r[2], r[3]); }
        else { *(LAS at::v2u*)d = (at::v2u){pk2(r[0][0], r[0][1]), pk2(r[0][2], r[0][3])}; } };
    const bf16* wb = w1t + (((size_t)c * 64) * 128 + 32 * pq + l15) * 64 + 8 * qd;
    auto ldb = [&](bf16x8 (&b)[2][2], int l) {
#pragma unroll
        for (int ct = 0; ct < 2; ++ct)
#pragma unroll
            for (int ks = 0; ks < 2; ++ks) b[ct][ks] = *(const bf16x8*)(wb + ((size_t)l * 128 + 16 * ct) * 64 + 32 * ks); };
    f32x4 acc[RT][2];
#pragma unroll
    for (int rt = 0; rt < RT; ++rt)
#pragma unroll
        for (int ct = 0; ct < 2; ++ct) acc[rt][ct] = (f32x4){0.f, 0.f, 0.f, 0.f};
    auto compute = [&](int buf, const bf16x8 (&b)[2][2]) {
        const LAS unsigned char* a0 = L + L_A + buf * A_BUF + (c * 64 + l15) * AS + 16 * qd;
#pragma unroll
        for (int ks = 0; ks < 2; ++ks)
#pragma unroll
            for (int rt = 0; rt < RT; ++rt) { const bf16x8 a = *(const LAS bf16x8*)(a0 + 16 * rt * AS + 64 * ks);
#pragma unroll
                for (int ct = 0; ct < 2; ++ct) acc[rt][ct] = __builtin_amdgcn_mfma_f32_16x16x32_bf16(a, b[ct][ks], acc[rt][ct], 0, 0, 0); } };
    bf16x8 b0[2][2], b1[2][2];
    ld(ra, 0); ld(rb, 1); ldb(b0, 0);
    st(ra, 0);
    __syncthreads();
    for (int l = 0; l < CMPB; l += 2) {
        if (l + 2 < CMPB) ld(ra, l + 2);
        ldb(b1, l + 1);
        compute(0, b0);
        st(rb, 1);
        __syncthreads();
        if (l + 3 < CMPB) ld(rb, l + 3);
        if (l + 2 < CMPB) ldb(b0, l + 2);
        compute(1, b1);
        if (l + 2 < CMPB) st(ra, 0);
        __syncthreads();
    }
    {
        LAS unsigned short* H = (LAS unsigned short*)(L + L_H);
#pragma unroll
        for (int ct = 0; ct < 2; ++ct) { const int pp = 32 * pq + 16 * ct + l15; const float bz = bias1[c * DPHI + pp];
#pragma unroll
            for (int rt = 0; rt < RT; ++rt)
#pragma unroll
                for (int r = 0; r < 4; ++r) { const float x = acc[rt][ct][r] + bz; const float hv = x / (1.0f + __expf(-x));
                    H[((c * 64 + 16 * rt + 4 * qd + r) * HS) / 2 + pp] = (unsigned short)f2bf(hv); } }
    }
    __syncthreads();
    {
        f32x4 o2[RT];
#pragma unroll
        for (int rt = 0; rt < RT; ++rt) o2[rt] = (f32x4){0.f, 0.f, 0.f, 0.f};
        const bf16* w2 = w2t + ((size_t)(c * 64 + 16 * pq + l15)) * 128 + 8 * qd;
#pragma unroll
        for (int ks = 0; ks < 4; ++ks) { const bf16x8 b = *(const bf16x8*)(w2 + 32 * ks);
#pragma unroll
            for (int rt = 0; rt < RT; ++rt) { const bf16x8 a = *(const LAS bf16x8*)(L + L_H + (c * 64 + 16 * rt + l15) * HS + (32 * ks + 8 * qd) * 2);
                o2[rt] = __builtin_amdgcn_mfma_f32_16x16x32_bf16(a, b, o2[rt], 0, 0, 0); } }
        const int dd = 16 * pq + l15; const float b2 = p.in[I_BPHI2][c * HD + dd];
        float* comp = p.ws + W_COMP;
#pragma unroll
        for (int rt = 0; rt < RT; ++rt)
#pragma unroll
            for (int r = 0; r < 4; ++r) { const int row = 16 * rt + 4 * qd + r; const int sn = sn_first + (row >> 2), g = row & 3;
                comp[((size_t)sn * NKV + g) * 128 + c * HD + dd] = o2[rt][r] + b2; }
    }
    __syncthreads();
}

__device__ __forceinline__ void comp_bias(const Params& p, float* bias1, int gw, int ngw, int lane) {
    for (int o = gw; o < 2 * DPHI; o += ngw) { const int c = o / DPHI, pp = o % DPHI; float s = 0.f;
        for (int i = lane; i < CMPB * HD; i += 64) { const int l = i >> 6, d = i & 63; s += p.in[I_PE][((size_t)l * 2 + c) * HD + d] * p.in[I_WPHI1][(((size_t)c * CMPB + l) * HD + d) * DPHI + pp]; }
#pragma unroll
        for (int sh = 1; sh < 64; sh <<= 1) s += __shfl_xor(s, sh);
        if (lane == 0) bias1[o] = s + p.in[I_BPHI1][o]; }
}
}

constexpr int NTHREADS = 512, NWAVES = 8;
constexpr int LDS_BYTES = 147456;
constexpr int RING_OFF = 0;
constexpr int MISC_OFF = 131072 + 320;
constexpr int NKVIN = 3840;
constexpr long W_WT_INA = nv::W_END2, W_WT_OUTA = W_WT_INA + 2048L * 1024 / 2, W_WT_KVIN = W_WT_OUTA + 1024L * 1024 / 2,
    W_WT_OUTB = W_WT_KVIN + (long)NKVIN * 1024 / 2, W_AGG = W_WT_OUTB + 1024L * 1024 / 2, W_W1T = W_AGG + 2L * nv::BATCH * (nv::SEQ / 128) * 1024, W_W2T = W_W1T + 2L * 64 * 128 * 64 / 2,
    W_B1 = W_W2T + 2L * 64 * 128 / 2, W_FAST_END = W_B1 + 256;
constexpr size_t CTL_BYTES = 1u << 20;
constexpr size_t WS_CTL_OFF = ((size_t)W_FAST_END * 4 + 4095) / 4096 * 4096;
constexpr int CW_BAR = 4096;
struct Args { nv::Params p; unsigned char* ctl; };
static_assert(nv::D == 1024 && nv::M % 256 == 0, "fast GEMM path is built for d_model 1024 and M % 256 == 0");

__device__ __forceinline__ void p0_prologue(const nv::Params& p, LAS unsigned char* L, int wave, int lane) {
    LAS float* scr = (LAS float*)(L + RING_OFF + wave * 16384);
    const int gw = blockIdx.x * NWAVES + wave, NGW = gridDim.x * NWAVES;
    bf16* wt_ina = (bf16*)(p.ws + W_WT_INA); bf16* wt_outa = (bf16*)(p.ws + W_WT_OUTA); bf16* wt_kvin = (bf16*)(p.ws + W_WT_KVIN); bf16* wt_outb = (bf16*)(p.ws + W_WT_OUTB);
    constexpr int I_A = 16 * (2048 / 32), I_B = 16 * (1024 / 32), I_C = 16 * (1536 / 32), I_D = 16 * ((nv::NU + 31) / 32), I_E = 16 * (1024 / 32), I_F = 2 * 64 * 4, I_G = 2 * 4;
    bf16* w1t = (bf16*)(p.ws + W_W1T); bf16* w2t = (bf16*)(p.ws + W_W2T);
    for (int it = gw; it < I_A + I_B + I_C + I_D + I_E + I_F + I_G; it += NGW) {
        int r = it;
        if (r < I_A) { wt_transpose_item(p.in[nv::I_WINA], 1024, 2048, wt_ina, 0, scr, r, lane); continue; } r -= I_A;
        if (r < I_B) { wt_transpose_item(p.in[nv::I_WOUTA], 1024, 1024, wt_outa, 0, scr, r, lane); continue; } r -= I_B;
        if (r < I_C) { wt_transpose_item(p.in[nv::I_WKV], 1024, 1536, wt_kvin, 0, scr, r, lane); continue; } r -= I_C;
        if (r < I_D) { wt_transpose_item(p.in[nv::I_WINB], 1024, nv::NU, wt_kvin, 1536, scr, r, lane); continue; } r -= I_D;
        if (r < I_E) { wt_transpose_item(p.in[nv::I_WOUTB], 1024, 1024, wt_outb, 0, scr, r, lane); continue; } r -= I_E;
        if (r < I_F) { const int cl = r >> 2; wt_transpose_item(p.in[nv::I_WPHI1] + (size_t)cl * 64 * 128, 64, 128, w1t + (size_t)cl * 128 * 64, 0, scr, r & 3, lane); continue; } r -= I_F;
        { const int c = r >> 2; wt_transpose_item(p.in[nv::I_WPHI2] + (size_t)c * 128 * 64, 128, 64, w2t + (size_t)c * 64 * 128, 0, scr, r & 3, lane); }
    }
    cp::comp_bias(p, p.ws + W_B1, gw, NGW, lane);
    constexpr int ZR0 = 1536 + ((nv::NU + 31) / 32) * 32;
    for (long i = (long)blockIdx.x * NTHREADS + opaque_tid(); i < (long)(NKVIN - ZR0) * 1024 / 8; i += (long)gridDim.x * NTHREADS)
        ((GAS v4u*)(wt_kvin + (size_t)ZR0 * 1024))[i] = (v4u){0u, 0u, 0u, 0u};
}

__global__ void __launch_bounds__(NTHREADS, 2) mk_fwd(Args args) {
    extern __shared__ __attribute__((aligned(16))) unsigned char lds[];
    LAS unsigned char* L = (LAS unsigned char*)lds;
    volatile LAS unsigned* MISC = (volatile LAS unsigned*)(L + MISC_OFF);
    for (int u = threadIdx.x; u < 32; u += NTHREADS) MISC[u] = 0u;
    __syncthreads();
    XcdBarrier bar = xcd_barrier_post((unsigned*)(args.ctl) + CW_BAR, MISC + 8);
    const long gsz = (long)gridDim.x * NTHREADS;
    const nv::Params& p = args.p;
    const int G = gridDim.x;
#define NAIVE(k) nv::run_phase<k>(p, (long)blockIdx.x * NTHREADS + opaque_tid(), gsz)
#define BAR() xcd_barrier(bar)
    { const int t_ = opaque_tid(); p0_prologue(p, L, __builtin_amdgcn_readfirstlane(t_ >> 6), t_ & 63); } NAIVE(0); BAR();
    NAIVE(1);
    { const int t_ = opaque_tid();
      for (int uu = blockIdx.x; uu < nv::DECB * nv::NCS / 16; uu += G) cp::comp_unit<16>(p, L, nv::BATCH * nv::NCP + uu * 16, (const bf16*)(p.ws + W_W1T), (const bf16*)(p.ws + W_W2T), p.ws + W_B1, t_); }
    BAR();
    {
        pg8::Gemm g{(const pg8::bf16_t*)(p.ws + nv::W_BFA), (const pg8::bf16_t*)(p.ws + W_WT_INA), nv::M, 2048, 1024, (const pg8::bf16_t*)(p.ws + nv::W_BFA), 1 << 30};
        pg8::StaticOrder S; S.init(nv::M, 2048, G, (int)blockIdx.x);
        pg8::EpiF32Split E{p.ws + nv::W_U0, 2048, 2048, nullptr, 0, 0};
        pg8::gemm_phase<pg8::EpiF32Split, pg8::StaticOrder, true, true>(L + RING_OFF, g, S, E);
    }
    BAR();
    rg::rg_pass<1>(p, L, p.ws + W_AGG); BAR();
    rg::rg_pass<2>(p, L, p.ws + W_AGG); BAR();
    {
        pg8::Gemm g{(const pg8::bf16_t*)(p.ws + nv::W_BFA), (const pg8::bf16_t*)(p.ws + W_WT_OUTA), nv::M, 1024, 1024, (const pg8::bf16_t*)(p.ws + nv::W_BFA), 1 << 30};
        pg8::StaticOrder S; S.init(nv::M, 1024, G, (int)blockIdx.x);
        pg8::EpiF32Split E{p.ws + nv::W_F, 1024, 1024, nullptr, 0, 0};
        pg8::gemm_phase<pg8::EpiF32Split, pg8::StaticOrder, true, true>(L + RING_OFF, g, S, E);
    }
    BAR();
    NAIVE(8); BAR();
    NAIVE(10); BAR();
    {
        pg8::Gemm g{(const pg8::bf16_t*)(p.ws + nv::W_BFB), (const pg8::bf16_t*)(p.ws + W_WT_KVIN), nv::M, NKVIN, 1024, (const pg8::bf16_t*)(p.ws + nv::W_BFA), 6};
        pg8::StaticOrder S; S.init(nv::M, NKVIN, G, (int)blockIdx.x);
        pg8::EpiF32Split E{p.ws + nv::W_KV, nv::NKVC, nv::NKVC, p.ws + nv::W_U, nv::NU, nv::NU};
        pg8::gemm_phase<pg8::EpiF32Split, pg8::StaticOrder, true, true>(L + RING_OFF, g, S, E);
    }
    BAR();
    nv::ph_outputs(p, (long)blockIdx.x * NTHREADS + opaque_tid(), gsz); at::attn_prep(p, (bf16*)(p.ws + nv::W_BFB), (bf16*)(p.ws + nv::W_PC), (long)blockIdx.x * NTHREADS + opaque_tid(), gsz);
    { const int t_ = opaque_tid();
      for (int uu = blockIdx.x; uu < nv::BATCH * nv::NCP / 4; uu += G) cp::comp_unit<4>(p, L, uu * 4, (const bf16*)(p.ws + W_W1T), (const bf16*)(p.ws + W_W2T), p.ws + W_B1, t_); }
    BAR();
    at::attn_phase(p, L, (const bf16*)(p.ws + nv::W_BFB), (const bf16*)(p.ws + nv::W_PC)); BAR();
    {
        pg8::Gemm g{(const pg8::bf16_t*)(p.ws + nv::W_BFA), (const pg8::bf16_t*)(p.ws + W_WT_OUTB), nv::M, 1024, 1024, (const pg8::bf16_t*)(p.ws + nv::W_BFA), 1 << 30};
        pg8::StaticOrder S; S.init(nv::M, 1024, G, (int)blockIdx.x);
        pg8::EpiF32Split E{p.ws + nv::W_F, 1024, 1024, nullptr, 0, 0};
        pg8::gemm_phase<pg8::EpiF32Split, pg8::StaticOrder, true, true>(L + RING_OFF, g, S, E);
    }
    BAR();
    NAIVE(20);
#undef NAIVE
#undef BAR
}

extern "C" void kernel_launch(void* const* d_in, const int* in_sizes, int n_in,
                              void* d_out, int out_size, void* d_ws, size_t ws_size,
                              hipStream_t stream) {
    static int grid = 0;
    if (grid == 0) {
        if (n_in != nv::I_N || out_size != (int)nv::O_END || ws_size < WS_CTL_OFF + CTL_BYTES) { fprintf(stderr, "kernel_launch: unexpected sizes n_in %d out %d ws %zu\n", n_in, out_size, ws_size); grid = -1; return; }
        int dev = 0, cus = 0, per_cu = 0;
        if (hipGetDevice(&dev) != hipSuccess || hipDeviceGetAttribute(&cus, hipDeviceAttributeMultiprocessorCount, dev) != hipSuccess) { grid = -1; return; }
        if (hipFuncSetAttribute((const void*)mk_fwd, hipFuncAttributeMaxDynamicSharedMemorySize, LDS_BYTES) != hipSuccess) { fprintf(stderr, "kernel_launch: hipFuncSetAttribute failed\n"); grid = -1; return; }
        if (hipOccupancyMaxActiveBlocksPerMultiprocessor(&per_cu, (const void*)mk_fwd, NTHREADS, LDS_BYTES) != hipSuccess || per_cu < 1) fprintf(stderr, "kernel_launch: occupancy query reports %d\n", per_cu);
        (void)hipGetLastError();
        grid = cus;
    }
    if (grid < 0) return;
    unsigned char* ctl = (unsigned char*)d_ws + WS_CTL_OFF;
    if (hipMemsetAsync(ctl, 0, CTL_BYTES, stream) != hipSuccess) return;
    Args a{};
    for (int i = 0; i < nv::I_N; ++i) a.p.in[i] = (const float*)d_in[i];
    a.p.out = (float*)d_out; a.p.ws = (float*)d_ws; a.ctl = ctl;
    hipLaunchKernelGGL(mk_fwd, dim3(grid), dim3(NTHREADS), LDS_BYTES, stream, a);
}
```

```cpp
#include <hip/hip_runtime.h>
#include <cstdio>
#include <cstdint>
#ifndef CFG_D
#define CFG_D 1024
#define CFG_BATCH 2
#define CFG_SEQ 8192
#define CFG_DECB 32
#define CFG_PAST 8192
#define CFG_NRG 8
#define CFG_NH 16
#define CFG_NKV 4
#endif
namespace nv {
constexpr int D = CFG_D, BATCH = CFG_BATCH, SEQ = CFG_SEQ, DECB = CFG_DECB, DSEQ = 8, PAST = CFG_PAST, PAGE = 128;
constexpr int NRG = CFG_NRG, RGB = D / NRG, NH = CFG_NH, HD = 64, NKV = CFG_NKV, HPG = NH / NKV;
static_assert(D == NH * HD && HPG == 4, "geometry");
constexpr int CMPB = 64, NSEL = 16, WIN = 512, DPHI = 128;
constexpr int MP = BATCH * SEQ, MS = DECB * DSEQ, M = MP + MS, NC = BATCH + DECB;
constexpr int NKVC = 3 * NKV * 2 * HD;
constexpr int KVG = NKV * 2 * HD;
constexpr int NU = 2 * D + 3 * NH;
constexpr int NCP = SEQ / CMPB, NCS = (PAST + DSEQ) / CMPB, NSBS = (PAST + DSEQ + CMPB - 1) / CMPB;
constexpr int NSBMAX = ((NCP > NSBS ? NCP : NSBS) + 7) / 8 * 8;
constexpr int NPAGES = PAST / PAGE;
constexpr int NSEQN = BATCH * NCP + DECB * NCS;
constexpr float ALPHA = 1.4142135623730951f;
constexpr float LN_EPS = 1e-5f;
static_assert(PAST >= WIN && SEQ >= WIN, "window geometry");

constexpr long O_YP = 0, O_YS = O_YP + (long)MP * D, O_CMPP = O_YS + (long)MS * D, O_SELP = O_CMPP + (long)MP * KVG,
    O_WINP = O_SELP + (long)MP * KVG, O_HP = O_WINP + (long)BATCH * WIN * KVG, O_CONVP = O_HP + (long)BATCH * D,
    O_CMPS = O_CONVP + (long)BATCH * 3 * D, O_SELS = O_CMPS + (long)MS * KVG, O_WINS = O_SELS + (long)MS * KVG,
    O_HS = O_WINS + (long)DECB * WIN * KVG, O_CONVS = O_HS + (long)DECB * D, O_END = O_CONVS + (long)DECB * 3 * D;

enum { I_XP, I_XS, I_CP, I_CS, I_STH, I_STC, I_CCMP, I_CSEL, I_SWIN, I_PT, I_WADA, I_BADA, I_LNG, I_LNB, I_WINA, I_CONVW, I_CONVB,
       I_WR, I_BR, I_WI, I_BI, I_LAM, I_WOUTA, I_WKV, I_PE, I_WPHI1, I_BPHI1, I_WPHI2, I_BPHI2, I_WINB, I_BGATE, I_WOUTB, I_N };

struct WS {
    float *mod, *mA, *u0, *xc, *ga, *gb, *fbuf, *x1, *kv, *u, *hid, *comp, *pc, *ocmp, *osel, *owin, *obuf; int* idx;
};
constexpr long al(long x) { return (x + 63) / 64 * 64; }
constexpr long W_MOD = 0, W_MA = W_MOD + al(2L * NC * 3 * D), W_U0 = W_MA + al((long)M * D), W_XC = W_U0 + al((long)M * 2 * D),
    W_GA = W_XC + al((long)M * D), W_GB = W_GA + al((long)M * D), W_F = W_GB + al((long)M * D), W_X1 = W_F + al((long)M * D),
    W_KV = W_X1 + al((long)M * D), W_U = W_KV + al((long)M * NKVC), W_HID = W_U + al((long)M * NU),
    W_COMP = W_HID + al((long)NSEQN * NKV * 2 * DPHI), W_PC = W_COMP + al((long)NSEQN * NKV * 2 * HD),
    W_OCMP = W_PC + al((long)M * NH * NSBMAX), W_OSEL = W_OCMP + al((long)M * D), W_OWIN = W_OSEL + al((long)M * D),
    W_OBUF = W_OWIN + al((long)M * D), W_IDX = W_OBUF + al((long)M * D), W_END = W_IDX + al((long)M * NKV * NSEL);

constexpr long W_BFA = W_END, W_BFB = W_BFA + al((long)M * D / 2), W_END2 = W_BFB + al((long)M * D / 2);
struct Params { const float* in[I_N]; float* out; float* ws; };
static inline
#ifndef HOST_EMU
__device__
#endif
unsigned short f2bf_rne(float f) { unsigned u; __builtin_memcpy(&u, &f, 4); return (unsigned short)((u + 0x7fffu + ((u >> 16) & 1u)) >> 16); }

#ifdef HOST_EMU
#define NV_DEV static inline
#else
#define NV_DEV __device__ __forceinline__
#endif

NV_DEV float silu_f(float x) { return x / (1.0f + expf(-x)); }
NV_DEV float sigm_f(float x) { return 1.0f / (1.0f + expf(-x)); }
NV_DEV int cond_of(int row) { return row < MP ? row / SEQ : BATCH + (row - MP) / DSEQ; }
NV_DEV int pos_of(int row) { return row < MP ? row % SEQ : PAST + (row - MP) % DSEQ; }
NV_DEV float slope_of(int H) { return exp2f(-8.0f * (float)(H + 1) / (float)NH); }

NV_DEV void ph_ada(const Params& p, long gtid, long gsz) {
    float* mod = p.ws + W_MOD;
    for (long it = gtid; it < 2L * NC * 3 * D; it += gsz) {
        const int n = (int)(it % (3 * D)); const int ci = (int)((it / (3 * D)) % NC); const int layer = (int)(it / (3L * D * NC));
        const float* c = ci < BATCH ? p.in[I_CP] + (long)ci * D : p.in[I_CS] + (long)(ci - BATCH) * D;
        const float* w = p.in[I_WADA] + (long)layer * D * 3 * D;
        float acc = 0.f;
        for (int k = 0; k < D; ++k) acc += silu_f(c[k]) * w[(long)k * 3 * D + n];
        mod[it] = acc + p.in[I_BADA][layer * 3 * D + n];
    }
}
NV_DEV void ph_mod(const Params& p, int layer, long gtid, long gsz) {
    const float* mod = p.ws + W_MOD + (long)layer * NC * 3 * D; float* mA = p.ws + W_MA;
    for (long it = gtid; it < (long)M * D; it += gsz) {
        const int row = (int)(it / D), k = (int)(it % D); const int ci = cond_of(row);
        float x;
        if (layer == 0) x = row < MP ? p.in[I_XP][it] : p.in[I_XS][it - (long)MP * D];
        else x = (p.ws + W_X1)[it];
        const float v = x * (1.0f + mod[(long)ci * 3 * D + D + k]) + mod[(long)ci * 3 * D + k];
        mA[it] = v; ((unsigned short*)(p.ws + W_BFA))[it] = f2bf_rne(v);
    }
}
NV_DEV void gemm_naive(const float* A, int lda, const float* W, int ldw, float* C, int ldc, int Mr, int N, int K, long gtid, long gsz) {
    for (long it = gtid; it < (long)(Mr / 4) * N; it += gsz) {
        const int n = (int)(it % N); const long r0 = (it / N) * 4;
        float a0 = 0.f, a1 = 0.f, a2 = 0.f, a3 = 0.f;
        const float* A0 = A + r0 * lda;
        for (int k = 0; k < K; ++k) { const float w = W[(long)k * ldw + n];
            a0 += A0[k] * w; a1 += A0[lda + k] * w; a2 += A0[2 * lda + k] * w; a3 += A0[3 * lda + k] * w; }
        C[r0 * ldc + n] = a0; C[(r0 + 1) * ldc + n] = a1; C[(r0 + 2) * ldc + n] = a2; C[(r0 + 3) * ldc + n] = a3;
    }
}
NV_DEV void ph_conv(const Params& p, long gtid, long gsz) {
    const float* u0 = p.ws + W_U0; float* xc = p.ws + W_XC;
    for (long it = gtid; it < (long)M * D; it += gsz) {
        const int row = (int)(it / D), d = (int)(it % D);
        const int t = row < MP ? row % SEQ : (row - MP) % DSEQ;
        float acc = p.in[I_CONVB][d];
        for (int k = 0; k < 4; ++k) { const int j = t - 3 + k;
            float v;
            if (j >= 0) v = u0[(long)(row - t + j) * 2 * D + d];
            else v = row < MP ? 0.f : p.in[I_STC][((long)((row - MP) / DSEQ) * 3 + (3 + j)) * D + d];
            acc += v * p.in[I_CONVW][k * D + d]; }
        xc[it] = acc;
    }
}
NV_DEV void ph_gates(const Params& p, long gtid, long gsz) {
    const float* xc = p.ws + W_XC; float* ga = p.ws + W_GA; float* gb = p.ws + W_GB;
    for (long it = gtid; it < (long)M * D; it += gsz) {
        const int row = (int)(it / D), d = (int)(it % D); const int n = d / RGB, dd = d % RGB;
        const float* x = xc + (long)row * D + n * RGB;
        const float* wr = p.in[I_WR] + (long)n * RGB * RGB + dd; const float* wi = p.in[I_WI] + (long)n * RGB * RGB + dd;
        float ar = 0.f, ai = 0.f;
        for (int c = 0; c < RGB; ++c) { ar += x[c] * wr[(long)c * RGB]; ai += x[c] * wi[(long)c * RGB]; }
        const float r = sigm_f(ar + p.in[I_BR][d]), i = sigm_f(ai + p.in[I_BI][d]);
        const float lam = p.in[I_LAM][d];
        const float sp = (-lam > 20.f) ? -lam : log1pf(expf(-lam));
        const float log_a = -8.0f * sp * r;
        const float a = expf(log_a);
        const float gain = sqrtf(fmaxf(-expm1f(2.0f * log_a), 0.f));
        float b = gain * i * xc[it];
        const int t = row < MP ? row % SEQ : (row - MP) % DSEQ;
        if (t == 0 && row >= MP) b += a * p.in[I_STH][(long)((row - MP) / DSEQ) * D + d];
        ga[it] = a; gb[it] = b;
    }
}
NV_DEV void ph_scan(const Params& p, long gtid, long gsz) {
    const float* ga = p.ws + W_GA; float* gb = p.ws + W_GB;
    for (long it = gtid; it < (long)NC * D; it += gsz) {
        const int sq = (int)(it / D), d = (int)(it % D);
        const long row0 = sq < BATCH ? (long)sq * SEQ : MP + (long)(sq - BATCH) * DSEQ; const int T = sq < BATCH ? SEQ : DSEQ;
        float h = 0.f;
        for (int t = 0; t < T; ++t) { const long o = (row0 + t) * D + d; h = ga[o] * h + gb[o]; gb[o] = h; }
        if (sq < BATCH) p.out[O_HP + (long)sq * D + d] = h; else p.out[O_HS + (long)(sq - BATCH) * D + d] = h;
    }
}
NV_DEV void ph_gated(const Params& p, long gtid, long gsz) {
    const float* hs = p.ws + W_GB; const float* u0 = p.ws + W_U0; float* mA = p.ws + W_MA;
    for (long it = gtid; it < (long)M * D; it += gsz) { const long row = it / D; const int d = (int)(it % D);
        const float v = hs[it] * silu_f(u0[row * 2 * D + D + d]); mA[it] = v; ((unsigned short*)(p.ws + W_BFA))[it] = f2bf_rne(v); }
}
NV_DEV void ph_ln(const Params& p, int layer, long gtid, long gsz) {
    const float* mod = p.ws + W_MOD + (long)layer * NC * 3 * D; const float* f = p.ws + W_F;
    for (long row = gtid; row < M; row += gsz) {
        const int ci = cond_of((int)row);
        const float* x = layer == 0 ? (row < MP ? p.in[I_XP] + row * D : p.in[I_XS] + (row - MP) * D) : p.ws + W_X1 + row * D;
        const float* gt = mod + (long)ci * 3 * D + 2 * D; const float* fr = f + row * D;
        float s = 0.f;
        for (int k = 0; k < D; ++k) s += ALPHA * x[k] + (1.0f + gt[k]) * fr[k];
        const float mu = s / D; float v = 0.f;
        for (int k = 0; k < D; ++k) { const float e = ALPHA * x[k] + (1.0f + gt[k]) * fr[k] - mu; v += e * e; }
        const float rstd = 1.0f / sqrtf(v / D + LN_EPS);
        float* dst = layer == 0 ? p.ws + W_X1 + row * D : (row < MP ? p.out + O_YP + row * D : p.out + O_YS + (row - MP) * D);
        const float* lg = p.in[I_LNG] + layer * D; const float* lb = p.in[I_LNB] + layer * D;
        for (int k = 0; k < D; ++k) { const float v = (ALPHA * x[k] + (1.0f + gt[k]) * fr[k] - mu) * rstd * lg[k] + lb[k]; dst[k] = v;
            if (layer == 0) ((unsigned short*)(p.ws + W_BFB))[row * D + k] = f2bf_rne(v); }
    }
}
NV_DEV void ph_outputs(const Params& p, long gtid, long gsz) {
    const float* kv = p.ws + W_KV; const float* u0 = p.ws + W_U0;
    for (long it = gtid; it < (long)MP * KVG; it += gsz) { const long row = it / KVG; const int c = (int)(it % KVG);
        p.out[O_CMPP + it] = kv[row * NKVC + c]; p.out[O_SELP + it] = kv[row * NKVC + KVG + c]; }
    for (long it = gtid; it < (long)BATCH * WIN * KVG; it += gsz) { const int c = (int)(it % KVG); const int j = (int)((it / KVG) % WIN); const int b = (int)(it / ((long)KVG * WIN));
        p.out[O_WINP + it] = kv[((long)b * SEQ + SEQ - WIN + j) * NKVC + 2 * KVG + c]; }
    for (long it = gtid; it < (long)MS * KVG; it += gsz) { const long row = MP + it / KVG; const int c = (int)(it % KVG);
        p.out[O_CMPS + it] = kv[row * NKVC + c]; p.out[O_SELS + it] = kv[row * NKVC + KVG + c]; }
    for (long it = gtid; it < (long)DECB * WIN * KVG; it += gsz) { const int c = (int)(it % KVG); const int j = (int)((it / KVG) % WIN); const int bs = (int)(it / ((long)KVG * WIN));
        const int jj = j + DSEQ;
        p.out[O_WINS + it] = jj < WIN ? p.in[I_SWIN][((long)bs * WIN + jj) * KVG + c] : kv[((long)MP + bs * DSEQ + (jj - WIN)) * NKVC + 2 * KVG + c]; }
    for (long it = gtid; it < (long)BATCH * 3 * D; it += gsz) { const int d = (int)(it % D); const int j = (int)((it / D) % 3); const int b = (int)(it / (3 * D));
        p.out[O_CONVP + it] = u0[((long)b * SEQ + SEQ - 3 + j) * 2 * D + d]; }
    for (long it = gtid; it < (long)DECB * 3 * D; it += gsz) { const int d = (int)(it % D); const int j = (int)((it / D) % 3); const int bs = (int)(it / (3 * D));
        p.out[O_CONVS + it] = u0[((long)MP + bs * DSEQ + DSEQ - 3 + j) * 2 * D + d]; }
}
NV_DEV const float* cmp_src_row(const Params& p, int sn, int l, int& ok) {
    ok = 1;
    if (sn < BATCH * NCP) { const int b = sn / NCP, n = sn % NCP; return p.ws + W_KV + ((long)b * SEQ + n * CMPB + l) * NKVC; }
    const int r = sn - BATCH * NCP; const int bs = r / NCS, n = r % NCS; const int pos = n * CMPB + l;
    if (pos < PAST) { const int pg = ((const int*)p.in[I_PT])[bs * NPAGES + pos / PAGE]; return p.in[I_CCMP] + ((long)pg * PAGE + pos % PAGE) * KVG; }
    return p.ws + W_KV + ((long)MP + bs * DSEQ + (pos - PAST)) * NKVC;
}
NV_DEV void ph_comp1(const Params& p, long gtid, long gsz) {
    float* hid = p.ws + W_HID;
    for (long it = gtid; it < (long)NSEQN * NKV * 2 * DPHI; it += gsz) {
        const int pp = (int)(it % DPHI); const int c = (int)((it / DPHI) % 2); const int g = (int)((it / (2 * DPHI)) % NKV); const int sn = (int)(it / (2L * DPHI * NKV));
        float acc = 0.f;
        for (int l = 0; l < CMPB; ++l) { int ok; const float* src = cmp_src_row(p, sn, l, ok) + g * 2 * HD + c * HD;
            const float* pe = p.in[I_PE] + ((long)l * 2 + c) * HD; const float* w = p.in[I_WPHI1] + (((long)c * CMPB + l) * HD) * DPHI + pp;
            for (int d = 0; d < HD; ++d) acc += (src[d] + pe[d]) * w[(long)d * DPHI]; }
        hid[it] = silu_f(acc + p.in[I_BPHI1][c * DPHI + pp]);
    }
}
NV_DEV void ph_comp2(const Params& p, long gtid, long gsz) {
    const float* hid = p.ws + W_HID; float* comp = p.ws + W_COMP;
    for (long it = gtid; it < (long)NSEQN * NKV * 2 * HD; it += gsz) {
        const int d = (int)(it % HD); const int c = (int)((it / HD) % 2); const long sgc = it / HD;
        const float* h = hid + sgc * DPHI; const float* w = p.in[I_WPHI2] + (long)c * DPHI * HD + d;
        float acc = 0.f;
        for (int q = 0; q < DPHI; ++q) acc += h[q] * w[(long)q * HD];
        comp[it] = acc + p.in[I_BPHI2][c * HD + d];
    }
}
NV_DEV void ph_cmp_attn(const Params& p, long gtid, long gsz) {
    const float* u = p.ws + W_U; const float* comp = p.ws + W_COMP; float* pc = p.ws + W_PC; float* ocmp = p.ws + W_OCMP;
    for (long it = gtid; it < (long)M * NH; it += gsz) {
        const int row = (int)(it / NH), H = (int)(it % NH); const int g = H / HPG; const int t = pos_of(row);
        const int nc = row < MP ? NCP : NCS; const long sn0 = row < MP ? (long)(row / SEQ) * NCP : (long)BATCH * NCP + (long)((row - MP) / DSEQ) * NCS;
        const float sl = slope_of(H);
        float q[HD];
        for (int d = 0; d < HD; ++d) q[d] = u[(long)row * NU + H * HD + d] * 0.125f;
        float* pr = pc + ((long)row * NH + H) * NSBMAX;
        float m = -3.0e38f; int nvalid = 0;
        for (int n = 0; n < nc; ++n) { const int ce = n * CMPB + CMPB - 1;
            if (ce <= t) { const float* k = comp + ((sn0 + n) * NKV + g) * 2 * HD; float s = 0.f;
                for (int d = 0; d < HD; ++d) s += q[d] * k[d];
                s -= sl * (float)(t - ce); pr[n] = s; m = fmaxf(m, s); ++nvalid; } }
        float l = 0.f;
        for (int n = 0; n < nvalid; ++n) l += expf(pr[n] - m);
        float o[HD];
        for (int d = 0; d < HD; ++d) o[d] = 0.f;
        for (int n = 0; n < nvalid; ++n) { const float pn = expf(pr[n] - m) / l; pr[n] = pn;
            const float* v = comp + ((sn0 + n) * NKV + g) * 2 * HD + HD;
            for (int d = 0; d < HD; ++d) o[d] += pn * v[d]; }
        for (int n = nvalid; n < NSBMAX; ++n) pr[n] = 0.f;
        for (int d = 0; d < HD; ++d) ocmp[(long)row * D + H * HD + d] = o[d];
    }
}
NV_DEV void ph_topk(const Params& p, long gtid, long gsz) {
    float* pc = p.ws + W_PC; int* idx = (int*)(p.ws + W_IDX);
    for (long it = gtid; it < (long)M * NKV; it += gsz) {
        const int row = (int)(it / NKV), g = (int)(it % NKV); const int t = pos_of(row); const int cb = t / CMPB;
        const int nsb = row < MP ? NCP : NSBS; const int kk = nsb < NSEL ? nsb : NSEL;
        float* p0 = pc + ((long)row * NH + g * HPG) * NSBMAX;
        for (int j = 0; j < nsb; ++j) { const float imp = ((p0[j] + p0[NSBMAX + j]) + p0[2 * NSBMAX + j]) + p0[3 * NSBMAX + j];
            const bool forced = (j == 0) || (j == cb) || (j == cb - 1);
            p0[j] = forced ? 1.0e6f : (j <= cb ? imp : -1.0f); }
        for (int k = 0; k < NSEL; ++k) {
            if (k >= kk) { idx[it * NSEL + k] = -1; continue; }
            float best = -4.0f; int bj = 0;
            for (int j = 0; j < nsb; ++j) if (p0[j] > best) { best = p0[j]; bj = j; }
            p0[bj] = -5.0f; idx[it * NSEL + k] = bj; }
    }
}
NV_DEV void ph_sel(const Params& p, long gtid, long gsz) {
    const float* u = p.ws + W_U; const float* kv = p.ws + W_KV; const int* idx = (const int*)(p.ws + W_IDX); float* osel = p.ws + W_OSEL;
    for (long it = gtid; it < (long)M * NH; it += gsz) {
        const int row = (int)(it / NH), H = (int)(it % NH); const int g = H / HPG; const int t = pos_of(row); const float sl = slope_of(H);
        float q[HD], o[HD];
        for (int d = 0; d < HD; ++d) { q[d] = u[(long)row * NU + H * HD + d] * 0.125f; o[d] = 0.f; }
        float m = -3.0e38f, l = 0.f;
        for (int k = 0; k < NSEL; ++k) { const int blk = idx[((long)row * NKV + g) * NSEL + k]; if (blk < 0) continue;
            for (int j = 0; j < CMPB; ++j) { const int pos = blk * CMPB + j; if (pos > t) continue;
                const float* kr;
                if (row < MP) kr = kv + ((long)(row / SEQ) * SEQ + pos) * NKVC + KVG + g * 2 * HD;
                else { const int bs = (row - MP) / DSEQ;
                    if (pos < PAST) { const int pg = ((const int*)p.in[I_PT])[bs * NPAGES + pos / PAGE]; kr = p.in[I_CSEL] + ((long)pg * PAGE + pos % PAGE) * KVG + g * 2 * HD; }
                    else { int r = pos - PAST; if (r > DSEQ - 1) r = DSEQ - 1; kr = kv + ((long)MP + bs * DSEQ + r) * NKVC + KVG + g * 2 * HD; } }
                float s = 0.f;
                for (int d = 0; d < HD; ++d) s += q[d] * kr[d];
                s -= sl * (float)(t - pos);
                const float mn = fmaxf(m, s); const float sc = expf(m - mn), pe = expf(s - mn);
                l = l * sc + pe;
                for (int d = 0; d < HD; ++d) o[d] = o[d] * sc + pe * kr[HD + d];
                m = mn; } }
        const float inv = 1.0f / l;
        for (int d = 0; d < HD; ++d) osel[(long)row * D + H * HD + d] = o[d] * inv;
    }
}
NV_DEV void ph_win(const Params& p, long gtid, long gsz) {
    const float* u = p.ws + W_U; const float* kv = p.ws + W_KV; float* owin = p.ws + W_OWIN;
    for (long it = gtid; it < (long)M * NH; it += gsz) {
        const int row = (int)(it / NH), H = (int)(it % NH); const int g = H / HPG; const int t = pos_of(row); const float sl = slope_of(H);
        float q[HD], o[HD];
        for (int d = 0; d < HD; ++d) { q[d] = u[(long)row * NU + H * HD + d] * 0.125f; o[d] = 0.f; }
        float m = -3.0e38f, l = 0.f;
        const int p0 = t - WIN > 0 ? t - WIN : 0;
        for (int pos = p0; pos <= t; ++pos) {
            const float* kr;
            if (row < MP) kr = kv + ((long)(row / SEQ) * SEQ + pos) * NKVC + 2 * KVG + g * 2 * HD;
            else { const int bs = (row - MP) / DSEQ; const int j = pos - (PAST - WIN);
                if (j < WIN) kr = p.in[I_SWIN] + ((long)bs * WIN + j) * KVG + g * 2 * HD;
                else kr = kv + ((long)MP + bs * DSEQ + (j - WIN)) * NKVC + 2 * KVG + g * 2 * HD; }
            float s = 0.f;
            for (int d = 0; d < HD; ++d) s += q[d] * kr[d];
            s -= sl * (float)(t - pos);
            const float mn = fmaxf(m, s); const float sc = expf(m - mn), pe = expf(s - mn);
            l = l * sc + pe;
            for (int d = 0; d < HD; ++d) o[d] = o[d] * sc + pe * kr[HD + d];
            m = mn; }
        const float inv = 1.0f / l;
        for (int d = 0; d < HD; ++d) owin[(long)row * D + H * HD + d] = o[d] * inv;
    }
}
NV_DEV void ph_combine(const Params& p, long gtid, long gsz) {
    const float* u = p.ws + W_U; float* obuf = p.ws + W_OBUF;
    for (long it = gtid; it < (long)M * D; it += gsz) { const long row = it / D; const int c = (int)(it % D); const int H = c / HD;
        const float* gl = u + row * NU + 2 * D + H * 3; const float* bg = p.in[I_BGATE] + H * 3;
        const float g0 = sigm_f(gl[0] + bg[0]), g1 = sigm_f(gl[1] + bg[1]), g2 = sigm_f(gl[2] + bg[2]);
        const float o = g0 * (p.ws + W_OCMP)[it] + g1 * (p.ws + W_OSEL)[it] + g2 * (p.ws + W_OWIN)[it];
        const float v = o * silu_f(u[row * NU + D + c]); obuf[it] = v; ((unsigned short*)(p.ws + W_BFA))[it] = f2bf_rne(v); }
}

constexpr int N_PH = 21;
template <int PH> NV_DEV void run_phase(const Params& p, long gtid, long gsz) {
    if constexpr (PH == 0) ph_ada(p, gtid, gsz);
    else if constexpr (PH == 1) ph_mod(p, 0, gtid, gsz);
    else if constexpr (PH == 2) gemm_naive(p.ws + W_MA, D, p.in[I_WINA], 2 * D, p.ws + W_U0, 2 * D, M, 2 * D, D, gtid, gsz);
    else if constexpr (PH == 3) ph_conv(p, gtid, gsz);
    else if constexpr (PH == 4) ph_gates(p, gtid, gsz);
    else if constexpr (PH == 5) ph_scan(p, gtid, gsz);
    else if constexpr (PH == 6) ph_gated(p, gtid, gsz);
    else if constexpr (PH == 7) gemm_naive(p.ws + W_MA, D, p.in[I_WOUTA], D, p.ws + W_F, D, M, D, D, gtid, gsz);
    else if constexpr (PH == 8) ph_ln(p, 0, gtid, gsz);
    else if constexpr (PH == 9) gemm_naive(p.ws + W_X1, D, p.in[I_WKV], NKVC, p.ws + W_KV, NKVC, M, NKVC, D, gtid, gsz);
    else if constexpr (PH == 10) ph_mod(p, 1, gtid, gsz);
    else if constexpr (PH == 11) gemm_naive(p.ws + W_MA, D, p.in[I_WINB], NU, p.ws + W_U, NU, M, NU, D, gtid, gsz);
    else if constexpr (PH == 12) { ph_outputs(p, gtid, gsz); ph_comp1(p, gtid, gsz); }
    else if constexpr (PH == 13) ph_comp2(p, gtid, gsz);
    else if constexpr (PH == 14) ph_cmp_attn(p, gtid, gsz);
    else if constexpr (PH == 15) ph_topk(p, gtid, gsz);
    else if constexpr (PH == 16) ph_sel(p, gtid, gsz);
    else if constexpr (PH == 17) ph_win(p, gtid, gsz);
    else if constexpr (PH == 18) ph_combine(p, gtid, gsz);
    else if constexpr (PH == 19) gemm_naive(p.ws + W_OBUF, D, p.in[I_WOUTB], D, p.ws + W_F, D, M, D, D, gtid, gsz);
    else if constexpr (PH == 20) ph_ln(p, 1, gtid, gsz);
}
}

#define XB_TMO      128
#define XB_XCNT(j)  (256  + 64 * (j))
#define XB_XSUB(j)  (1280 + 64 * (j))
#define XB_XGEN(j)  (2304 + 64 * (j))
#define XB_TOP      3328
#define XB_TOPGEN   3392
#define XCD_BAR_WORDS 3456
#define XB_SPIN_CAP (1u << 18)
#define LAS __attribute__((address_space(3)))

__device__ __forceinline__ unsigned xb_ld(unsigned* p)              { return __hip_atomic_load(p, __ATOMIC_RELAXED, __HIP_MEMORY_SCOPE_AGENT); }
__device__ __forceinline__ unsigned xb_add(unsigned* p, unsigned v) { return __hip_atomic_fetch_add(p, v, __ATOMIC_RELAXED, __HIP_MEMORY_SCOPE_AGENT); }
__device__ __forceinline__ unsigned xb_xcc_id() { return (unsigned)__builtin_amdgcn_s_getreg((3 << 11) | 20) & 0xFu; }
#define XB_SPIN(cond, bar) do { unsigned _sp = 0; while (cond) { __builtin_amdgcn_s_sleep(1); \
    if ((++_sp & 255u) == 0u) { if (xb_ld(&(bar)[XB_TMO])) break; if (_sp > XB_SPIN_CAP) { atomicAdd(&(bar)[XB_TMO], 1u); break; } } } } while (0)

struct XcdBarrier {
    unsigned* bar; unsigned x;
    volatile LAS unsigned* st;
};

__device__ __forceinline__ XcdBarrier xcd_barrier_post(unsigned* bar, volatile LAS unsigned* st) {
    XcdBarrier b; b.bar = bar; b.x = xb_xcc_id(); b.st = st;
    if (threadIdx.x == 0) (void)xb_add(&bar[XB_XCNT(b.x)], 1u);
    return b;
}
__device__ __forceinline__ void xcd_barrier_complete(unsigned* bar, unsigned x, unsigned& nloc, unsigned& nx) {
    const unsigned G = gridDim.x * gridDim.y * gridDim.z;
    unsigned sum, cnt, mine, sp = 0u;
    for (;;) {
        sum = 0u; cnt = 0u; mine = 0u;
#pragma unroll
        for (unsigned j = 0; j < 16; ++j) { const unsigned c = xb_ld(&bar[XB_XCNT(j)]); sum += c; cnt += (c > 0u) ? 1u : 0u; mine = (j == x) ? c : mine; }
        if (sum == G) break;
        __builtin_amdgcn_s_sleep(1);
        if ((++sp & 255u) == 0u) { if (xb_ld(&bar[XB_TMO])) break; if (sp > XB_SPIN_CAP) { atomicAdd(&bar[XB_TMO], 1u); break; } }
    }
    nloc = mine > 0u ? mine : 1u; nx = cnt > 0u ? cnt : 1u;
}

__device__ __forceinline__ void xcd_barrier(const XcdBarrier& b) {
    asm volatile("s_waitcnt vmcnt(0)" ::: "memory");
    __syncthreads();
    if (threadIdx.x == 0) {
        unsigned* bar = b.bar;
        __builtin_amdgcn_s_waitcnt(0);
        unsigned nloc = b.st[0], nx = b.st[1];
        if (nloc == 0u) { xcd_barrier_complete(bar, b.x, nloc, nx); b.st[0] = nloc; b.st[1] = nx; }
        const unsigned old = xb_add(&bar[XB_XSUB(b.x)], 1u);
        const unsigned gen = old / nloc;
        if (old + 1u == (gen + 1u) * nloc) {
            __builtin_amdgcn_fence(__ATOMIC_RELEASE, "agent");
            asm volatile("s_waitcnt vmcnt(0)" ::: "memory");
            const unsigned og = xb_add(&bar[XB_TOP], 1u);
            const unsigned tg = og / nx;
            if (og + 1u == (tg + 1u) * nx) xb_add(&bar[XB_TOPGEN], 1u);
            else XB_SPIN(xb_ld(&bar[XB_TOPGEN]) == tg, bar);
            __builtin_amdgcn_fence(__ATOMIC_ACQUIRE, "agent");
            xb_add(&bar[XB_XGEN(b.x)], 1u);
            asm volatile("s_waitcnt vmcnt(0)" ::: "memory");
        } else {
            XB_SPIN(xb_ld(&bar[XB_XGEN(b.x)]) == gen, bar);
            __builtin_amdgcn_fence(__ATOMIC_ACQUIRE, "agent");
            asm volatile("s_waitcnt vmcnt(0)" ::: "memory");
        }
    }
    __syncthreads();
}

__device__ __forceinline__ int opaque_tid() { int t = threadIdx.x; asm volatile("" : "+v"(t)); return t; }

namespace pg8 {
#define PG8_LAS __attribute__((address_space(3)))
typedef unsigned short bf16_t;
typedef short bf16x8 __attribute__((ext_vector_type(8)));
typedef float f32x4 __attribute__((ext_vector_type(4)));
typedef unsigned u32x4 __attribute__((ext_vector_type(4)));
constexpr int BM = 256, BK = 64, HALF = 128, HTB = HALF * BK * 2  , STAGE_BYTES = 8 * HTB, NXCD = 8, WGM = 8;

__host__ __device__ __forceinline__ int lds_byte(int r, int c) { const int st = (r >> 4) * 2 + (c >> 5), rr = r & 15, cc = c & 31, ob = rr * 64 + cc * 2; return st * 1024 + (ob ^ (((ob >> 9) & 1) << 5)); }
__host__ __device__ __forceinline__ void stage_rc(int b, int& R, int& C) { const int st = b / 1024, sb = b % 1024, swz = sb ^ (((sb >> 9) & 1) << 5); R = (st >> 1) * 16 + swz / 64; C = (st & 1) * 32 + (swz % 64) / 2; }
__host__ __device__ __forceinline__ int perm32(int rho) { const int n = rho >> 4, i = rho & 15; return 8 * (i >> 2) + 4 * n + (i & 3); }

struct Unit { int pm, pn; };
struct Gemm { const bf16_t* A; const bf16_t* Bt; int M, N, K; const bf16_t* A2; int nsplit; };

struct StaticOrder {
    int nM, nN, nwg, G, c;
    __host__ __device__ void init(int M, int N, int G_, int c_) { nM = M / BM; nN = N / BM; nwg = nM * nN; G = G_; c = c_; }
    __host__ __device__ bool next(int i, Unit& u) const {
        const long L = (long)i * G + c; if (L >= nwg) return false;
        int wgid = (int)L; { const int q = nwg / NXCD, r = nwg % NXCD, xcd = wgid % NXCD, off = wgid / NXCD; wgid = (xcd < r ? xcd * (q + 1) : r * (q + 1) + (xcd - r) * q) + off; }
        const int nig = WGM * nN, gid = wgid / nig, fm = gid * WGM, gsz = (nM - fm) < WGM ? (nM - fm) : WGM;
        u.pm = fm + ((wgid % nig) % gsz); u.pn = (wgid % nig) / gsz; return true;
    }
    __device__ __forceinline__ void a_ready(const Unit&) const {}
    __device__ __forceinline__ void done(const Unit&) const {}
};

__device__ __forceinline__ unsigned cvt_pk_bf16(float lo, float hi) { unsigned r; asm volatile("v_cvt_pk_bf16_f32 %0, %1, %2" : "=v"(r) : "v"(lo), "v"(hi)); return r; }
typedef float f32x2 __attribute__((ext_vector_type(2)));
template <class Epi, class Sched, bool ALIGN_EPI = false, bool SP2 = false>
__device__ __forceinline__ void gemm_phase(PG8_LAS unsigned char* lds, const Gemm g, const Sched& S, const Epi& E) {
    const int tid = opaque_tid(), wid = __builtin_amdgcn_readfirstlane(tid >> 6), lane = tid & 63, wr = wid >> 2, wc = wid & 3, fr = lane & 15, fq = lane >> 4;
    const int K = g.K, nt = K / BK;
    unsigned voffA[2], voffB[2];
#pragma unroll
    for (int i = 0; i < 2; ++i) { int R, C; stage_rc(tid * 16 + i * 8192, R, C); const int Rb = Epi::PERM ? ((R & ~31) + perm32(R & 31)) : R;
        voffA[i] = (unsigned)(R * K + C) * 2u; voffB[i] = (unsigned)(Rb * K + C) * 2u; }
    const size_t kstep = (size_t)(BK * 2);
    const size_t hstep = (size_t)HALF * K * 2;
    const size_t tstep = 2 * hstep;
    const unsigned ldsw = (unsigned)wid * 1024u;
    const int aoff = lds_byte(wr * 64 + fr, fq * 8), boff = lds_byte(wc * 32 + fr, fq * 8);
#define PG8_SA(b, h) (((b) * 2 + (h)) * HTB)
#define PG8_SB(b, h) ((4 + (b) * 2 + (h)) * HTB)
#define PG8_STAGE(bufoff, gbase, voff) do { _Pragma("unroll") for (int _i = 0; _i < 2; ++_i) \
        __builtin_amdgcn_global_load_lds((const unsigned*)((const char*)(gbase) + (voff)[_i]), (PG8_LAS unsigned*)(lds + (bufoff) + ldsw + _i * 8192), 16, 0, 0); } while (0)
#define PG8_LDA(dst, b, h) do { _Pragma("unroll") for (int m = 0; m < 4; ++m) _Pragma("unroll") for (int k = 0; k < 2; ++k) dst[m][k] = *(const PG8_LAS bf16x8*)(lds + PG8_SA(b, h) + aoff + m * 2048 + k * 1024); } while (0)
#define PG8_LDB(dst, b, h) do { _Pragma("unroll") for (int n = 0; n < 2; ++n) _Pragma("unroll") for (int k = 0; k < 2; ++k) dst[n][k] = *(const PG8_LAS bf16x8*)(lds + PG8_SB(b, h) + boff + n * 2048 + k * 1024); } while (0)
#define PG8_MMA(ai, bj, At, Bt) do { __builtin_amdgcn_s_setprio(1); _Pragma("unroll") for (int m = 0; m < 4; ++m) _Pragma("unroll") for (int n = 0; n < 2; ++n) _Pragma("unroll") for (int k = 0; k < 2; ++k) \
        acc[ai][bj][m][n] = __builtin_amdgcn_mfma_f32_16x16x32_bf16(Bt[n][k], At[m][k], acc[ai][bj][m][n], 0, 0, 0); __builtin_amdgcn_s_setprio(0); } while (0)
#define PG8_WAIT_V(n) asm volatile("s_waitcnt vmcnt(" #n ")" ::: "memory")
#define PG8_WAIT_L(n) asm volatile("s_waitcnt lgkmcnt(" #n ")" ::: "memory")
#define PG8_BAR __builtin_amdgcn_s_barrier()
#define PG8_SCHED __builtin_amdgcn_sched_barrier(0)
    Unit cur, nxt; int ui = 0;
    if (!S.next(0, cur)) return;
    f32x4 acc[2][2][4][2];
#pragma unroll
    for (int a = 0; a < 2; ++a)
#pragma unroll
        for (int b = 0; b < 2; ++b)
#pragma unroll
            for (int m = 0; m < 4; ++m)
#pragma unroll
                for (int n = 0; n < 2; ++n) acc[a][b][m][n] = (f32x4){0.f, 0.f, 0.f, 0.f};
    bf16x8 At[4][2], B0[2][2], B1[2][2];
    const char* cA = (const char*)(cur.pn < g.nsplit ? g.A : g.A2) + (size_t)cur.pm * tstep; const char* cB = (const char*)g.Bt + (size_t)cur.pn * tstep;
    S.a_ready(cur);
    if constexpr (SP2) {
        PG8_STAGE(PG8_SB(0, 0), cB, voffB); PG8_STAGE(PG8_SB(0, 1), cB + hstep, voffB); PG8_STAGE(PG8_SA(0, 0), cA, voffA); PG8_STAGE(PG8_SA(0, 1), cA + hstep, voffA);
        if (wr == 1) PG8_BAR;
        PG8_WAIT_V(2); PG8_BAR;
        PG8_STAGE(PG8_SB(1, 0), cB + kstep, voffB); PG8_STAGE(PG8_SA(1, 0), cA + kstep, voffA); PG8_STAGE(PG8_SB(1, 1), cB + hstep + kstep, voffB);
        PG8_WAIT_V(6); PG8_BAR;
    } else {
        PG8_STAGE(PG8_SB(0, 0), cB, voffB); PG8_STAGE(PG8_SA(0, 0), cA, voffA); PG8_STAGE(PG8_SB(0, 1), cB + hstep, voffB); PG8_STAGE(PG8_SA(0, 1), cA + hstep, voffA);
        if (wr == 1) PG8_BAR;
        PG8_WAIT_V(4); PG8_BAR;
        PG8_STAGE(PG8_SB(1, 0), cB + kstep, voffB); PG8_STAGE(PG8_SA(1, 0), cA + kstep, voffA); PG8_STAGE(PG8_SB(1, 1), cB + hstep + kstep, voffB);
        PG8_WAIT_V(6); PG8_BAR;
    }
    for (;;) {
        const bool has_next = S.next(ui + 1, nxt);
        const char* nA = has_next ? (const char*)(nxt.pn < g.nsplit ? g.A : g.A2) + (size_t)nxt.pm * tstep : cA; const char* nB = has_next ? (const char*)g.Bt + (size_t)nxt.pn * tstep : cB;
        for (int t = 0; t < nt; t += 2) {
            const bool last = (t == nt - 2);
            const char* a1 = cA + (size_t)(t + 1) * kstep;
            const char* a2 = last ? nA : cA + (size_t)(t + 2) * kstep; const char* b2 = last ? nB : cB + (size_t)(t + 2) * kstep;
            const char* a3 = a2 + kstep; const char* b3 = b2 + kstep;
            if (last && has_next) S.a_ready(nxt);
            if constexpr (SP2) {
            PG8_LDB(B0, 0, 0); PG8_LDB(B1, 0, 1); PG8_SCHED; PG8_LDA(At, 0, 0); PG8_STAGE(PG8_SA(1, 1), a1 + hstep, voffA);
            PG8_WAIT_V(8); PG8_WAIT_L(0); PG8_BAR; PG8_MMA(0, 0, At, B0); PG8_MMA(0, 1, At, B1); PG8_BAR; PG8_SCHED;
            PG8_LDA(At, 0, 1); PG8_STAGE(PG8_SB(0, 0), b2, voffB); PG8_STAGE(PG8_SB(0, 1), b2 + hstep, voffB); PG8_STAGE(PG8_SA(0, 0), a2, voffA);
            PG8_WAIT_V(8); PG8_WAIT_L(0); PG8_BAR; PG8_MMA(1, 0, At, B0); PG8_MMA(1, 1, At, B1); PG8_BAR; PG8_SCHED;
            PG8_LDB(B0, 1, 0); PG8_LDB(B1, 1, 1); PG8_SCHED; PG8_LDA(At, 1, 0); PG8_STAGE(PG8_SA(0, 1), a2 + hstep, voffA);
            PG8_WAIT_V(8); PG8_WAIT_L(0); PG8_BAR; PG8_MMA(0, 0, At, B0); PG8_MMA(0, 1, At, B1); PG8_BAR; PG8_SCHED;
            PG8_LDA(At, 1, 1); PG8_STAGE(PG8_SB(1, 0), b3, voffB); PG8_STAGE(PG8_SB(1, 1), b3 + hstep, voffB); PG8_STAGE(PG8_SA(1, 0), a3, voffA);
            PG8_WAIT_V(8); PG8_WAIT_L(0); PG8_BAR; PG8_MMA(1, 0, At, B0); PG8_MMA(1, 1, At, B1); PG8_BAR; PG8_SCHED;
            } else {
            PG8_LDB(B0, 0, 0); PG8_SCHED; PG8_LDA(At, 0, 0); PG8_STAGE(PG8_SA(1, 1), a1 + hstep, voffA);
            PG8_WAIT_L(8); PG8_BAR; PG8_WAIT_L(0); PG8_MMA(0, 0, At, B0); PG8_BAR; PG8_SCHED;
            PG8_LDB(B1, 0, 1); PG8_STAGE(PG8_SB(0, 0), b2, voffB);
            PG8_BAR; PG8_WAIT_L(0); PG8_MMA(0, 1, At, B1); PG8_BAR;
            PG8_LDA(At, 0, 1); PG8_STAGE(PG8_SA(0, 0), a2, voffA);
            PG8_BAR; PG8_WAIT_L(0); PG8_MMA(1, 0, At, B0); PG8_BAR; PG8_SCHED;
            PG8_STAGE(PG8_SB(0, 1), b2 + hstep, voffB);
            PG8_WAIT_V(6); PG8_BAR; PG8_MMA(1, 1, At, B1); PG8_BAR;
            PG8_LDB(B0, 1, 0); PG8_SCHED; PG8_LDA(At, 1, 0); PG8_STAGE(PG8_SA(0, 1), a2 + hstep, voffA);
            PG8_WAIT_L(8); PG8_BAR; PG8_WAIT_L(0); PG8_MMA(0, 0, At, B0); PG8_BAR; PG8_SCHED;
            PG8_LDB(B1, 1, 1); PG8_STAGE(PG8_SB(1, 0), b3, voffB);
            PG8_BAR; PG8_WAIT_L(0); PG8_MMA(0, 1, At, B1); PG8_BAR;
            PG8_LDA(At, 1, 1); PG8_STAGE(PG8_SA(1, 0), a3, voffA);
            PG8_BAR; PG8_WAIT_L(0); PG8_MMA(1, 0, At, B0); PG8_BAR; PG8_SCHED;
            PG8_STAGE(PG8_SB(1, 1), b3 + hstep, voffB);
            PG8_WAIT_V(6); PG8_BAR; PG8_MMA(1, 1, At, B1); PG8_BAR;
            }
        }
        if constexpr (ALIGN_EPI) { if (wr == 0) PG8_BAR; }
        if constexpr (!Epi::AFTER_DRAIN) { E(acc, cur, wr, wc, fr, fq); S.done(cur); }
        if (!has_next) break;
#pragma unroll
        for (int a = 0; a < 2; ++a)
#pragma unroll
            for (int b = 0; b < 2; ++b)
#pragma unroll
                for (int m = 0; m < 4; ++m)
#pragma unroll
                    for (int n = 0; n < 2; ++n) acc[a][b][m][n] = (f32x4){0.f, 0.f, 0.f, 0.f};
        cur = nxt; cA = nA; cB = nB; ++ui;
        if constexpr (ALIGN_EPI) { if (wr == 1) PG8_BAR; }
    }
    PG8_WAIT_V(0);
    if constexpr (!ALIGN_EPI) { if (wr == 0) PG8_BAR; }
    PG8_BAR;
    if constexpr (Epi::AFTER_DRAIN) { E.fused(acc, cur, wr, wc, fr, fq, lds, wid, lane); S.done(cur); }
#undef PG8_SA
#undef PG8_SB
#undef PG8_STAGE
#undef PG8_LDA
#undef PG8_LDB
#undef PG8_MMA
#undef PG8_WAIT_V
#undef PG8_WAIT_L
#undef PG8_BAR
#undef PG8_SCHED
}
}

#define GAS __attribute__((address_space(1)))
typedef unsigned short bf16;
typedef unsigned v4u __attribute__((ext_vector_type(4)));
typedef float f32x4 __attribute__((ext_vector_type(4)));
#define LDS_WAIT() asm volatile("s_waitcnt lgkmcnt(0)" ::: "memory")
#define VM_WAIT() asm volatile("s_waitcnt vmcnt(0)" ::: "memory")
__device__ __forceinline__ unsigned f2bf(float f) { unsigned u = __builtin_bit_cast(unsigned, f); return (u + 0x7fffu + ((u >> 16) & 1u)) >> 16; }
__device__ __forceinline__ unsigned pk2(float lo, float hi) { return f2bf(lo) | (f2bf(hi) << 16); }

namespace pg8 {
struct EpiF32Split {
    static constexpr bool PERM = false, AFTER_DRAIN = false;
    float* C0; int ldc0, n0; float* C1; int ldc1, n1;
    __device__ __forceinline__ void operator()(const f32x4 (&acc)[2][2][4][2], const Unit& u, int wr, int wc, int fr, int fq) const {
#pragma unroll
        for (int ai = 0; ai < 2; ++ai)
#pragma unroll
            for (int m = 0; m < 4; ++m) { const size_t row = (size_t)u.pm * BM + ai * HALF + wr * 64 + m * 16 + fr;
#pragma unroll
                for (int bj = 0; bj < 2; ++bj)
#pragma unroll
                    for (int n = 0; n < 2; ++n) { const int col = u.pn * BM + bj * HALF + wc * 32 + n * 16 + 4 * fq;
                        if (col < n0) *(f32x4*)(C0 + row * ldc0 + col) = acc[ai][bj][m][n];
                        else if (col - n0 < n1) *(f32x4*)(C1 + row * ldc1 + (col - n0)) = acc[ai][bj][m][n]; } }
    }
};
}

__device__ __forceinline__ void wt_transpose_item(const float* W, int K, int N, bf16* WT, int row_off, LAS float* scr, int item, int lane) {
    const int nblk = (N + 31) / 32, kb = item / nblk, nb = item % nblk, k0 = 64 * kb, n0 = 32 * nb;
    const bool okn = n0 + (lane & 31) < N;
#pragma unroll 8
    for (int i = 0; i < 32; ++i) { const int kk = 2 * i + (lane >> 5); scr[kk * 33 + (lane & 31)] = okn ? W[(size_t)(k0 + kk) * N + n0 + (lane & 31)] : 0.f; }
    LDS_WAIT(); asm volatile("" ::: "memory");
    const int c = lane & 7;
#pragma unroll
    for (int j = 0; j < 4; ++j) { const int n = (lane >> 3) + 8 * j; const LAS float* s = scr + (8 * c) * 33 + n;
        v4u o; o.x = pk2(s[0 * 33], s[1 * 33]); o.y = pk2(s[2 * 33], s[3 * 33]); o.z = pk2(s[4 * 33], s[5 * 33]); o.w = pk2(s[6 * 33], s[7 * 33]);
        *(GAS v4u*)(WT + (size_t)(row_off + n0 + n) * K + k0 + 8 * c) = o; }
    LDS_WAIT(); asm volatile("" ::: "memory");
}

namespace rg {
typedef short bf16x8 __attribute__((ext_vector_type(8)));
constexpr int TC = 128, NCHUNK = nv::SEQ / TC;
constexpr int A_STRIDE = 272;
constexpr int X_STRIDE = 132;
constexpr int LDS_A = 0, LDS_X = 128 * A_STRIDE;
constexpr int NUNIT_P = nv::BATCH * NCHUNK * 8, NUNIT_S = (nv::MS / 128) * 8;
static_assert(nv::RGB == 128 && nv::NRG == 8 && nv::MS % 128 == 0 && nv::SEQ % TC == 0, "rg geometry");

__device__ __forceinline__ float sigm(float x) { return 1.0f / (1.0f + __expf(-x)); }

template <int PASS>
__device__ __forceinline__ void rg_pass(const nv::Params& p, LAS unsigned char* L, float* agg) {
    using namespace nv;
    const int tid = opaque_tid(), wave = __builtin_amdgcn_readfirstlane(tid >> 6), lane = tid & 63;
    const int n = blockIdx.x & 7;
    const int l15 = lane & 15, q = lane >> 4;
    const int cl = 16 * wave + l15, ch = n * 128 + cl;
    const float* u0 = p.ws + W_U0;
    LAS float* X = (LAS float*)(L + LDS_X);
    bf16x8 Br[4], Bi[4];
#pragma unroll
    for (int ks = 0; ks < 4; ++ks)
#pragma unroll
        for (int j = 0; j < 8; ++j) { const int k = 32 * ks + 8 * q + j;
            Br[ks][j] = (short)f2bf(p.in[I_WR][((size_t)n * 128 + k) * 128 + cl]); Bi[ks][j] = (short)f2bf(p.in[I_WI][((size_t)n * 128 + k) * 128 + cl]); }
    const float br = p.in[I_BR][ch], bi = p.in[I_BI][ch];
    const float lam = p.in[I_LAM][ch];
    const float sp8 = 8.0f * ((-lam > 20.f) ? -lam : log1pf(expf(-lam)));
    const int nunits = PASS == 1 ? NUNIT_P : NUNIT_P + NUNIT_S;
    for (int u = blockIdx.x; u < nunits; u += gridDim.x) {
        const bool samp = u >= NUNIT_P;
        int row0, b = 0, chunk = 0;
        if (!samp) { const int cidx = u >> 3; b = cidx / NCHUNK; chunk = cidx % NCHUNK; row0 = b * SEQ + chunk * TC; }
        else row0 = MP + ((u - NUNIT_P) >> 3) * 128;
        {
            const int c = tid & 127, rq = tid >> 7; const int chn = n * 128 + c;
            const float w0 = p.in[I_CONVW][chn], w1 = p.in[I_CONVW][D + chn], w2 = p.in[I_CONVW][2 * D + chn], w3 = p.in[I_CONVW][3 * D + chn], cb = p.in[I_CONVB][chn];
            LAS unsigned short* Abf = (LAS unsigned short*)(L + LDS_A);
            for (int i = 0; i < 32; ++i) {
                const int rl = rq * 32 + i, row = row0 + rl;
                int t, srow; if (!samp) { t = chunk * TC + rl; srow = b * SEQ; } else { t = rl & 7; srow = row - t; }
                float v[4];
#pragma unroll
                for (int k = 0; k < 4; ++k) { const int tt = t - 3 + k;
                    if (tt >= 0) v[k] = u0[(size_t)(srow + tt) * 2048 + chn];
                    else v[k] = samp ? p.in[I_STC][((size_t)((row - MP) >> 3) * 3 + (3 + tt)) * D + chn] : 0.f; }
                const float acc = cb + v[0] * w0 + v[1] * w1 + v[2] * w2 + v[3] * w3;
                X[rl * X_STRIDE + c] = acc; Abf[rl * (A_STRIDE / 2) + c] = (unsigned short)f2bf(acc);
            }
        }
        __syncthreads();
        float hin = 0.f;
        if (PASS == 2 && !samp) {
            float Ap = 1.f, Bp = 0.f;
            const float2* ag = (const float2*)agg + ((size_t)b * NCHUNK) * 1024 + ch;
#pragma unroll
            for (int i = 0; i < 16; ++i) { const int cc = 16 * q + i; const int cs = cc < chunk ? cc : 0; const float2 ab = ag[(size_t)cs * 1024];
                const float a_ = cc < chunk ? ab.x : 1.f, b_ = cc < chunk ? ab.y : 0.f; Bp = a_ * Bp + b_; Ap = a_ * Ap; }
#pragma unroll
            for (int qq = 0; qq < 4; ++qq) { const float a_ = __shfl(Ap, 16 * qq + l15), b_ = __shfl(Bp, 16 * qq + l15); hin = a_ * hin + b_; }
        }
        f32x4 accr[8], acci[8];
#pragma unroll
        for (int rt = 0; rt < 8; ++rt) { accr[rt] = (f32x4){0.f, 0.f, 0.f, 0.f}; acci[rt] = (f32x4){0.f, 0.f, 0.f, 0.f}; }
#pragma unroll
        for (int ks = 0; ks < 4; ++ks)
#pragma unroll
            for (int rt = 0; rt < 8; ++rt) { const bf16x8 a = *(const LAS bf16x8*)(L + LDS_A + (16 * rt + l15) * A_STRIDE + (32 * ks + 8 * q) * 2);
                accr[rt] = __builtin_amdgcn_mfma_f32_16x16x32_bf16(a, Br[ks], accr[rt], 0, 0, 0);
                acci[rt] = __builtin_amdgcn_mfma_f32_16x16x32_bf16(a, Bi[ks], acci[rt], 0, 0, 0); }
        float carA = 1.f, carB = hin;
#pragma unroll
        for (int rt = 0; rt < 8; ++rt) {
            float a[4], bb[4];
#pragma unroll
            for (int j = 0; j < 4; ++j) { const int rl = 16 * rt + 4 * q + j; const float xc = X[rl * X_STRIDE + cl];
                const float r = sigm(accr[rt][j] + br), ii = sigm(acci[rt][j] + bi);
                const float la = -sp8 * r; a[j] = expf(la); const float gain = sqrtf(fmaxf(-expm1f(2.0f * la), 0.f)); bb[j] = gain * ii * xc; }
            float As = a[0], Bs = bb[0];
#pragma unroll
            for (int j = 1; j < 4; ++j) { Bs = a[j] * Bs + bb[j]; As *= a[j]; }
            if (!samp) {
                float Ai = As, Bq = Bs;
                { const float pa = __shfl_up(Ai, 16), pb = __shfl_up(Bq, 16); if (q >= 1) { Bq = Ai * pb + Bq; Ai = pa * Ai; } }
                { const float pa = __shfl_up(Ai, 32), pb = __shfl_up(Bq, 32); if (q >= 2) { Bq = Ai * pb + Bq; Ai = pa * Ai; } }
                float Ae = __shfl_up(Ai, 16), Be = __shfl_up(Bq, 16); if (q == 0) { Ae = 1.f; Be = 0.f; }
                const float At = __shfl(Ai, 48 + l15), Bt = __shfl(Bq, 48 + l15);
                if (PASS == 2) {
                    float h = Ae * carB + Be;
#pragma unroll
                    for (int j = 0; j < 4; ++j) { h = a[j] * h + bb[j]; X[(16 * rt + 4 * q + j) * X_STRIDE + cl] = h; }
                    if (rt == 7 && q == 3 && chunk == NCHUNK - 1) p.out[O_HP + (size_t)b * D + ch] = h;
                    carB = At * carB + Bt;
                } else { carB = At * carB + Bt; carA = At * carA; }
            } else if (PASS == 2) {
                const int bs = ((row0 - MP) >> 3) + 2 * rt + (q >> 1);
                const float h0 = p.in[I_STH][(size_t)bs * D + ch];
                const float pa = __shfl_up(As, 16), pb = __shfl_up(Bs, 16);
                float h = (q & 1) ? pa * h0 + pb : h0;
#pragma unroll
                for (int j = 0; j < 4; ++j) { h = a[j] * h + bb[j]; X[(16 * rt + 4 * q + j) * X_STRIDE + cl] = h; }
                if (q & 1) p.out[O_HS + (size_t)bs * D + ch] = h;
            }
        }
        if (PASS == 1) { if (q == 3) ((float2*)agg)[((size_t)b * NCHUNK + chunk) * 1024 + ch] = make_float2(carA, carB); }
        if (PASS == 2) {
            __syncthreads();
            bf16* gA = (bf16*)(p.ws + W_BFA);
            for (int it = tid; it < 2048; it += 512) { const int rl = it >> 4, g8 = it & 15;
                const f32x4 h0 = *(const LAS f32x4*)(X + rl * X_STRIDE + 8 * g8), h1 = *(const LAS f32x4*)(X + rl * X_STRIDE + 8 * g8 + 4);
                const float* zp = u0 + (size_t)(row0 + rl) * 2048 + 1024 + n * 128 + 8 * g8;
                const f32x4 z0 = *(const f32x4*)zp, z1 = *(const f32x4*)(zp + 4);
                v4u o; o.x = pk2(h0[0] * z0[0] * sigm(z0[0]), h0[1] * z0[1] * sigm(z0[1])); o.y = pk2(h0[2] * z0[2] * sigm(z0[2]), h0[3] * z0[3] * sigm(z0[3]));
                o.z = pk2(h1[0] * z1[0] * sigm(z1[0]), h1[1] * z1[1] * sigm(z1[1])); o.w = pk2(h1[2] * z1[2] * sigm(z1[2]), h1[3] * z1[3] * sigm(z1[3]));
                *(GAS v4u*)(gA + (size_t)(row0 + rl) * 1024 + n * 128 + 8 * g8) = o; }
        }
        __syncthreads();
    }
}
}

namespace at {
using namespace nv;
typedef short bf16x8 __attribute__((ext_vector_type(8)));
typedef short s16x4 __attribute__((ext_vector_type(4)));
typedef short v4i16_t __attribute__((ext_vector_type(4)));
typedef unsigned v2u __attribute__((ext_vector_type(2)));
constexpr float LOG2E = 1.4426950408889634f, C2 = 0.125f * LOG2E;
constexpr int KS = 144, VS = 160, KVB = 64 * KS + 64 * VS;
constexpr int TQ = 64;
constexpr int L_KV = 0, L_OT = 2 * KVB, OT_RS = 528, OT_W = 8 * OT_RS, L_UNI = L_OT + 8 * OT_W;
static_assert(L_UNI + 64 <= 131072, "attention LDS map");
constexpr float NEGF = -1.0e30f;
constexpr int NT_P = BATCH * NKV * (SEQ / TQ), NT_S = DECB * NKV;

__device__ __forceinline__ s16x4 vtr(const LAS unsigned char* p) { return __builtin_bit_cast(s16x4, __builtin_amdgcn_ds_read_tr16_b64_v4i16((LAS v4i16_t*)p)); }
__device__ __forceinline__ bf16x8 cvt8(const f32x4 a, const f32x4 b) { v4u o; o.x = pk2(a[0], a[1]); o.y = pk2(a[2], a[3]); o.z = pk2(b[0], b[1]); o.w = pk2(b[2], b[3]); return __builtin_bit_cast(bf16x8, o); }

struct TileCtx {
    int b, g, t0;
    size_t rowbase;
    size_t sn0;
};

template <int KIND> __device__ __forceinline__ void stage_load(const Params& p, const TileCtx& c, const bf16* kvb, int kb, int boff, bf16x8& kr, bf16x8& vr, int tid) {
    const int key = tid >> 3, chn = tid & 7;
    if constexpr (KIND == 0) {
        const bf16* s = kvb + ((size_t)c.b * SEQ + kb * 64 + key) * NKVC + boff + c.g * 128 + 8 * chn;
        kr = *(const bf16x8*)s; vr = *(const bf16x8*)(s + 64);
    } else {
        const float* s;
        if constexpr (KIND == 1) s = p.ws + W_COMP + ((c.sn0 + kb * 64 + key) * NKV + c.g) * 128;
        else if constexpr (KIND == 2) { const int pos = kb * 64 + key;
            if (pos < PAST) { const int pg = ((const int*)p.in[I_PT])[c.b * NPAGES + (pos >> 7)]; s = p.in[I_CSEL] + ((size_t)pg * PAGE + (pos & 127)) * KVG + c.g * 128; }
            else { int r = pos - PAST; r = r > DSEQ - 1 ? DSEQ - 1 : r; s = p.ws + W_KV + ((size_t)MP + c.b * DSEQ + r) * NKVC + KVG + c.g * 128; } }
        else { int j = kb * 64 + key; j = j > WIN + DSEQ - 1 ? WIN + DSEQ - 1 : j;
            if (j < WIN) s = p.in[I_SWIN] + ((size_t)c.b * WIN + j) * KVG + c.g * 128;
            else s = p.ws + W_KV + ((size_t)MP + c.b * DSEQ + (j - WIN)) * NKVC + 2 * KVG + c.g * 128; }
        const f32x4 k0 = *(const f32x4*)(s + 8 * chn), k1 = *(const f32x4*)(s + 8 * chn + 4), v0 = *(const f32x4*)(s + 64 + 8 * chn), v1 = *(const f32x4*)(s + 64 + 8 * chn + 4);
        kr = cvt8(k0, k1); vr = cvt8(v0, v1);
    }
}
__device__ __forceinline__ void stage_write(LAS unsigned char* buf, const bf16x8 kr, const bf16x8 vr, int tid) {
    const int key = tid >> 3, chn = tid & 7;
    *(LAS bf16x8*)(buf + key * KS + chn * 16) = kr; *(LAS bf16x8*)(buf + 64 * KS + key * VS + chn * 16) = vr;
}

__device__ __forceinline__ void qk_block(const LAS unsigned char* buf, const bf16x8 (&qf)[2][2], f32x4 (&s)[4][2], int l15, int qd) {
#pragma unroll
    for (int kt = 0; kt < 4; ++kt)
#pragma unroll
        for (int ct = 0; ct < 2; ++ct) s[kt][ct] = (f32x4){0.f, 0.f, 0.f, 0.f};
#pragma unroll
    for (int ks = 0; ks < 2; ++ks) {
        bf16x8 kf[4];
#pragma unroll
        for (int kt = 0; kt < 4; ++kt) kf[kt] = *(const LAS bf16x8*)(buf + (16 * kt + l15) * KS + (32 * ks + 8 * qd) * 2);
#pragma unroll
        for (int kt = 0; kt < 4; ++kt)
#pragma unroll
            for (int ct = 0; ct < 2; ++ct) s[kt][ct] = __builtin_amdgcn_mfma_f32_16x16x32_bf16(kf[kt], qf[ct][ks], s[kt][ct], 0, 0, 0);
    }
}
__device__ __forceinline__ void pv_block(const LAS unsigned char* buf, const bf16x8 (&pf)[2][2], f32x4 (&O)[4][2], int l15, int qd) {
    const LAS unsigned char* vb = buf + 64 * KS + (4 * qd + (l15 >> 2)) * VS + (l15 & 3) * 8;
#pragma unroll
    for (int kk = 0; kk < 2; ++kk)
#pragma unroll
        for (int dt = 0; dt < 4; ++dt) {
            const s16x4 lo = vtr(vb + (32 * kk) * VS + dt * 32), hi = vtr(vb + (32 * kk + 16) * VS + dt * 32);
            const bf16x8 vf = (bf16x8){lo[0], lo[1], lo[2], lo[3], hi[0], hi[1], hi[2], hi[3]};
#pragma unroll
            for (int ct = 0; ct < 2; ++ct) O[dt][ct] = __builtin_amdgcn_mfma_f32_16x16x32_bf16(vf, pf[ct][kk], O[dt][ct], 0, 0, 0);
        }
}

template <int BR> __device__ __forceinline__ void online_step(const LAS unsigned char* buf, const bf16x8 (&qf)[2][2], f32x4 (&O)[4][2], float (&m)[2], float (&l)[2],
                                                              const float (&sl2)[2], int t, int pos0, bool lane_on, int l15, int qd) {
    f32x4 s[4][2];
    qk_block(buf, qf, s, l15, qd);
    bf16x8 pf[2][2];
#pragma unroll
    for (int ct = 0; ct < 2; ++ct) {
        float mloc = NEGF;
#pragma unroll
        for (int kt = 0; kt < 4; ++kt)
#pragma unroll
            for (int r = 0; r < 4; ++r) { const int dist = t - (pos0 + 16 * kt + 4 * qd + r);
                const bool ok = lane_on && dist >= 0 && (BR == 2 ? dist <= WIN : true);
                const float v = ok ? s[kt][ct][r] - sl2[ct] * (float)dist : NEGF; s[kt][ct][r] = v; mloc = fmaxf(mloc, v); }
        mloc = fmaxf(mloc, __shfl_xor(mloc, 16)); mloc = fmaxf(mloc, __shfl_xor(mloc, 32));
        const float mn = fmaxf(m[ct], mloc), alpha = __builtin_amdgcn_exp2f(m[ct] - mn);
        m[ct] = mn; float ls = 0.f;
#pragma unroll
        for (int kt = 0; kt < 4; ++kt)
#pragma unroll
            for (int r = 0; r < 4; ++r) { const float v = s[kt][ct][r]; const float pe = v > -1.0e29f ? __builtin_amdgcn_exp2f(v - mn) : 0.f; s[kt][ct][r] = pe; ls += pe; }
        l[ct] = l[ct] * alpha + ls;
#pragma unroll
        for (int dt = 0; dt < 4; ++dt) O[dt][ct] *= alpha;
        pf[ct][0] = cvt8(s[0][ct], s[1][ct]); pf[ct][1] = cvt8(s[2][ct], s[3][ct]);
    }
    pv_block(buf, pf, O, l15, qd);
}

template <bool ACC> __device__ __forceinline__ void ot_merge(LAS unsigned char* ot, const f32x4 (&O)[4][2], const float (&sc)[2], int l15, int qd) {
    const int hs = l15 >> 3, tq8 = l15 & 7;
#pragma unroll
    for (int ct = 0; ct < 2; ++ct)
#pragma unroll
        for (int dt = 0; dt < 4; ++dt) { LAS v2u* q = (LAS v2u*)(ot + tq8 * OT_RS + ((2 * ct + hs) * 64 + 16 * dt + 4 * qd) * 2);
            f32x4 v = O[dt][ct] * sc[ct];
            if (ACC) { const v2u o = *q; v[0] += __uint_as_float(o.x << 16); v[1] += __uint_as_float(o.x & 0xffff0000u); v[2] += __uint_as_float(o.y << 16); v[3] += __uint_as_float(o.y & 0xffff0000u); }
            *q = (v2u){pk2(v[0], v[1]), pk2(v[2], v[3])}; }
}

template <bool SAMP> __device__ __forceinline__ void attn_tile(const Params& p, LAS unsigned char* L, const TileCtx& c, const bf16* qb, const bf16* kvb) {
    const int tid = opaque_tid(), wave = __builtin_amdgcn_readfirstlane(tid >> 6), lane = tid & 63, l15 = lane & 15, qd = lane >> 4;
    const int hs = l15 >> 3, tq8 = l15 & 7;
    const bool wave_on = SAMP ? (wave == 0) : true;
    const int tq = SAMP ? tq8 : 8 * wave + tq8;
    const int t = c.t0 + tq;
    const size_t qrow = c.rowbase + tq;
    const float* u = p.ws + W_U;
    LAS unsigned char* ot = L + L_OT + wave * OT_W;
    LAS unsigned* uni = (LAS unsigned*)(L + L_UNI);
    if (tid < 4) uni[tid] = 0u;
    bf16x8 qf[2][2]; float sl2[2];
#pragma unroll
    for (int ct = 0; ct < 2; ++ct) { const int H = c.g * 4 + 2 * ct + hs;
#pragma unroll
        for (int ks = 0; ks < 2; ++ks) qf[ct][ks] = *(const bf16x8*)(qb + qrow * 1024 + H * 64 + 32 * ks + 8 * qd);
        sl2[ct] = exp2f(-8.0f * (float)(H + 1) / (float)NH) * LOG2E; }
    auto gate = [&](int ct, int x) -> float { const int H = c.g * 4 + 2 * ct + hs; return 1.0f / (1.0f + __expf(-(u[qrow * NU + 2 * D + H * 3 + x] + p.in[I_BGATE][H * 3 + x]))); };
    f32x4 O[4][2]; float m[2], l[2];
    LAS unsigned char* buf0 = L + L_KV; LAS unsigned char* buf1 = L + L_KV + KVB;
    { bf16x8 kr, vr; stage_load<1>(p, c, kvb, 0, 0, kr, vr, tid); stage_write(buf0, kr, vr, tid); stage_load<1>(p, c, kvb, 1, 0, kr, vr, tid); stage_write(buf1, kr, vr, tid); }
    __syncthreads();
    unsigned long long selLo = 0ull, selHi = 0ull;
#define AT_SETBIT(n) do { const int _n = (n); if (_n < 64) selLo |= 1ull << _n; else selHi |= 1ull << (_n - 64); } while (0)
    const int cb = t >> 6;
    if (wave_on) {
        const int nvalid = (t + 1) >> 6;
#pragma unroll
        for (int ct = 0; ct < 2; ++ct) { m[ct] = NEGF; l[ct] = 0.f; }
#pragma unroll
        for (int kb = 0; kb < 2; ++kb) { f32x4 s[4][2]; qk_block(kb ? buf1 : buf0, qf, s, l15, qd);
#pragma unroll
            for (int ct = 0; ct < 2; ++ct) { float mloc = NEGF;
#pragma unroll
                for (int kt = 0; kt < 4; ++kt)
#pragma unroll
                    for (int r = 0; r < 4; ++r) { const int n = 64 * kb + 16 * kt + 4 * qd + r; const bool ok = n < nvalid;
                        const float v = ok ? s[kt][ct][r] - sl2[ct] * (float)(t - (64 * n + 63)) : NEGF; s[kt][ct][r] = v; mloc = fmaxf(mloc, v); }
                mloc = fmaxf(mloc, __shfl_xor(mloc, 16)); mloc = fmaxf(mloc, __shfl_xor(mloc, 32));
                const float mn = fmaxf(m[ct], mloc); float ls = 0.f;
#pragma unroll
                for (int kt = 0; kt < 4; ++kt)
#pragma unroll
                    for (int r = 0; r < 4; ++r) { const float v = s[kt][ct][r]; ls += v > -1.0e29f ? __builtin_amdgcn_exp2f(v - mn) : 0.f; }
                l[ct] = l[ct] * __builtin_amdgcn_exp2f(m[ct] - mn) + ls; m[ct] = mn; } }
        float rl[2];
#pragma unroll
        for (int ct = 0; ct < 2; ++ct) { float ls = l[ct]; ls += __shfl_xor(ls, 16); ls += __shfl_xor(ls, 32); rl[ct] = ls > 0.f ? 1.0f / ls : 0.f; }
        float imp[2][4][4];
#pragma unroll
        for (int kb = 0; kb < 2; ++kb) { f32x4 s[4][2]; qk_block(kb ? buf1 : buf0, qf, s, l15, qd);
#pragma unroll
            for (int kt = 0; kt < 4; ++kt)
#pragma unroll
                for (int r = 0; r < 4; ++r) { const int n = 64 * kb + 16 * kt + 4 * qd + r; const bool ok = n < nvalid; const float dist = (float)(t - (64 * n + 63));
                    const float p0 = ok ? __builtin_amdgcn_exp2f(s[kt][0][r] - sl2[0] * dist - m[0]) * rl[0] : 0.f;
                    const float p1 = ok ? __builtin_amdgcn_exp2f(s[kt][1][r] - sl2[1] * dist - m[1]) * rl[1] : 0.f;
                    const float ps = p0 + p1; imp[kb][kt][r] = ps + __shfl_xor(ps, 8); } }
        int npick;
        if (SAMP) { selLo |= 1ull; selHi |= 1ull << 63; npick = NSEL - 3; }
        else { selLo |= 1ull; AT_SETBIT(cb); if (cb >= 1) AT_SETBIT(cb - 1); npick = NSEL - (cb == 0 ? 1 : (cb == 1 ? 2 : 3)); }
#pragma unroll
        for (int kb = 0; kb < 2; ++kb)
#pragma unroll
            for (int kt = 0; kt < 4; ++kt)
#pragma unroll
                for (int r = 0; r < 4; ++r) { const int n = 64 * kb + 16 * kt + 4 * qd + r;
                    const bool excl = (n == 0) || (n == cb) || (n == cb - 1) || (n > cb); if (excl) imp[kb][kt][r] = -2.f; }
        for (int it = 0; it < NSEL - 1; ++it) {
            float bv = -2.f; int bn = 1 << 20;
#pragma unroll
            for (int kb = 0; kb < 2; ++kb)
#pragma unroll
                for (int kt = 0; kt < 4; ++kt)
#pragma unroll
                    for (int r = 0; r < 4; ++r) { const int n = 64 * kb + 16 * kt + 4 * qd + r; const float v = imp[kb][kt][r]; if (v > bv) { bv = v; bn = n; } }
#pragma unroll
            for (int sh = 16; sh <= 32; sh <<= 1) { const float ov = __shfl_xor(bv, sh); const int on = __shfl_xor(bn, sh); if (ov > bv || (ov == bv && on < bn)) { bv = ov; bn = on; } }
            const bool take = it < npick && bv >= 0.f;
            if (take) AT_SETBIT(bn & 127);
#pragma unroll
            for (int kb = 0; kb < 2; ++kb)
#pragma unroll
                for (int kt = 0; kt < 4; ++kt)
#pragma unroll
                    for (int r = 0; r < 4; ++r) { const int n = 64 * kb + 16 * kt + 4 * qd + r; if (n == bn) imp[kb][kt][r] = -2.f; }
        }
        if (qd == 0 && hs == 0) { __hip_atomic_fetch_or(uni + 0, (unsigned)selLo, __ATOMIC_RELAXED, __HIP_MEMORY_SCOPE_WORKGROUP); __hip_atomic_fetch_or(uni + 1, (unsigned)(selLo >> 32), __ATOMIC_RELAXED, __HIP_MEMORY_SCOPE_WORKGROUP);
            __hip_atomic_fetch_or(uni + 2, (unsigned)selHi, __ATOMIC_RELAXED, __HIP_MEMORY_SCOPE_WORKGROUP); __hip_atomic_fetch_or(uni + 3, (unsigned)(selHi >> 32), __ATOMIC_RELAXED, __HIP_MEMORY_SCOPE_WORKGROUP); }
        {
#pragma unroll
            for (int ct = 0; ct < 2; ++ct) rl[ct] *= gate(ct, 0);
#pragma unroll
            for (int dt = 0; dt < 4; ++dt)
#pragma unroll
                for (int ct = 0; ct < 2; ++ct) O[dt][ct] = (f32x4){0.f, 0.f, 0.f, 0.f};
#pragma unroll
            for (int kb = 0; kb < 2; ++kb) { f32x4 s[4][2]; qk_block(kb ? buf1 : buf0, qf, s, l15, qd); bf16x8 pf[2][2];
#pragma unroll
                for (int ct = 0; ct < 2; ++ct) {
#pragma unroll
                    for (int kt = 0; kt < 4; ++kt)
#pragma unroll
                        for (int r = 0; r < 4; ++r) { const int n = 64 * kb + 16 * kt + 4 * qd + r; const bool ok = n < nvalid;
                            s[kt][ct][r] = ok ? __builtin_amdgcn_exp2f(s[kt][ct][r] - sl2[ct] * (float)(t - (64 * n + 63)) - m[ct]) * rl[ct] : 0.f; }
                    pf[ct][0] = cvt8(s[0][ct], s[1][ct]); pf[ct][1] = cvt8(s[2][ct], s[3][ct]); }
                pv_block(kb ? buf1 : buf0, pf, O, l15, qd); }
            const float one[2] = {1.f, 1.f}; ot_merge<false>(ot, O, one, l15, qd);
        }
    }
    __syncthreads();
    const unsigned long long unLo = ((unsigned long long)__builtin_amdgcn_readfirstlane(uni[1]) << 32) | (unsigned)__builtin_amdgcn_readfirstlane(uni[0]);
    const unsigned long long unHi = ((unsigned long long)__builtin_amdgcn_readfirstlane(uni[3]) << 32) | (unsigned)__builtin_amdgcn_readfirstlane(uni[2]);
#pragma unroll
    for (int ct = 0; ct < 2; ++ct) { m[ct] = NEGF; l[ct] = 0.f; }
#pragma unroll
    for (int dt = 0; dt < 4; ++dt)
#pragma unroll
        for (int ct = 0; ct < 2; ++ct) O[dt][ct] = (f32x4){0.f, 0.f, 0.f, 0.f};
    {
        auto next_bit = [&](int from) -> int {
            if (from < 64) { const unsigned long long x = unLo & (~0ull << from); if (x) return __builtin_ctzll(x); }
            const unsigned long long y = from <= 64 ? unHi : (from < 128 ? unHi & (~0ull << (from - 64)) : 0ull);
            return y ? 64 + __builtin_ctzll(y) : 128; };
        int cur = next_bit(0), pb = 0;
        const int last = SAMP ? 129 : 128;
        bf16x8 kr, vr;
        if (cur < last) { stage_load<SAMP ? 2 : 0>(p, c, kvb, cur, KVG, kr, vr, tid); stage_write(buf0, kr, vr, tid); }
        __syncthreads();
        while (cur < last) {
            int nxt = cur < 128 ? next_bit(cur + 1) : 129;
            if (!SAMP && nxt == 128) nxt = 129;
            const bool has_next = nxt <= 128;
            if (has_next) stage_load<SAMP ? 2 : 0>(p, c, kvb, nxt, KVG, kr, vr, tid);
            if (wave_on) {
                const bool bit = cur >= 128 ? true : (((cur < 64 ? selLo >> cur : selHi >> (cur - 64)) & 1ull) != 0ull);
                if (__builtin_amdgcn_ballot_w64(bit) != 0ull) online_step<1>(pb ? buf1 : buf0, qf, O, m, l, sl2, t, cur * 64, bit, l15, qd);
            }
            if (has_next) stage_write(pb ? buf0 : buf1, kr, vr, tid);
            __syncthreads();
            pb ^= 1; cur = has_next ? nxt : last;
        }
    }
    if (wave_on) { float sc[2];
#pragma unroll
        for (int ct = 0; ct < 2; ++ct) { float ls = l[ct]; ls += __shfl_xor(ls, 16); ls += __shfl_xor(ls, 32); sc[ct] = ls > 0.f ? gate(ct, 1) / ls : 0.f; }
        ot_merge<true>(ot, O, sc, l15, qd); }
#pragma unroll
    for (int ct = 0; ct < 2; ++ct) { m[ct] = NEGF; l[ct] = 0.f; }
#pragma unroll
    for (int dt = 0; dt < 4; ++dt)
#pragma unroll
        for (int ct = 0; ct < 2; ++ct) O[dt][ct] = (f32x4){0.f, 0.f, 0.f, 0.f};
    {
        const int kb0 = SAMP ? 0 : (c.t0 >= WIN ? (c.t0 - WIN) >> 6 : 0), kb1 = SAMP ? (WIN + DSEQ - 1) >> 6 : (c.t0 + TQ - 1) >> 6;
        const int wpos0 = SAMP ? PAST - WIN : 0;
        bf16x8 kr, vr; int pb = 0;
        stage_load<SAMP ? 3 : 0>(p, c, kvb, kb0, 2 * KVG, kr, vr, tid); stage_write(buf0, kr, vr, tid);
        __syncthreads();
        for (int kb = kb0; kb <= kb1; ++kb) {
            if (kb < kb1) stage_load<SAMP ? 3 : 0>(p, c, kvb, kb + 1, 2 * KVG, kr, vr, tid);
            if (wave_on) {
                const int pos0 = wpos0 + kb * 64;
                const int tlo = c.t0 + (SAMP ? 0 : 8 * wave), thi = tlo + 7;
                if (pos0 <= thi && pos0 + 63 >= tlo - WIN) online_step<2>(pb ? buf1 : buf0, qf, O, m, l, sl2, t, pos0, true, l15, qd);
            }
            if (kb < kb1) stage_write(pb ? buf0 : buf1, kr, vr, tid);
            __syncthreads();
            pb ^= 1;
        }
    }
    if (wave_on) { float sc[2];
#pragma unroll
        for (int ct = 0; ct < 2; ++ct) { float ls = l[ct]; ls += __shfl_xor(ls, 16); ls += __shfl_xor(ls, 32); sc[ct] = ls > 0.f ? gate(ct, 2) / ls : 0.f; }
        ot_merge<true>(ot, O, sc, l15, qd);
        asm volatile("s_waitcnt lgkmcnt(0)" ::: "memory");
        bf16* oA = (bf16*)(p.ws + W_BFA);
#pragma unroll
        for (int i = 0; i < 4; ++i) { const int it = lane + 64 * i; const int rr = it >> 5, ch = it & 31;
            const v4u ov = *(const LAS v4u*)(ot + rr * OT_RS + ch * 16);
            const size_t grow = c.rowbase + (SAMP ? rr : 8 * wave + rr); const int col = c.g * 256 + ch * 8;
            const float* zp = u + grow * NU + D + col; const f32x4 z0 = *(const f32x4*)zp, z1 = *(const f32x4*)(zp + 4);
            float o[8] = {__uint_as_float(ov.x << 16), __uint_as_float(ov.x & 0xffff0000u), __uint_as_float(ov.y << 16), __uint_as_float(ov.y & 0xffff0000u),
                          __uint_as_float(ov.z << 16), __uint_as_float(ov.z & 0xffff0000u), __uint_as_float(ov.w << 16), __uint_as_float(ov.w & 0xffff0000u)};
            const float zz[8] = {z0[0], z0[1], z0[2], z0[3], z1[0], z1[1], z1[2], z1[3]};
#pragma unroll
            for (int e = 0; e < 8; ++e) o[e] *= zz[e] / (1.0f + __expf(-zz[e]));
            v4u w; w.x = pk2(o[0], o[1]); w.y = pk2(o[2], o[3]); w.z = pk2(o[4], o[5]); w.w = pk2(o[6], o[7]);
            *(GAS v4u*)(oA + grow * 1024 + col) = w; }
    }
    __syncthreads();
#undef AT_SETBIT
}

__device__ __forceinline__ void attn_prep(const Params& p, bf16* qb, bf16* kvb, long gtid, long gsz) {
    const float* u = p.ws + W_U; const float* kv = p.ws + W_KV;
    for (long it = gtid; it < (long)M * 128; it += gsz) { const long row = it >> 7; const int c8 = (int)(it & 127) * 8;
        const f32x4 a = *(const f32x4*)(u + row * NU + c8), b = *(const f32x4*)(u + row * NU + c8 + 4);
        *(GAS v4u*)(qb + row * 1024 + c8) = __builtin_bit_cast(v4u, cvt8(a * C2, b * C2)); }
    for (long it = gtid; it < (long)M * 192; it += gsz) { const long row = it / 192; const int c8 = (int)(it % 192) * 8;
        const f32x4 a = *(const f32x4*)(kv + row * NKVC + c8), b = *(const f32x4*)(kv + row * NKVC + c8 + 4);
        *(GAS v4u*)(kvb + row * NKVC + c8) = __builtin_bit_cast(v4u, cvt8(a, b)); }
}

__device__ __forceinline__ void attn_phase(const Params& p, LAS unsigned char* L, const bf16* qb, const bf16* kvb) {
    const int G = gridDim.x, k = blockIdx.x;
    for (int r = 0; r * G < NT_P; ++r) {
        const int cnt = NT_P - r * G < G ? NT_P - r * G : G;
        if (k >= cnt) break;
        const int T = r * G + ((r & 1) ? cnt - 1 - k : k);
        TileCtx c; const int bg = T / (SEQ / TQ), qblk = T % (SEQ / TQ);
        c.b = bg / NKV; c.g = bg % NKV; c.t0 = qblk * TQ; c.rowbase = (size_t)c.b * SEQ + c.t0; c.sn0 = (size_t)c.b * NCP;
        attn_tile<false>(p, L, c, qb, kvb);
    }
    for (int T = k; T < NT_S; T += G) {
        TileCtx c; c.b = T / NKV; c.g = T % NKV; c.t0 = PAST; c.rowbase = (size_t)MP + (size_t)c.b * DSEQ; c.sn0 = (size_t)BATCH * NCP + (size_t)c.b * NCS;
        attn_tile<true>(p, L, c, qb, kvb);
    }
}
}

namespace cp {
using namespace nv;
typedef short bf16x8 __attribute__((ext_vector_type(8)));
constexpr int AS = 144, HS = 272;
constexpr int L_A = 0, A_BUF = 2 * 64 * AS, L_H = 2 * A_BUF, L_END = L_H + 2 * 64 * HS;
static_assert(L_END <= 131072 && NCS * CMPB <= PAST, "compress geometry");

template <int NB>
__device__ __forceinline__ void comp_unit(const Params& p, LAS unsigned char* L, int sn_first, const bf16* w1t, const bf16* w2t, const float* bias1, int tid) {
    constexpr int RT = NB / 4, TPB = 512 / NB, NV4 = NB / 4;
    const int wave = __builtin_amdgcn_readfirstlane(tid >> 6), lane = tid & 63, l15 = lane & 15, qd = lane >> 4;
    const int c = wave >> 2, pq = wave & 3;
    const int blk = tid / TPB, ck = tid % TPB, eo = ck * NB;
    const int sg = eo >> 7, sc = (eo >> 6) & 1, sd0 = eo & 63;
    const float* src; size_t tstride;
    { const int sn = sn_first + blk;
      if (sn < BATCH * NCP) { const int b = sn / NCP, n = sn % NCP; src = p.ws + W_KV + ((size_t)b * SEQ + (size_t)n * CMPB) * NKVC + eo; tstride = NKVC; }
      else { const int r = sn - BATCH * NCP, bs = r / NCS, n = r % NCS, pos0 = n * CMPB; const int pg = ((const int*)p.in[I_PT])[bs * NPAGES + (pos0 >> 7)];
             src = p.in[I_CCMP] + ((size_t)pg * PAGE + (pos0 & 127)) * KVG + eo; tstride = KVG; } }
    const unsigned dstoff = (unsigned)((sc * 64 + blk * 4 + sg) * AS + sd0 * 2);
    f32x4 ra[NV4], rb[NV4];
    auto ld = [&](f32x4 (&r)[NV4], int l) {
#pragma unroll
        for (int i = 0; i < NV4; ++i) r[i] = *(const f32x4*)(src + (size_t)l * tstride + 4 * i); };
    auto st = [&](const f32x4 (&r)[NV4], int buf) {
        LAS unsigned char* d = L + L_A + buf * A_BUF + dstoff;
        if constexpr (NB == 16) { *(LAS bf16x8*)d = at::cvt8(r[0], r[1]); *(LAS bf16x8*)(d + 16) = at::cvt8(r[2], r[3]); }
        else { *(LAS at::v2u*)d = (at::v2u){pk2(r[0][0], r[0][1]), pk2(r[0][2], r[0][3])}; } };
    const bf16* wb = w1t + (((size_t)c * 64) * 128 + 32 * pq + l15) * 64 + 8 * qd;
    auto ldb = [&](bf16x8 (&b)[2][2], int l) {
#pragma unroll
        for (int ct = 0; ct < 2; ++ct)
#pragma unroll
            for (int ks = 0; ks < 2; ++ks) b[ct][ks] = *(const bf16x8*)(wb + ((size_t)l * 128 + 16 * ct) * 64 + 32 * ks); };
    f32x4 acc[RT][2];
#pragma unroll
    for (int rt = 0; rt < RT; ++rt)
#pragma unroll
        for (int ct = 0; ct < 2; ++ct) acc[rt][ct] = (f32x4){0.f, 0.f, 0.f, 0.f};
    auto compute = [&](int buf, const bf16x8 (&b)[2][2]) {
        const LAS unsigned char* a0 = L + L_A + buf * A_BUF + (c * 64 + l15) * AS + 16 * qd;
#pragma unroll
        for (int ks = 0; ks < 2; ++ks)
#pragma unroll
            for (int rt = 0; rt < RT; ++rt) { const bf16x8 a = *(const LAS bf16x8*)(a0 + 16 * rt * AS + 64 * ks);
#pragma unroll
                for (int ct = 0; ct < 2; ++ct) acc[rt][ct] = __builtin_amdgcn_mfma_f32_16x16x32_bf16(a, b[ct][ks], acc[rt][ct], 0, 0, 0); } };
    bf16x8 b0[2][2], b1[2][2];
    ld(ra, 0); ld(rb, 1); ldb(b0, 0);
    st(ra, 0);
    __syncthreads();
    for (int l = 0; l < CMPB; l += 2) {
        if (l + 2 < CMPB) ld(ra, l + 2);
        ldb(b1, l + 1);
        compute(0, b0);
        st(rb, 1);
        __syncthreads();
        if (l + 3 < CMPB) ld(rb, l + 3);
        if (l + 2 < CMPB) ldb(b0, l + 2);
        compute(1, b1);
        if (l + 2 < CMPB) st(ra, 0);
        __syncthreads();
    }
    {
        LAS unsigned short* H = (LAS unsigned short*)(L + L_H);
#pragma unroll
        for (int ct = 0; ct < 2; ++ct) { const int pp = 32 * pq + 16 * ct + l15; const float bz = bias1[c * DPHI + pp];
#pragma unroll
            for (int rt = 0; rt < RT; ++rt)
#pragma unroll
                for (int r = 0; r < 4; ++r) { const float x = acc[rt][ct][r] + bz; const float hv = x / (1.0f + __expf(-x));
                    H[((c * 64 + 16 * rt + 4 * qd + r) * HS) / 2 + pp] = (unsigned short)f2bf(hv); } }
    }
    __syncthreads();
    {
        f32x4 o2[RT];
#pragma unroll
        for (int rt = 0; rt < RT; ++rt) o2[rt] = (f32x4){0.f, 0.f, 0.f, 0.f};
        const bf16* w2 = w2t + ((size_t)(c * 64 + 16 * pq + l15)) * 128 + 8 * qd;
#pragma unroll
        for (int ks = 0; ks < 4; ++ks) { const bf16x8 b = *(const bf16x8*)(w2 + 32 * ks);
#pragma unroll
            for (int rt = 0; rt < RT; ++rt) { const bf16x8 a = *(const LAS bf16x8*)(L + L_H + (c * 64 + 16 * rt + l15) * HS + (32 * ks + 8 * qd) * 2);
                o2[rt] = __builtin_amdgcn_mfma_f32_16x16x32_bf16(a, b, o2[rt], 0, 0, 0); } }
        const int dd = 16 * pq + l15; const float b2 = p.in[I_BPHI2][c * HD + dd];
        float* comp = p.ws + W_COMP;
#pragma unroll
        for (int rt = 0; rt < RT; ++rt)
#pragma unroll
            for (int r = 0; r < 4; ++r) { const int row = 16 * rt + 4 * qd + r; const int sn = sn_first + (row >> 2), g = row & 3;
                comp[((size_t)sn * NKV + g) * 128 + c * HD + dd] = o2[rt][r] + b2; }
    }
    __syncthreads();
}

__device__ __forceinline__ void comp_bias(const Params& p, float* bias1, int gw, int ngw, int lane) {
    for (int o = gw; o < 2 * DPHI; o += ngw) { const int c = o / DPHI, pp = o % DPHI; float s = 0.f;
        for (int i = lane; i < CMPB * HD; i += 64) { const int l = i >> 6, d = i & 63; s += p.in[I_PE][((size_t)l * 2 + c) * HD + d] * p.in[I_WPHI1][(((size_t)c * CMPB + l) * HD + d) * DPHI + pp]; }
#pragma unroll
        for (int sh = 1; sh < 64; sh <<= 1) s += __shfl_xor(s, sh);
        if (lane == 0) bias1[o] = s + p.in[I_BPHI1][o]; }
}
}

namespace ms {
using namespace nv;
__device__ __forceinline__ float wave_sum(float v) {
#pragma unroll
    for (int o = 1; o < 64; o <<= 1) v += __shfl_xor(v, o);
    return v;
}
constexpr int ADA_TILES = 2 * (3 * D / 64);
__device__ __forceinline__ void ada_phase(const Params& p, LAS unsigned char* L, int tid) {
    const int wave = __builtin_amdgcn_readfirstlane(tid >> 6), lane = tid & 63;
    LAS float* sc = (LAS float*)L;
    LAS float* red = (LAS float*)(L + 17 * 1024 * 4);
    static_assert(NC <= 34, "ada tile assumes at most 34 condition rows");
    float* mod = p.ws + W_MOD;
    for (int tile = blockIdx.x; tile < ADA_TILES; tile += gridDim.x) {
        const int layer = tile / (3 * D / 64), n = (tile % (3 * D / 64)) * 64 + lane;
        const float* w = p.in[I_WADA] + (size_t)layer * D * 3 * D + n;
        for (int half = 0; half < 2; ++half) {
            const int r0 = half * 17, nr = NC - r0 < 17 ? NC - r0 : 17;
            __syncthreads();
            for (int i = tid; i < nr * 1024; i += 512) { const int r = r0 + (i >> 10), k = i & 1023;
                const float cv = r < BATCH ? p.in[I_CP][(size_t)r * D + k] : p.in[I_CS][(size_t)(r - BATCH) * D + k]; sc[i] = cv / (1.0f + __expf(-cv)); }
            __syncthreads();
            float acc[17];
#pragma unroll
            for (int r = 0; r < 17; ++r) acc[r] = 0.f;
            for (int kk = 0; kk < 128; ++kk) { const int k = wave * 128 + kk; const float wv = w[(size_t)k * 3 * D];
#pragma unroll
                for (int r = 0; r < 17; ++r) acc[r] += sc[r * 1024 + k] * wv; }
#pragma unroll
            for (int r = 0; r < 17; ++r) red[(wave * 17 + r) * 64 + lane] = acc[r];
            __syncthreads();
            for (int i = tid; i < nr * 64; i += 512) { const int r = i >> 6, c = i & 63; float s = 0.f;
#pragma unroll
                for (int wv = 0; wv < 8; ++wv) s += red[(wv * 17 + r) * 64 + c];
                const int nn = (tile % (3 * D / 64)) * 64 + c;
                mod[((size_t)layer * NC + r0 + r) * 3 * D + nn] = s + p.in[I_BADA][layer * 3 * D + nn]; }
        }
    }
    __syncthreads();
}
__device__ __forceinline__ void mod0_phase(const Params& p, long gtid, long gsz) {
    const float* mod = p.ws + W_MOD; bf16* mA = (bf16*)(p.ws + W_BFA);
    for (long it = gtid; it < (long)M * 128; it += gsz) { const long row = it >> 7; const int c8 = (int)(it & 127) * 8; const int ci = cond_of((int)row);
        const float* x = row < MP ? p.in[I_XP] + row * D + c8 : p.in[I_XS] + (row - MP) * D + c8;
        const float* sh = mod + (size_t)ci * 3 * D + c8; const float* scl = sh + D;
        const f32x4 x0 = *(const f32x4*)x, x1 = *(const f32x4*)(x + 4), s0 = *(const f32x4*)scl, s1 = *(const f32x4*)(scl + 4), h0 = *(const f32x4*)sh, h1 = *(const f32x4*)(sh + 4);
        *(GAS v4u*)(mA + row * 1024 + c8) = __builtin_bit_cast(v4u, at::cvt8(x0 * (1.0f + s0) + h0, x1 * (1.0f + s1) + h1)); }
}
template <int LAYER> __device__ __forceinline__ void ln_phase(const Params& p, int tid) {
    const int wave = __builtin_amdgcn_readfirstlane(tid >> 6), lane = tid & 63;
    const float* f = p.ws + W_F; const float* lg = p.in[I_LNG] + LAYER * D; const float* lb = p.in[I_LNB] + LAYER * D;
    for (int row = blockIdx.x * 8 + wave; row < M; row += gridDim.x * 8) {
        const int ci = cond_of(row);
        const float* x = LAYER == 0 ? (row < MP ? p.in[I_XP] + (size_t)row * D : p.in[I_XS] + (size_t)(row - MP) * D) : p.ws + W_X1 + (size_t)row * D;
        const float* gt = p.ws + W_MOD + ((size_t)LAYER * NC + ci) * 3 * D + 2 * D;
        f32x4 v[4]; float s = 0.f;
#pragma unroll
        for (int j = 0; j < 4; ++j) { const int o = 4 * lane + 256 * j; const f32x4 xv = *(const f32x4*)(x + o), fv = *(const f32x4*)(f + (size_t)row * D + o), gv = *(const f32x4*)(gt + o);
            v[j] = ALPHA * xv + (1.0f + gv) * fv; s += (v[j][0] + v[j][1]) + (v[j][2] + v[j][3]); }
        const float mu = wave_sum(s) * (1.0f / D); float s2 = 0.f;
#pragma unroll
        for (int j = 0; j < 4; ++j) { v[j] = v[j] - mu; s2 += (v[j][0] * v[j][0] + v[j][1] * v[j][1]) + (v[j][2] * v[j][2] + v[j][3] * v[j][3]); }
        const float rstd = 1.0f / sqrtf(wave_sum(s2) * (1.0f / D) + LN_EPS);
#pragma unroll
        for (int j = 0; j < 4; ++j) { const int o = 4 * lane + 256 * j; const f32x4 y = v[j] * rstd * *(const f32x4*)(lg + o) + *(const f32x4*)(lb + o);
            if (LAYER == 0) {
                *(f32x4*)(p.ws + W_X1 + (size_t)row * D + o) = y;
                const float* sh = p.ws + W_MOD + ((size_t)NC + ci) * 3 * D + o; const f32x4 m1 = y * (1.0f + *(const f32x4*)(sh + D)) + *(const f32x4*)sh;
                *(GAS at::v2u*)((bf16*)(p.ws + W_BFB) + (size_t)row * D + o) = (at::v2u){pk2(y[0], y[1]), pk2(y[2], y[3])};
                *(GAS at::v2u*)((bf16*)(p.ws + W_BFA) + (size_t)row * D + o) = (at::v2u){pk2(m1[0], m1[1]), pk2(m1[2], m1[3])};
            } else {
                float* dst = row < MP ? p.out + O_YP + (size_t)row * D + o : p.out + O_YS + (size_t)(row - MP) * D + o;
                *(f32x4*)dst = y;
            } }
    }
}
}

constexpr int NTHREADS = 512, NWAVES = 8;
constexpr int LDS_BYTES = 147456;
constexpr int RING_OFF = 0;
constexpr int MISC_OFF = 131072 + 320;
constexpr int NKVIN = 3840;
constexpr long W_WT_INA = nv::W_END2, W_WT_OUTA = W_WT_INA + 2048L * 1024 / 2, W_WT_KVIN = W_WT_OUTA + 1024L * 1024 / 2,
    W_WT_OUTB = W_WT_KVIN + (long)NKVIN * 1024 / 2, W_AGG = W_WT_OUTB + 1024L * 1024 / 2, W_W1T = W_AGG + 2L * nv::BATCH * (nv::SEQ / 128) * 1024, W_W2T = W_W1T + 2L * 64 * 128 * 64 / 2,
    W_B1 = W_W2T + 2L * 64 * 128 / 2, W_FAST_END = W_B1 + 256;
constexpr size_t CTL_BYTES = 1u << 20;
constexpr size_t WS_CTL_OFF = ((size_t)W_FAST_END * 4 + 4095) / 4096 * 4096;
constexpr int CW_BAR = 4096;
struct Args { nv::Params p; unsigned char* ctl; };
static_assert(nv::D == 1024 && nv::M % 256 == 0, "fast GEMM path is built for d_model 1024 and M % 256 == 0");

__device__ __forceinline__ void p0_prologue(const nv::Params& p, LAS unsigned char* L, int wave, int lane) {
    LAS float* scr = (LAS float*)(L + RING_OFF + wave * 16384);
    const int gw = blockIdx.x * NWAVES + wave, NGW = gridDim.x * NWAVES;
    bf16* wt_ina = (bf16*)(p.ws + W_WT_INA); bf16* wt_outa = (bf16*)(p.ws + W_WT_OUTA); bf16* wt_kvin = (bf16*)(p.ws + W_WT_KVIN); bf16* wt_outb = (bf16*)(p.ws + W_WT_OUTB);
    constexpr int I_A = 16 * (2048 / 32), I_B = 16 * (1024 / 32), I_C = 16 * (1536 / 32), I_D = 16 * ((nv::NU + 31) / 32), I_E = 16 * (1024 / 32), I_F = 2 * 64 * 4, I_G = 2 * 4;
    bf16* w1t = (bf16*)(p.ws + W_W1T); bf16* w2t = (bf16*)(p.ws + W_W2T);
    for (int it = gw; it < I_A + I_B + I_C + I_D + I_E + I_F + I_G; it += NGW) {
        int r = it;
        if (r < I_A) { wt_transpose_item(p.in[nv::I_WINA], 1024, 2048, wt_ina, 0, scr, r, lane); continue; } r -= I_A;
        if (r < I_B) { wt_transpose_item(p.in[nv::I_WOUTA], 1024, 1024, wt_outa, 0, scr, r, lane); continue; } r -= I_B;
        if (r < I_C) { wt_transpose_item(p.in[nv::I_WKV], 1024, 1536, wt_kvin, 0, scr, r, lane); continue; } r -= I_C;
        if (r < I_D) { wt_transpose_item(p.in[nv::I_WINB], 1024, nv::NU, wt_kvin, 1536, scr, r, lane); continue; } r -= I_D;
        if (r < I_E) { wt_transpose_item(p.in[nv::I_WOUTB], 1024, 1024, wt_outb, 0, scr, r, lane); continue; } r -= I_E;
        if (r < I_F) { const int cl = r >> 2; wt_transpose_item(p.in[nv::I_WPHI1] + (size_t)cl * 64 * 128, 64, 128, w1t + (size_t)cl * 128 * 64, 0, scr, r & 3, lane); continue; } r -= I_F;
        { const int c = r >> 2; wt_transpose_item(p.in[nv::I_WPHI2] + (size_t)c * 128 * 64, 128, 64, w2t + (size_t)c * 64 * 128, 0, scr, r & 3, lane); }
    }
    cp::comp_bias(p, p.ws + W_B1, gw, NGW, lane);
    constexpr int ZR0 = 1536 + ((nv::NU + 31) / 32) * 32;
    for (long i = (long)blockIdx.x * NTHREADS + opaque_tid(); i < (long)(NKVIN - ZR0) * 1024 / 8; i += (long)gridDim.x * NTHREADS)
        ((GAS v4u*)(wt_kvin + (size_t)ZR0 * 1024))[i] = (v4u){0u, 0u, 0u, 0u};
}

__global__ void __launch_bounds__(NTHREADS, 2) mk_fwd(Args args) {
    extern __shared__ __attribute__((aligned(16))) unsigned char lds[];
    LAS unsigned char* L = (LAS unsigned char*)lds;
    volatile LAS unsigned* MISC = (volatile LAS unsigned*)(L + MISC_OFF);
    for (int u = threadIdx.x; u < 32; u += NTHREADS) MISC[u] = 0u;
    __syncthreads();
    XcdBarrier bar = xcd_barrier_post((unsigned*)(args.ctl) + CW_BAR, MISC + 8);
    const long gsz = (long)gridDim.x * NTHREADS;
    const nv::Params& p = args.p;
    const int G = gridDim.x;
#define NAIVE(k) nv::run_phase<k>(p, (long)blockIdx.x * NTHREADS + opaque_tid(), gsz)
#define BAR() xcd_barrier(bar)
    { const int t_ = opaque_tid(); p0_prologue(p, L, __builtin_amdgcn_readfirstlane(t_ >> 6), t_ & 63); } ms::ada_phase(p, L, opaque_tid()); BAR();
    ms::mod0_phase(p, (long)blockIdx.x * NTHREADS + opaque_tid(), gsz);
    { const int t_ = opaque_tid();
      for (int uu = blockIdx.x; uu < nv::DECB * nv::NCS / 16; uu += G) cp::comp_unit<16>(p, L, nv::BATCH * nv::NCP + uu * 16, (const bf16*)(p.ws + W_W1T), (const bf16*)(p.ws + W_W2T), p.ws + W_B1, t_); }
    BAR();
    {
        pg8::Gemm g{(const pg8::bf16_t*)(p.ws + nv::W_BFA), (const pg8::bf16_t*)(p.ws + W_WT_INA), nv::M, 2048, 1024, (const pg8::bf16_t*)(p.ws + nv::W_BFA), 1 << 30};
        pg8::StaticOrder S; S.init(nv::M, 2048, G, (int)blockIdx.x);
        pg8::EpiF32Split E{p.ws + nv::W_U0, 2048, 2048, nullptr, 0, 0};
        pg8::gemm_phase<pg8::EpiF32Split, pg8::StaticOrder, true, true>(L + RING_OFF, g, S, E);
    }
    BAR();
    rg::rg_pass<1>(p, L, p.ws + W_AGG); BAR();
    rg::rg_pass<2>(p, L, p.ws + W_AGG); BAR();
    {
        pg8::Gemm g{(const pg8::bf16_t*)(p.ws + nv::W_BFA), (const pg8::bf16_t*)(p.ws + W_WT_OUTA), nv::M, 1024, 1024, (const pg8::bf16_t*)(p.ws + nv::W_BFA), 1 << 30};
        pg8::StaticOrder S; S.init(nv::M, 1024, G, (int)blockIdx.x);
        pg8::EpiF32Split E{p.ws + nv::W_F, 1024, 1024, nullptr, 0, 0};
        pg8::gemm_phase<pg8::EpiF32Split, pg8::StaticOrder, true, true>(L + RING_OFF, g, S, E);
    }
    BAR();
    ms::ln_phase<0>(p, opaque_tid()); BAR();
    {
        pg8::Gemm g{(const pg8::bf16_t*)(p.ws + nv::W_BFB), (const pg8::bf16_t*)(p.ws + W_WT_KVIN), nv::M, NKVIN, 1024, (const pg8::bf16_t*)(p.ws + nv::W_BFA), 6};
        pg8::StaticOrder S; S.init(nv::M, NKVIN, G, (int)blockIdx.x);
        pg8::EpiF32Split E{p.ws + nv::W_KV, nv::NKVC, nv::NKVC, p.ws + nv::W_U, nv::NU, nv::NU};
        pg8::gemm_phase<pg8::EpiF32Split, pg8::StaticOrder, true, true>(L + RING_OFF, g, S, E);
    }
    BAR();
    nv::ph_outputs(p, (long)blockIdx.x * NTHREADS + opaque_tid(), gsz); at::attn_prep(p, (bf16*)(p.ws + nv::W_BFB), (bf16*)(p.ws + nv::W_PC), (long)blockIdx.x * NTHREADS + opaque_tid(), gsz);
    { const int t_ = opaque_tid();
      for (int uu = blockIdx.x; uu < nv::BATCH * nv::NCP / 4; uu += G) cp::comp_unit<4>(p, L, uu * 4, (const bf16*)(p.ws + W_W1T), (const bf16*)(p.ws + W_W2T), p.ws + W_B1, t_); }
    BAR();
    at::attn_phase(p, L, (const bf16*)(p.ws + nv::W_BFB), (const bf16*)(p.ws + nv::W_PC)); BAR();
    {
        pg8::Gemm g{(const pg8::bf16_t*)(p.ws + nv::W_BFA), (const pg8::bf16_t*)(p.ws + W_WT_OUTB), nv::M, 1024, 1024, (const pg8::bf16_t*)(p.ws + nv::W_BFA), 1 << 30};
        pg8::StaticOrder S; S.init(nv::M, 1024, G, (int)blockIdx.x);
        pg8::EpiF32Split E{p.ws + nv::W_F, 1024, 1024, nullptr, 0, 0};
        pg8::gemm_phase<pg8::EpiF32Split, pg8::StaticOrder, true, true>(L + RING_OFF, g, S, E);
    }
    BAR();
    ms::ln_phase<1>(p, opaque_tid());
#undef NAIVE
#undef BAR
}

extern "C" void kernel_launch(void* const* d_in, const int* in_sizes, int n_in,
                              void* d_out, int out_size, void* d_ws, size_t ws_size,
                              hipStream_t stream) {
    static int grid = 0;
    if (grid == 0) {
        if (n_in != nv::I_N || out_size != (int)nv::O_END || ws_size < WS_CTL_OFF + CTL_BYTES) { fprintf(stderr, "kernel_launch: unexpected sizes n_in %d out %d ws %zu\n", n_in, out_size, ws_size); grid = -1; return; }
        int dev = 0, cus = 0, per_cu = 0;
        if (hipGetDevice(&dev) != hipSuccess || hipDeviceGetAttribute(&cus, hipDeviceAttributeMultiprocessorCount, dev) != hipSuccess) { grid = -1; return; }
        if (hipFuncSetAttribute((const void*)mk_fwd, hipFuncAttributeMaxDynamicSharedMemorySize, LDS_BYTES) != hipSuccess) { fprintf(stderr, "kernel_launch: hipFuncSetAttribute failed\n"); grid = -1; return; }
        if (hipOccupancyMaxActiveBlocksPerMultiprocessor(&per_cu, (const void*)mk_fwd, NTHREADS, LDS_BYTES) != hipSuccess || per_cu < 1) fprintf(stderr, "kernel_launch: occupancy query reports %d\n", per_cu);
        (void)hipGetLastError();
        grid = cus;
    }
    if (grid < 0) return;
    unsigned char* ctl = (unsigned char*)d_ws + WS_CTL_OFF;
    if (hipMemsetAsync(ctl, 0, CTL_BYTES, stream) != hipSuccess) return;
    Args a{};
    for (int i = 0; i < nv::I_N; ++i) a.p.in[i] = (const float*)d_in[i];
    a.p.out = (float*)d_out; a.p.ws = (float*)d_ws; a.ctl = ctl;
    hipLaunchKernelGGL(mk_fwd, dim3(grid), dim3(NTHREADS), LDS_BYTES, stream, a);
}
```

```cpp
#include <hip/hip_runtime.h>
#include <cstdio>
#include <cstdint>
#ifndef CFG_D
#define CFG_D 1024
#define CFG_BATCH 2
#define CFG_SEQ 8192
#define CFG_DECB 32
#define CFG_PAST 8192
#define CFG_NRG 8
#define CFG_NH 16
#define CFG_NKV 4
#endif
namespace nv {
constexpr int D = CFG_D, BATCH = CFG_BATCH, SEQ = CFG_SEQ, DECB = CFG_DECB, DSEQ = 8, PAST = CFG_PAST, PAGE = 128;
constexpr int NRG = CFG_NRG, RGB = D / NRG, NH = CFG_NH, HD = 64, NKV = CFG_NKV, HPG = NH / NKV;
static_assert(D == NH * HD && HPG == 4, "geometry");
constexpr int CMPB = 64, NSEL = 16, WIN = 512, DPHI = 128;
constexpr int MP = BATCH * SEQ, MS = DECB * DSEQ, M = MP + MS, NC = BATCH + DECB;
constexpr int NKVC = 3 * NKV * 2 * HD;
constexpr int KVG = NKV * 2 * HD;
constexpr int NU = 2 * D + 3 * NH;
constexpr int NCP = SEQ / CMPB, NCS = (PAST + DSEQ) / CMPB, NSBS = (PAST + DSEQ + CMPB - 1) / CMPB;
constexpr int NSBMAX = ((NCP > NSBS ? NCP : NSBS) + 7) / 8 * 8;
constexpr int NPAGES = PAST / PAGE;
constexpr int NSEQN = BATCH * NCP + DECB * NCS;
constexpr float ALPHA = 1.4142135623730951f;
constexpr float LN_EPS = 1e-5f;
static_assert(PAST >= WIN && SEQ >= WIN, "window geometry");

constexpr long O_YP = 0, O_YS = O_YP + (long)MP * D, O_CMPP = O_YS + (long)MS * D, O_SELP = O_CMPP + (long)MP * KVG,
    O_WINP = O_SELP + (long)MP * KVG, O_HP = O_WINP + (long)BATCH * WIN * KVG, O_CONVP = O_HP + (long)BATCH * D,
    O_CMPS = O_CONVP + (long)BATCH * 3 * D, O_SELS = O_CMPS + (long)MS * KVG, O_WINS = O_SELS + (long)MS * KVG,
    O_HS = O_WINS + (long)DECB * WIN * KVG, O_CONVS = O_HS + (long)DECB * D, O_END = O_CONVS + (long)DECB * 3 * D;

enum { I_XP, I_XS, I_CP, I_CS, I_STH, I_STC, I_CCMP, I_CSEL, I_SWIN, I_PT, I_WADA, I_BADA, I_LNG, I_LNB, I_WINA, I_CONVW, I_CONVB,
       I_WR, I_BR, I_WI, I_BI, I_LAM, I_WOUTA, I_WKV, I_PE, I_WPHI1, I_BPHI1, I_WPHI2, I_BPHI2, I_WINB, I_BGATE, I_WOUTB, I_N };

struct WS {
    float *mod, *mA, *u0, *xc, *ga, *gb, *fbuf, *x1, *kv, *u, *hid, *comp, *pc, *ocmp, *osel, *owin, *obuf; int* idx;
};
constexpr long al(long x) { return (x + 63) / 64 * 64; }
constexpr long W_MOD = 0, W_MA = W_MOD + al(2L * NC * 3 * D), W_U0 = W_MA + al((long)M * D), W_XC = W_U0 + al((long)M * 2 * D),
    W_GA = W_XC + al((long)M * D), W_GB = W_GA + al((long)M * D), W_F = W_GB + al((long)M * D), W_X1 = W_F + al((long)M * D),
    W_KV = W_X1 + al((long)M * D), W_U = W_KV + al((long)M * NKVC), W_HID = W_U + al((long)M * NU),
    W_COMP = W_HID + al((long)NSEQN * NKV * 2 * DPHI), W_PC = W_COMP + al((long)NSEQN * NKV * 2 * HD),
    W_OCMP = W_PC + al((long)M * NH * NSBMAX), W_OSEL = W_OCMP + al((long)M * D), W_OWIN = W_OSEL + al((long)M * D),
    W_OBUF = W_OWIN + al((long)M * D), W_IDX = W_OBUF + al((long)M * D), W_END = W_IDX + al((long)M * NKV * NSEL);

constexpr long W_BFA = W_END, W_BFB = W_BFA + al((long)M * D / 2), W_END2 = W_BFB + al((long)M * D / 2);
struct Params { const float* in[I_N]; float* out; float* ws; };
static inline
#ifndef HOST_EMU
__device__
#endif
unsigned short f2bf_rne(float f) { unsigned u; __builtin_memcpy(&u, &f, 4); return (unsigned short)((u + 0x7fffu + ((u >> 16) & 1u)) >> 16); }

#ifdef HOST_EMU
#define NV_DEV static inline
#else
#define NV_DEV __device__ __forceinline__
#endif

NV_DEV float silu_f(float x) { return x / (1.0f + expf(-x)); }
NV_DEV float sigm_f(float x) { return 1.0f / (1.0f + expf(-x)); }
NV_DEV int cond_of(int row) { return row < MP ? row / SEQ : BATCH + (row - MP) / DSEQ; }
NV_DEV int pos_of(int row) { return row < MP ? row % SEQ : PAST + (row - MP) % DSEQ; }
NV_DEV float slope_of(int H) { return exp2f(-8.0f * (float)(H + 1) / (float)NH); }

NV_DEV void ph_ada(const Params& p, long gtid, long gsz) {
    float* mod = p.ws + W_MOD;
    for (long it = gtid; it < 2L * NC * 3 * D; it += gsz) {
        const int n = (int)(it % (3 * D)); const int ci = (int)((it / (3 * D)) % NC); const int layer = (int)(it / (3L * D * NC));
        const float* c = ci < BATCH ? p.in[I_CP] + (long)ci * D : p.in[I_CS] + (long)(ci - BATCH) * D;
        const float* w = p.in[I_WADA] + (long)layer * D * 3 * D;
        float acc = 0.f;
        for (int k = 0; k < D; ++k) acc += silu_f(c[k]) * w[(long)k * 3 * D + n];
        mod[it] = acc + p.in[I_BADA][layer * 3 * D + n];
    }
}
NV_DEV void ph_mod(const Params& p, int layer, long gtid, long gsz) {
    const float* mod = p.ws + W_MOD + (long)layer * NC * 3 * D; float* mA = p.ws + W_MA;
    for (long it = gtid; it < (long)M * D; it += gsz) {
        const int row = (int)(it / D), k = (int)(it % D); const int ci = cond_of(row);
        float x;
        if (layer == 0) x = row < MP ? p.in[I_XP][it] : p.in[I_XS][it - (long)MP * D];
        else x = (p.ws + W_X1)[it];
        const float v = x * (1.0f + mod[(long)ci * 3 * D + D + k]) + mod[(long)ci * 3 * D + k];
        mA[it] = v; ((unsigned short*)(p.ws + W_BFA))[it] = f2bf_rne(v);
    }
}
NV_DEV void gemm_naive(const float* A, int lda, const float* W, int ldw, float* C, int ldc, int Mr, int N, int K, long gtid, long gsz) {
    for (long it = gtid; it < (long)(Mr / 4) * N; it += gsz) {
        const int n = (int)(it % N); const long r0 = (it / N) * 4;
        float a0 = 0.f, a1 = 0.f, a2 = 0.f, a3 = 0.f;
        const float* A0 = A + r0 * lda;
        for (int k = 0; k < K; ++k) { const float w = W[(long)k * ldw + n];
            a0 += A0[k] * w; a1 += A0[lda + k] * w; a2 += A0[2 * lda + k] * w; a3 += A0[3 * lda + k] * w; }
        C[r0 * ldc + n] = a0; C[(r0 + 1) * ldc + n] = a1; C[(r0 + 2) * ldc + n] = a2; C[(r0 + 3) * ldc + n] = a3;
    }
}
NV_DEV void ph_conv(const Params& p, long gtid, long gsz) {
    const float* u0 = p.ws + W_U0; float* xc = p.ws + W_XC;
    for (long it = gtid; it < (long)M * D; it += gsz) {
        const int row = (int)(it / D), d = (int)(it % D);
        const int t = row < MP ? row % SEQ : (row - MP) % DSEQ;
        float acc = p.in[I_CONVB][d];
        for (int k = 0; k < 4; ++k) { const int j = t - 3 + k;
            float v;
            if (j >= 0) v = u0[(long)(row - t + j) * 2 * D + d];
            else v = row < MP ? 0.f : p.in[I_STC][((long)((row - MP) / DSEQ) * 3 + (3 + j)) * D + d];
            acc += v * p.in[I_CONVW][k * D + d]; }
        xc[it] = acc;
    }
}
NV_DEV void ph_gates(const Params& p, long gtid, long gsz) {
    const float* xc = p.ws + W_XC; float* ga = p.ws + W_GA; float* gb = p.ws + W_GB;
    for (long it = gtid; it < (long)M * D; it += gsz) {
        const int row = (int)(it / D), d = (int)(it % D); const int n = d / RGB, dd = d % RGB;
        const float* x = xc + (long)row * D + n * RGB;
        const float* wr = p.in[I_WR] + (long)n * RGB * RGB + dd; const float* wi = p.in[I_WI] + (long)n * RGB * RGB + dd;
        float ar = 0.f, ai = 0.f;
        for (int c = 0; c < RGB; ++c) { ar += x[c] * wr[(long)c * RGB]; ai += x[c] * wi[(long)c * RGB]; }
        const float r = sigm_f(ar + p.in[I_BR][d]), i = sigm_f(ai + p.in[I_BI][d]);
        const float lam = p.in[I_LAM][d];
        const float sp = (-lam > 20.f) ? -lam : log1pf(expf(-lam));
        const float log_a = -8.0f * sp * r;
        const float a = expf(log_a);
        const float gain = sqrtf(fmaxf(-expm1f(2.0f * log_a), 0.f));
        float b = gain * i * xc[it];
        const int t = row < MP ? row % SEQ : (row - MP) % DSEQ;
        if (t == 0 && row >= MP) b += a * p.in[I_STH][(long)((row - MP) / DSEQ) * D + d];
        ga[it] = a; gb[it] = b;
    }
}
NV_DEV void ph_scan(const Params& p, long gtid, long gsz) {
    const float* ga = p.ws + W_GA; float* gb = p.ws + W_GB;
    for (long it = gtid; it < (long)NC * D; it += gsz) {
        const int sq = (int)(it / D), d = (int)(it % D);
        const long row0 = sq < BATCH ? (long)sq * SEQ : MP + (long)(sq - BATCH) * DSEQ; const int T = sq < BATCH ? SEQ : DSEQ;
        float h = 0.f;
        for (int t = 0; t < T; ++t) { const long o = (row0 + t) * D + d; h = ga[o] * h + gb[o]; gb[o] = h; }
        if (sq < BATCH) p.out[O_HP + (long)sq * D + d] = h; else p.out[O_HS + (long)(sq - BATCH) * D + d] = h;
    }
}
NV_DEV void ph_gated(const Params& p, long gtid, long gsz) {
    const float* hs = p.ws + W_GB; const float* u0 = p.ws + W_U0; float* mA = p.ws + W_MA;
    for (long it = gtid; it < (long)M * D; it += gsz) { const long row = it / D; const int d = (int)(it % D);
        const float v = hs[it] * silu_f(u0[row * 2 * D + D + d]); mA[it] = v; ((unsigned short*)(p.ws + W_BFA))[it] = f2bf_rne(v); }
}
NV_DEV void ph_ln(const Params& p, int layer, long gtid, long gsz) {
    const float* mod = p.ws + W_MOD + (long)layer * NC * 3 * D; const float* f = p.ws + W_F;
    for (long row = gtid; row < M; row += gsz) {
        const int ci = cond_of((int)row);
        const float* x = layer == 0 ? (row < MP ? p.in[I_XP] + row * D : p.in[I_XS] + (row - MP) * D) : p.ws + W_X1 + row * D;
        const float* gt = mod + (long)ci * 3 * D + 2 * D; const float* fr = f + row * D;
        float s = 0.f;
        for (int k = 0; k < D; ++k) s += ALPHA * x[k] + (1.0f + gt[k]) * fr[k];
        const float mu = s / D; float v = 0.f;
        for (int k = 0; k < D; ++k) { const float e = ALPHA * x[k] + (1.0f + gt[k]) * fr[k] - mu; v += e * e; }
        const float rstd = 1.0f / sqrtf(v / D + LN_EPS);
        float* dst = layer == 0 ? p.ws + W_X1 + row * D : (row < MP ? p.out + O_YP + row * D : p.out + O_YS + (row - MP) * D);
        const float* lg = p.in[I_LNG] + layer * D; const float* lb = p.in[I_LNB] + layer * D;
        for (int k = 0; k < D; ++k) { const float v = (ALPHA * x[k] + (1.0f + gt[k]) * fr[k] - mu) * rstd * lg[k] + lb[k]; dst[k] = v;
            if (layer == 0) ((unsigned short*)(p.ws + W_BFB))[row * D + k] = f2bf_rne(v); }
    }
}
NV_DEV void ph_outputs(const Params& p, long gtid, long gsz) {
    const float* kv = p.ws + W_KV; const float* u0 = p.ws + W_U0;
    for (long it = gtid; it < (long)MP * KVG; it += gsz) { const long row = it / KVG; const int c = (int)(it % KVG);
        p.out[O_CMPP + it] = kv[row * NKVC + c]; p.out[O_SELP + it] = kv[row * NKVC + KVG + c]; }
    for (long it = gtid; it < (long)BATCH * WIN * KVG; it += gsz) { const int c = (int)(it % KVG); const int j = (int)((it / KVG) % WIN); const int b = (int)(it / ((long)KVG * WIN));
        p.out[O_WINP + it] = kv[((long)b * SEQ + SEQ - WIN + j) * NKVC + 2 * KVG + c]; }
    for (long it = gtid; it < (long)MS * KVG; it += gsz) { const long row = MP + it / KVG; const int c = (int)(it % KVG);
        p.out[O_CMPS + it] = kv[row * NKVC + c]; p.out[O_SELS + it] = kv[row * NKVC + KVG + c]; }
    for (long it = gtid; it < (long)DECB * WIN * KVG; it += gsz) { const int c = (int)(it % KVG); const int j = (int)((it / KVG) % WIN); const int bs = (int)(it / ((long)KVG * WIN));
        const int jj = j + DSEQ;
        p.out[O_WINS + it] = jj < WIN ? p.in[I_SWIN][((long)bs * WIN + jj) * KVG + c] : kv[((long)MP + bs * DSEQ + (jj - WIN)) * NKVC + 2 * KVG + c]; }
    for (long it = gtid; it < (long)BATCH * 3 * D; it += gsz) { const int d = (int)(it % D); const int j = (int)((it / D) % 3); const int b = (int)(it / (3 * D));
        p.out[O_CONVP + it] = u0[((long)b * SEQ + SEQ - 3 + j) * 2 * D + d]; }
    for (long it = gtid; it < (long)DECB * 3 * D; it += gsz) { const int d = (int)(it % D); const int j = (int)((it / D) % 3); const int bs = (int)(it / (3 * D));
        p.out[O_CONVS + it] = u0[((long)MP + bs * DSEQ + DSEQ - 3 + j) * 2 * D + d]; }
}
NV_DEV const float* cmp_src_row(const Params& p, int sn, int l, int& ok) {
    ok = 1;
    if (sn < BATCH * NCP) { const int b = sn / NCP, n = sn % NCP; return p.ws + W_KV + ((long)b * SEQ + n * CMPB + l) * NKVC; }
    const int r = sn - BATCH * NCP; const int bs = r / NCS, n = r % NCS; const int pos = n * CMPB + l;
    if (pos < PAST) { const int pg = ((const int*)p.in[I_PT])[bs * NPAGES + pos / PAGE]; return p.in[I_CCMP] + ((long)pg * PAGE + pos % PAGE) * KVG; }
    return p.ws + W_KV + ((long)MP + bs * DSEQ + (pos - PAST)) * NKVC;
}
NV_DEV void ph_comp1(const Params& p, long gtid, long gsz) {
    float* hid = p.ws + W_HID;
    for (long it = gtid; it < (long)NSEQN * NKV * 2 * DPHI; it += gsz) {
        const int pp = (int)(it % DPHI); const int c = (int)((it / DPHI) % 2); const int g = (int)((it / (2 * DPHI)) % NKV); const int sn = (int)(it / (2L * DPHI * NKV));
        float acc = 0.f;
        for (int l = 0; l < CMPB; ++l) { int ok; const float* src = cmp_src_row(p, sn, l, ok) + g * 2 * HD + c * HD;
            const float* pe = p.in[I_PE] + ((long)l * 2 + c) * HD; const float* w = p.in[I_WPHI1] + (((long)c * CMPB + l) * HD) * DPHI + pp;
            for (int d = 0; d < HD; ++d) acc += (src[d] + pe[d]) * w[(long)d * DPHI]; }
        hid[it] = silu_f(acc + p.in[I_BPHI1][c * DPHI + pp]);
    }
}
NV_DEV void ph_comp2(const Params& p, long gtid, long gsz) {
    const float* hid = p.ws + W_HID; float* comp = p.ws + W_COMP;
    for (long it = gtid; it < (long)NSEQN * NKV * 2 * HD; it += gsz) {
        const int d = (int)(it % HD); const int c = (int)((it / HD) % 2); const long sgc = it / HD;
        const float* h = hid + sgc * DPHI; const float* w = p.in[I_WPHI2] + (long)c * DPHI * HD + d;
        float acc = 0.f;
        for (int q = 0; q < DPHI; ++q) acc += h[q] * w[(long)q * HD];
        comp[it] = acc + p.in[I_BPHI2][c * HD + d];
    }
}
NV_DEV void ph_cmp_attn(const Params& p, long gtid, long gsz) {
    const float* u = p.ws + W_U; const float* comp = p.ws + W_COMP; float* pc = p.ws + W_PC; float* ocmp = p.ws + W_OCMP;
    for (long it = gtid; it < (long)M * NH; it += gsz) {
        const int row = (int)(it / NH), H = (int)(it % NH); const int g = H / HPG; const int t = pos_of(row);
        const int nc = row < MP ? NCP : NCS; const long sn0 = row < MP ? (long)(row / SEQ) * NCP : (long)BATCH * NCP + (long)((row - MP) / DSEQ) * NCS;
        const float sl = slope_of(H);
        float q[HD];
        for (int d = 0; d < HD; ++d) q[d] = u[(long)row * NU + H * HD + d] * 0.125f;
        float* pr = pc + ((long)row * NH + H) * NSBMAX;
        float m = -3.0e38f; int nvalid = 0;
        for (int n = 0; n < nc; ++n) { const int ce = n * CMPB + CMPB - 1;
            if (ce <= t) { const float* k = comp + ((sn0 + n) * NKV + g) * 2 * HD; float s = 0.f;
                for (int d = 0; d < HD; ++d) s += q[d] * k[d];
                s -= sl * (float)(t - ce); pr[n] = s; m = fmaxf(m, s); ++nvalid; } }
        float l = 0.f;
        for (int n = 0; n < nvalid; ++n) l += expf(pr[n] - m);
        float o[HD];
        for (int d = 0; d < HD; ++d) o[d] = 0.f;
        for (int n = 0; n < nvalid; ++n) { const float pn = expf(pr[n] - m) / l; pr[n] = pn;
            const float* v = comp + ((sn0 + n) * NKV + g) * 2 * HD + HD;
            for (int d = 0; d < HD; ++d) o[d] += pn * v[d]; }
        for (int n = nvalid; n < NSBMAX; ++n) pr[n] = 0.f;
        for (int d = 0; d < HD; ++d) ocmp[(long)row * D + H * HD + d] = o[d];
    }
}
NV_DEV void ph_topk(const Params& p, long gtid, long gsz) {
    float* pc = p.ws + W_PC; int* idx = (int*)(p.ws + W_IDX);
    for (long it = gtid; it < (long)M * NKV; it += gsz) {
        const int row = (int)(it / NKV), g = (int)(it % NKV); const int t = pos_of(row); const int cb = t / CMPB;
        const int nsb = row < MP ? NCP : NSBS; const int kk = nsb < NSEL ? nsb : NSEL;
        float* p0 = pc + ((long)row * NH + g * HPG) * NSBMAX;
        for (int j = 0; j < nsb; ++j) { const float imp = ((p0[j] + p0[NSBMAX + j]) + p0[2 * NSBMAX + j]) + p0[3 * NSBMAX + j];
            const bool forced = (j == 0) || (j == cb) || (j == cb - 1);
            p0[j] = forced ? 1.0e6f : (j <= cb ? imp : -1.0f); }
        for (int k = 0; k < NSEL; ++k) {
            if (k >= kk) { idx[it * NSEL + k] = -1; continue; }
            float best = -4.0f; int bj = 0;
            for (int j = 0; j < nsb; ++j) if (p0[j] > best) { best = p0[j]; bj = j; }
            p0[bj] = -5.0f; idx[it * NSEL + k] = bj; }
    }
}
NV_DEV void ph_sel(const Params& p, long gtid, long gsz) {
    const float* u = p.ws + W_U; const float* kv = p.ws + W_KV; const int* idx = (const int*)(p.ws + W_IDX); float* osel = p.ws + W_OSEL;
    for (long it = gtid; it < (long)M * NH; it += gsz) {
        const int row = (int)(it / NH), H = (int)(it % NH); const int g = H / HPG; const int t = pos_of(row); const float sl = slope_of(H);
        float q[HD], o[HD];
        for (int d = 0; d < HD; ++d) { q[d] = u[(long)row * NU + H * HD + d] * 0.125f; o[d] = 0.f; }
        float m = -3.0e38f, l = 0.f;
        for (int k = 0; k < NSEL; ++k) { const int blk = idx[((long)row * NKV + g) * NSEL + k]; if (blk < 0) continue;
            for (int j = 0; j < CMPB; ++j) { const int pos = blk * CMPB + j; if (pos > t) continue;
                const float* kr;
                if (row < MP) kr = kv + ((long)(row / SEQ) * SEQ + pos) * NKVC + KVG + g * 2 * HD;
                else { const int bs = (row - MP) / DSEQ;
                    if (pos < PAST) { const int pg = ((const int*)p.in[I_PT])[bs * NPAGES + pos / PAGE]; kr = p.in[I_CSEL] + ((long)pg * PAGE + pos % PAGE) * KVG + g * 2 * HD; }
                    else { int r = pos - PAST; if (r > DSEQ - 1) r = DSEQ - 1; kr = kv + ((long)MP + bs * DSEQ + r) * NKVC + KVG + g * 2 * HD; } }
                float s = 0.f;
                for (int d = 0; d < HD; ++d) s += q[d] * kr[d];
                s -= sl * (float)(t - pos);
                const float mn = fmaxf(m, s); const float sc = expf(m - mn), pe = expf(s - mn);
                l = l * sc + pe;
                for (int d = 0; d < HD; ++d) o[d] = o[d] * sc + pe * kr[HD + d];
                m = mn; } }
        const float inv = 1.0f / l;
        for (int d = 0; d < HD; ++d) osel[(long)row * D + H * HD + d] = o[d] * inv;
    }
}
NV_DEV void ph_win(const Params& p, long gtid, long gsz) {
    const float* u = p.ws + W_U; const float* kv = p.ws + W_KV; float* owin = p.ws + W_OWIN;
    for (long it = gtid; it < (long)M * NH; it += gsz) {
        const int row = (int)(it / NH), H = (int)(it % NH); const int g = H / HPG; const int t = pos_of(row); const float sl = slope_of(H);
        float q[HD], o[HD];
        for (int d = 0; d < HD; ++d) { q[d] = u[(long)row * NU + H * HD + d] * 0.125f; o[d] = 0.f; }
        float m = -3.0e38f, l = 0.f;
        const int p0 = t - WIN > 0 ? t - WIN : 0;
        for (int pos = p0; pos <= t; ++pos) {
            const float* kr;
            if (row < MP) kr = kv + ((long)(row / SEQ) * SEQ + pos) * NKVC + 2 * KVG + g * 2 * HD;
            else { const int bs = (row - MP) / DSEQ; const int j = pos - (PAST - WIN);
                if (j < WIN) kr = p.in[I_SWIN] + ((long)bs * WIN + j) * KVG + g * 2 * HD;
                else kr = kv + ((long)MP + bs * DSEQ + (j - WIN)) * NKVC + 2 * KVG + g * 2 * HD; }
            float s = 0.f;
            for (int d = 0; d < HD; ++d) s += q[d] * kr[d];
            s -= sl * (float)(t - pos);
            const float mn = fmaxf(m, s); const float sc = expf(m - mn), pe = expf(s - mn);
            l = l * sc + pe;
            for (int d = 0; d < HD; ++d) o[d] = o[d] * sc + pe * kr[HD + d];
            m = mn; }
        const float inv = 1.0f / l;
        for (int d = 0; d < HD; ++d) owin[(long)row * D + H * HD + d] = o[d] * inv;
    }
}
NV_DEV void ph_combine(const Params& p, long gtid, long gsz) {
    const float* u = p.ws + W_U; float* obuf = p.ws + W_OBUF;
    for (long it = gtid; it < (long)M * D; it += gsz) { const long row = it / D; const int c = (int)(it % D); const int H = c / HD;
        const float* gl = u + row * NU + 2 * D + H * 3; const float* bg = p.in[I_BGATE] + H * 3;
        const float g0 = sigm_f(gl[0] + bg[0]), g1 = sigm_f(gl[1] + bg[1]), g2 = sigm_f(gl[2] + bg[2]);
        const float o = g0 * (p.ws + W_OCMP)[it] + g1 * (p.ws + W_OSEL)[it] + g2 * (p.ws + W_OWIN)[it];
        const float v = o * silu_f(u[row * NU + D + c]); obuf[it] = v; ((unsigned short*)(p.ws + W_BFA))[it] = f2bf_rne(v); }
}

constexpr int N_PH = 21;
template <int PH> NV_DEV void run_phase(const Params& p, long gtid, long gsz) {
    if constexpr (PH == 0) ph_ada(p, gtid, gsz);
    else if constexpr (PH == 1) ph_mod(p, 0, gtid, gsz);
    else if constexpr (PH == 2) gemm_naive(p.ws + W_MA, D, p.in[I_WINA], 2 * D, p.ws + W_U0, 2 * D, M, 2 * D, D, gtid, gsz);
    else if constexpr (PH == 3) ph_conv(p, gtid, gsz);
    else if constexpr (PH == 4) ph_gates(p, gtid, gsz);
    else if constexpr (PH == 5) ph_scan(p, gtid, gsz);
    else if constexpr (PH == 6) ph_gated(p, gtid, gsz);
    else if constexpr (PH == 7) gemm_naive(p.ws + W_MA, D, p.in[I_WOUTA], D, p.ws + W_F, D, M, D, D, gtid, gsz);
    else if constexpr (PH == 8) ph_ln(p, 0, gtid, gsz);
    else if constexpr (PH == 9) gemm_naive(p.ws + W_X1, D, p.in[I_WKV], NKVC, p.ws + W_KV, NKVC, M, NKVC, D, gtid, gsz);
    else if constexpr (PH == 10) ph_mod(p, 1, gtid, gsz);
    else if constexpr (PH == 11) gemm_naive(p.ws + W_MA, D, p.in[I_WINB], NU, p.ws + W_U, NU, M, NU, D, gtid, gsz);
    else if constexpr (PH == 12) { ph_outputs(p, gtid, gsz); ph_comp1(p, gtid, gsz); }
    else if constexpr (PH == 13) ph_comp2(p, gtid, gsz);
    else if constexpr (PH == 14) ph_cmp_attn(p, gtid, gsz);
    else if constexpr (PH == 15) ph_topk(p, gtid, gsz);
    else if constexpr (PH == 16) ph_sel(p, gtid, gsz);
    else if constexpr (PH == 17) ph_win(p, gtid, gsz);
    else if constexpr (PH == 18) ph_combine(p, gtid, gsz);
    else if constexpr (PH == 19) gemm_naive(p.ws + W_OBUF, D, p.in[I_WOUTB], D, p.ws + W_F, D, M, D, D, gtid, gsz);
    else if constexpr (PH == 20) ph_ln(p, 1, gtid, gsz);
}
}

#define XB_TMO      128
#define XB_XCNT(j)  (256  + 64 * (j))
#define XB_XSUB(j)  (1280 + 64 * (j))
#define XB_XGEN(j)  (2304 + 64 * (j))
#define XB_TOP      3328
#define XB_TOPGEN   3392
#define XCD_BAR_WORDS 3456
#define XB_SPIN_CAP (1u << 18)
#define LAS __attribute__((address_space(3)))

__device__ __forceinline__ unsigned xb_ld(unsigned* p)              { return __hip_atomic_load(p, __ATOMIC_RELAXED, __HIP_MEMORY_SCOPE_AGENT); }
__device__ __forceinline__ unsigned xb_add(unsigned* p, unsigned v) { return __hip_atomic_fetch_add(p, v, __ATOMIC_RELAXED, __HIP_MEMORY_SCOPE_AGENT); }
__device__ __forceinline__ unsigned xb_xcc_id() { return (unsigned)__builtin_amdgcn_s_getreg((3 << 11) | 20) & 0xFu; }
#define XB_SPIN(cond, bar) do { unsigned _sp = 0; while (cond) { __builtin_amdgcn_s_sleep(1); \
    if ((++_sp & 255u) == 0u) { if (xb_ld(&(bar)[XB_TMO])) break; if (_sp > XB_SPIN_CAP) { atomicAdd(&(bar)[XB_TMO], 1u); break; } } } } while (0)

struct XcdBarrier {
    unsigned* bar; unsigned x;
    volatile LAS unsigned* st;
};

__device__ __forceinline__ XcdBarrier xcd_barrier_post(unsigned* bar, volatile LAS unsigned* st) {
    XcdBarrier b; b.bar = bar; b.x = xb_xcc_id(); b.st = st;
    if (threadIdx.x == 0) (void)xb_add(&bar[XB_XCNT(b.x)], 1u);
    return b;
}
__device__ __forceinline__ void xcd_barrier_complete(unsigned* bar, unsigned x, unsigned& nloc, unsigned& nx) {
    const unsigned G = gridDim.x * gridDim.y * gridDim.z;
    unsigned sum, cnt, mine, sp = 0u;
    for (;;) {
        sum = 0u; cnt = 0u; mine = 0u;
#pragma unroll
        for (unsigned j = 0; j < 16; ++j) { const unsigned c = xb_ld(&bar[XB_XCNT(j)]); sum += c; cnt += (c > 0u) ? 1u : 0u; mine = (j == x) ? c : mine; }
        if (sum == G) break;
        __builtin_amdgcn_s_sleep(1);
        if ((++sp & 255u) == 0u) { if (xb_ld(&bar[XB_TMO])) break; if (sp > XB_SPIN_CAP) { atomicAdd(&bar[XB_TMO], 1u); break; } }
    }
    nloc = mine > 0u ? mine : 1u; nx = cnt > 0u ? cnt : 1u;
}

__device__ __forceinline__ void xcd_barrier(const XcdBarrier& b) {
    asm volatile("s_waitcnt vmcnt(0)" ::: "memory");
    __syncthreads();
    if (threadIdx.x == 0) {
        unsigned* bar = b.bar;
        __builtin_amdgcn_s_waitcnt(0);
        unsigned nloc = b.st[0], nx = b.st[1];
        if (nloc == 0u) { xcd_barrier_complete(bar, b.x, nloc, nx); b.st[0] = nloc; b.st[1] = nx; }
        const unsigned old = xb_add(&bar[XB_XSUB(b.x)], 1u);
        const unsigned gen = old / nloc;
        if (old + 1u == (gen + 1u) * nloc) {
            __builtin_amdgcn_fence(__ATOMIC_RELEASE, "agent");
            asm volatile("s_waitcnt vmcnt(0)" ::: "memory");
            const unsigned og = xb_add(&bar[XB_TOP], 1u);
            const unsigned tg = og / nx;
            if (og + 1u == (tg + 1u) * nx) xb_add(&bar[XB_TOPGEN], 1u);
            else XB_SPIN(xb_ld(&bar[XB_TOPGEN]) == tg, bar);
            __builtin_amdgcn_fence(__ATOMIC_ACQUIRE, "agent");
            xb_add(&bar[XB_XGEN(b.x)], 1u);
            asm volatile("s_waitcnt vmcnt(0)" ::: "memory");
        } else {
            XB_SPIN(xb_ld(&bar[XB_XGEN(b.x)]) == gen, bar);
            __builtin_amdgcn_fence(__ATOMIC_ACQUIRE, "agent");
            asm volatile("s_waitcnt vmcnt(0)" ::: "memory");
        }
    }
    __syncthreads();
}

__device__ __forceinline__ int opaque_tid() { int t = threadIdx.x; asm volatile("" : "+v"(t)); return t; }

namespace pg8 {
#define PG8_LAS __attribute__((address_space(3)))
typedef unsigned short bf16_t;
typedef short bf16x8 __attribute__((ext_vector_type(8)));
typedef float f32x4 __attribute__((ext_vector_type(4)));
typedef unsigned u32x4 __attribute__((ext_vector_type(4)));
constexpr int BM = 256, BK = 64, HALF = 128, HTB = HALF * BK * 2  , STAGE_BYTES = 8 * HTB, NXCD = 8, WGM = 8;

__host__ __device__ __forceinline__ int lds_byte(int r, int c) { const int st = (r >> 4) * 2 + (c >> 5), rr = r & 15, cc = c & 31, ob = rr * 64 + cc * 2; return st * 1024 + (ob ^ (((ob >> 9) & 1) << 5)); }
__host__ __device__ __forceinline__ void stage_rc(int b, int& R, int& C) { const int st = b / 1024, sb = b % 1024, swz = sb ^ (((sb >> 9) & 1) << 5); R = (st >> 1) * 16 + swz / 64; C = (st & 1) * 32 + (swz % 64) / 2; }
__host__ __device__ __forceinline__ int perm32(int rho) { const int n = rho >> 4, i = rho & 15; return 8 * (i >> 2) + 4 * n + (i & 3); }

struct Unit { int pm, pn; };
struct Gemm { const bf16_t* A; const bf16_t* Bt; int M, N, K; const bf16_t* A2; int nsplit; };

struct StaticOrder {
    int nM, nN, nwg, G, c;
    __host__ __device__ void init(int M, int N, int G_, int c_) { nM = M / BM; nN = N / BM; nwg = nM * nN; G = G_; c = c_; }
    __host__ __device__ bool next(int i, Unit& u) const {
        const long L = (long)i * G + c; if (L >= nwg) return false;
        int wgid = (int)L; { const int q = nwg / NXCD, r = nwg % NXCD, xcd = wgid % NXCD, off = wgid / NXCD; wgid = (xcd < r ? xcd * (q + 1) : r * (q + 1) + (xcd - r) * q) + off; }
        const int nig = WGM * nN, gid = wgid / nig, fm = gid * WGM, gsz = (nM - fm) < WGM ? (nM - fm) : WGM;
        u.pm = fm + ((wgid % nig) % gsz); u.pn = (wgid % nig) / gsz; return true;
    }
    __device__ __forceinline__ void a_ready(const Unit&) const {}
    __device__ __forceinline__ void done(const Unit&) const {}
};

__device__ __forceinline__ unsigned cvt_pk_bf16(float lo, float hi) { unsigned r; asm volatile("v_cvt_pk_bf16_f32 %0, %1, %2" : "=v"(r) : "v"(lo), "v"(hi)); return r; }
typedef float f32x2 __attribute__((ext_vector_type(2)));
template <class Epi, class Sched, bool ALIGN_EPI = false, bool SP2 = false>
__device__ __forceinline__ void gemm_phase(PG8_LAS unsigned char* lds, const Gemm g, const Sched& S, const Epi& E) {
    const int tid = opaque_tid(), wid = __builtin_amdgcn_readfirstlane(tid >> 6), lane = tid & 63, wr = wid >> 2, wc = wid & 3, fr = lane & 15, fq = lane >> 4;
    const int K = g.K, nt = K / BK;
    unsigned voffA[2], voffB[2];
#pragma unroll
    for (int i = 0; i < 2; ++i) { int R, C; stage_rc(tid * 16 + i * 8192, R, C); const int Rb = Epi::PERM ? ((R & ~31) + perm32(R & 31)) : R;
        voffA[i] = (unsigned)(R * K + C) * 2u; voffB[i] = (unsigned)(Rb * K + C) * 2u; }
    const size_t kstep = (size_t)(BK * 2);
    const size_t hstep = (size_t)HALF * K * 2;
    const size_t tstep = 2 * hstep;
    const unsigned ldsw = (unsigned)wid * 1024u;
    const int aoff = lds_byte(wr * 64 + fr, fq * 8), boff = lds_byte(wc * 32 + fr, fq * 8);
#define PG8_SA(b, h) (((b) * 2 + (h)) * HTB)
#define PG8_SB(b, h) ((4 + (b) * 2 + (h)) * HTB)
#define PG8_STAGE(bufoff, gbase, voff) do { _Pragma("unroll") for (int _i = 0; _i < 2; ++_i) \
        __builtin_amdgcn_global_load_lds((const unsigned*)((const char*)(gbase) + (voff)[_i]), (PG8_LAS unsigned*)(lds + (bufoff) + ldsw + _i * 8192), 16, 0, 0); } while (0)
#define PG8_LDA(dst, b, h) do { _Pragma("unroll") for (int m = 0; m < 4; ++m) _Pragma("unroll") for (int k = 0; k < 2; ++k) dst[m][k] = *(const PG8_LAS bf16x8*)(lds + PG8_SA(b, h) + aoff + m * 2048 + k * 1024); } while (0)
#define PG8_LDB(dst, b, h) do { _Pragma("unroll") for (int n = 0; n < 2; ++n) _Pragma("unroll") for (int k = 0; k < 2; ++k) dst[n][k] = *(const PG8_LAS bf16x8*)(lds + PG8_SB(b, h) + boff + n * 2048 + k * 1024); } while (0)
#define PG8_MMA(ai, bj, At, Bt) do { __builtin_amdgcn_s_setprio(1); _Pragma("unroll") for (int m = 0; m < 4; ++m) _Pragma("unroll") for (int n = 0; n < 2; ++n) _Pragma("unroll") for (int k = 0; k < 2; ++k) \
        acc[ai][bj][m][n] = __builtin_amdgcn_mfma_f32_16x16x32_bf16(Bt[n][k], At[m][k], acc[ai][bj][m][n], 0, 0, 0); __builtin_amdgcn_s_setprio(0); } while (0)
#define PG8_WAIT_V(n) asm volatile("s_waitcnt vmcnt(" #n ")" ::: "memory")
#define PG8_WAIT_L(n) asm volatile("s_waitcnt lgkmcnt(" #n ")" ::: "memory")
#define PG8_BAR __builtin_amdgcn_s_barrier()
#define PG8_SCHED __builtin_amdgcn_sched_barrier(0)
    Unit cur, nxt; int ui = 0;
    if (!S.next(0, cur)) return;
    f32x4 acc[2][2][4][2];
#pragma unroll
    for (int a = 0; a < 2; ++a)
#pragma unroll
        for (int b = 0; b < 2; ++b)
#pragma unroll
            for (int m = 0; m < 4; ++m)
#pragma unroll
                for (int n = 0; n < 2; ++n) acc[a][b][m][n] = (f32x4){0.f, 0.f, 0.f, 0.f};
    bf16x8 At[4][2], B0[2][2], B1[2][2];
    const char* cA = (const char*)(cur.pn < g.nsplit ? g.A : g.A2) + (size_t)cur.pm * tstep; const char* cB = (const char*)g.Bt + (size_t)cur.pn * tstep;
    S.a_ready(cur);
    if constexpr (SP2) {
        PG8_STAGE(PG8_SB(0, 0), cB, voffB); PG8_STAGE(PG8_SB(0, 1), cB + hstep, voffB); PG8_STAGE(PG8_SA(0, 0), cA, voffA); PG8_STAGE(PG8_SA(0, 1), cA + hstep, voffA);
        if (wr == 1) PG8_BAR;
        PG8_WAIT_V(2); PG8_BAR;
        PG8_STAGE(PG8_SB(1, 0), cB + kstep, voffB); PG8_STAGE(PG8_SA(1, 0), cA + kstep, voffA); PG8_STAGE(PG8_SB(1, 1), cB + hstep + kstep, voffB);
        PG8_WAIT_V(6); PG8_BAR;
    } else {
        PG8_STAGE(PG8_SB(0, 0), cB, voffB); PG8_STAGE(PG8_SA(0, 0), cA, voffA); PG8_STAGE(PG8_SB(0, 1), cB + hstep, voffB); PG8_STAGE(PG8_SA(0, 1), cA + hstep, voffA);
        if (wr == 1) PG8_BAR;
        PG8_WAIT_V(4); PG8_BAR;
        PG8_STAGE(PG8_SB(1, 0), cB + kstep, voffB); PG8_STAGE(PG8_SA(1, 0), cA + kstep, voffA); PG8_STAGE(PG8_SB(1, 1), cB + hstep + kstep, voffB);
        PG8_WAIT_V(6); PG8_BAR;
    }
    for (;;) {
        const bool has_next = S.next(ui + 1, nxt);
        const char* nA = has_next ? (const char*)(nxt.pn < g.nsplit ? g.A : g.A2) + (size_t)nxt.pm * tstep : cA; const char* nB = has_next ? (const char*)g.Bt + (size_t)nxt.pn * tstep : cB;
        for (int t = 0; t < nt; t += 2) {
            const bool last = (t == nt - 2);
            const char* a1 = cA + (size_t)(t + 1) * kstep;
            const char* a2 = last ? nA : cA + (size_t)(t + 2) * kstep; const char* b2 = last ? nB : cB + (size_t)(t + 2) * kstep;
            const char* a3 = a2 + kstep; const char* b3 = b2 + kstep;
            if (last && has_next) S.a_ready(nxt);
            if constexpr (SP2) {
            PG8_LDB(B0, 0, 0); PG8_LDB(B1, 0, 1); PG8_SCHED; PG8_LDA(At, 0, 0); PG8_STAGE(PG8_SA(1, 1), a1 + hstep, voffA);
            PG8_WAIT_V(8); PG8_WAIT_L(0); PG8_BAR; PG8_MMA(0, 0, At, B0); PG8_MMA(0, 1, At, B1); PG8_BAR; PG8_SCHED;
            PG8_LDA(At, 0, 1); PG8_STAGE(PG8_SB(0, 0), b2, voffB); PG8_STAGE(PG8_SB(0, 1), b2 + hstep, voffB); PG8_STAGE(PG8_SA(0, 0), a2, voffA);
            PG8_WAIT_V(8); PG8_WAIT_L(0); PG8_BAR; PG8_MMA(1, 0, At, B0); PG8_MMA(1, 1, At, B1); PG8_BAR; PG8_SCHED;
            PG8_LDB(B0, 1, 0); PG8_LDB(B1, 1, 1); PG8_SCHED; PG8_LDA(At, 1, 0); PG8_STAGE(PG8_SA(0, 1), a2 + hstep, voffA);
            PG8_WAIT_V(8); PG8_WAIT_L(0); PG8_BAR; PG8_MMA(0, 0, At, B0); PG8_MMA(0, 1, At, B1); PG8_BAR; PG8_SCHED;
            PG8_LDA(At, 1, 1); PG8_STAGE(PG8_SB(1, 0), b3, voffB); PG8_STAGE(PG8_SB(1, 1), b3 + hstep, voffB); PG8_STAGE(PG8_SA(1, 0), a3, voffA);
            PG8_WAIT_V(8); PG8_WAIT_L(0); PG8_BAR; PG8_MMA(1, 0, At, B0); PG8_MMA(1, 1, At, B1); PG8_BAR; PG8_SCHED;
            } else {
            PG8_LDB(B0, 0, 0); PG8_SCHED; PG8_LDA(At, 0, 0); PG8_STAGE(PG8_SA(1, 1), a1 + hstep, voffA);
            PG8_WAIT_L(8); PG8_BAR; PG8_WAIT_L(0); PG8_MMA(0, 0, At, B0); PG8_BAR; PG8_SCHED;
            PG8_LDB(B1, 0, 1); PG8_STAGE(PG8_SB(0, 0), b2, voffB);
            PG8_BAR; PG8_WAIT_L(0); PG8_MMA(0, 1, At, B1); PG8_BAR;
            PG8_LDA(At, 0, 1); PG8_STAGE(PG8_SA(0, 0), a2, voffA);
            PG8_BAR; PG8_WAIT_L(0); PG8_MMA(1, 0, At, B0); PG8_BAR; PG8_SCHED;
            PG8_STAGE(PG8_SB(0, 1), b2 + hstep, voffB);
            PG8_WAIT_V(6); PG8_BAR; PG8_MMA(1, 1, At, B1); PG8_BAR;
            PG8_LDB(B0, 1, 0); PG8_SCHED; PG8_LDA(At, 1, 0); PG8_STAGE(PG8_SA(0, 1), a2 + hstep, voffA);
            PG8_WAIT_L(8); PG8_BAR; PG8_WAIT_L(0); PG8_MMA(0, 0, At, B0); PG8_BAR; PG8_SCHED;
            PG8_LDB(B1, 1, 1); PG8_STAGE(PG8_SB(1, 0), b3, voffB);
            PG8_BAR; PG8_WAIT_L(0); PG8_MMA(0, 1, At, B1); PG8_BAR;
            PG8_LDA(At, 1, 1); PG8_STAGE(PG8_SA(1, 0), a3, voffA);
            PG8_BAR; PG8_WAIT_L(0); PG8_MMA(1, 0, At, B0); PG8_BAR; PG8_SCHED;
            PG8_STAGE(PG8_SB(1, 1), b3 + hstep, voffB);
            PG8_WAIT_V(6); PG8_BAR; PG8_MMA(1, 1, At, B1); PG8_BAR;
            }
        }
        if constexpr (ALIGN_EPI) { if (wr == 0) PG8_BAR; }
        if constexpr (!Epi::AFTER_DRAIN) { E(acc, cur, wr, wc, fr, fq); S.done(cur); }
        if (!has_next) break;
#pragma unroll
        for (int a = 0; a < 2; ++a)
#pragma unroll
            for (int b = 0; b < 2; ++b)
#pragma unroll
                for (int m = 0; m < 4; ++m)
#pragma unroll
                    for (int n = 0; n < 2; ++n) acc[a][b][m][n] = (f32x4){0.f, 0.f, 0.f, 0.f};
        cur = nxt; cA = nA; cB = nB; ++ui;
        if constexpr (ALIGN_EPI) { if (wr == 1) PG8_BAR; }
    }
    PG8_WAIT_V(0);
    if constexpr (!ALIGN_EPI) { if (wr == 0) PG8_BAR; }
    PG8_BAR;
    if constexpr (Epi::AFTER_DRAIN) { E.fused(acc, cur, wr, wc, fr, fq, lds, wid, lane); S.done(cur); }
#undef PG8_SA
#undef PG8_SB
#undef PG8_STAGE
#undef PG8_LDA
#undef PG8_LDB
#undef PG8_MMA
#undef PG8_WAIT_V
#undef PG8_WAIT_L
#undef PG8_BAR
#undef PG8_SCHED
}
}

#define GAS __attribute__((address_space(1)))
typedef unsigned short bf16;
typedef unsigned v4u __attribute__((ext_vector_type(4)));
typedef float f32x4 __attribute__((ext_vector_type(4)));
#define LDS_WAIT() asm volatile("s_waitcnt lgkmcnt(0)" ::: "memory")
#define VM_WAIT() asm volatile("s_waitcnt vmcnt(0)" ::: "memory")
__device__ __forceinline__ unsigned f2bf(float f) { unsigned u = __builtin_bit_cast(unsigned, f); return (u + 0x7fffu + ((u >> 16) & 1u)) >> 16; }
__device__ __forceinline__ unsigned pk2(float lo, float hi) { return f2bf(lo) | (f2bf(hi) << 16); }

namespace pg8 {
struct EpiF32Split {
    static constexpr bool PERM = false, AFTER_DRAIN = false;
    float* C0; int ldc0, n0; float* C1; int ldc1, n1;
    __device__ __forceinline__ void operator()(const f32x4 (&acc)[2][2][4][2], const Unit& u, int wr, int wc, int fr, int fq) const {
#pragma unroll
        for (int ai = 0; ai < 2; ++ai)
#pragma unroll
            for (int m = 0; m < 4; ++m) { const size_t row = (size_t)u.pm * BM + ai * HALF + wr * 64 + m * 16 + fr;
#pragma unroll
                for (int bj = 0; bj < 2; ++bj)
#pragma unroll
                    for (int n = 0; n < 2; ++n) { const int col = u.pn * BM + bj * HALF + wc * 32 + n * 16 + 4 * fq;
                        if (col < n0) *(f32x4*)(C0 + row * ldc0 + col) = acc[ai][bj][m][n];
                        else if (col - n0 < n1) *(f32x4*)(C1 + row * ldc1 + (col - n0)) = acc[ai][bj][m][n]; } }
    }
};
struct EpiKvU {
    static constexpr bool PERM = true, AFTER_DRAIN = false;
    float* out; bf16_t* kvb; bf16_t* qb; bf16_t* zb; float* gl;
    __device__ __forceinline__ void operator()(const f32x4 (&acc)[2][2][4][2], const Unit& u, int wr, int wc, int fr, int fq) const {
        using namespace nv;
        const bool samp = u.pm == MP / BM; const int pn = u.pn;
#pragma unroll
        for (int ai = 0; ai < 2; ++ai)
#pragma unroll
            for (int m = 0; m < 4; ++m) { const size_t row = (size_t)u.pm * BM + ai * HALF + wr * 64 + m * 16 + fr;
#pragma unroll
                for (int bj = 0; bj < 2; ++bj) { const int col = pn * BM + bj * HALF + wc * 32 + 8 * fq; const f32x4 v0 = acc[ai][bj][m][0], v1 = acc[ai][bj][m][1];
                    if (pn < 6) { const int br = pn >> 1, cc = col & 511; float* dst = nullptr;
                        if (br < 2) dst = samp ? out + (br == 0 ? O_CMPS : O_SELS) + (row - MP) * KVG + cc : out + (br == 0 ? O_CMPP : O_SELP) + row * KVG + cc;
                        else if (samp) dst = out + O_WINS + (((row - MP) >> 3) * WIN + (WIN - DSEQ) + ((row - MP) & 7)) * KVG + cc;
                        else { const int t = (int)(row % SEQ); if (t >= SEQ - WIN) dst = out + O_WINP + ((row / SEQ) * WIN + (t - (SEQ - WIN))) * KVG + cc; }
                        if (dst) { *(f32x4*)dst = v0; *(f32x4*)(dst + 4) = v1; }
                        if (br >= 1 && !samp) { u32x4 w; w.x = cvt_pk_bf16(v0[0], v0[1]); w.y = cvt_pk_bf16(v0[2], v0[3]); w.z = cvt_pk_bf16(v1[0], v1[1]); w.w = cvt_pk_bf16(v1[2], v1[3]); *(u32x4*)(kvb + row * NKVC + col) = w; }
                    } else if (pn < 14) { const float sc = pn < 10 ? 0.125f * 1.4426950408889634f : 1.0f; bf16_t* d = pn < 10 ? qb + row * D + (col - NKVC) : zb + row * D + (col - NKVC - D);
                        const f32x4 a = v0 * sc, b = v1 * sc; u32x4 w; w.x = cvt_pk_bf16(a[0], a[1]); w.y = cvt_pk_bf16(a[2], a[3]); w.z = cvt_pk_bf16(b[0], b[1]); w.w = cvt_pk_bf16(b[2], b[3]); *(u32x4*)d = w;
                    } else { const int cc = col - NKVC - 2 * D; if (cc < 3 * NH) { float* d = gl + row * (3 * NH) + cc; *(f32x4*)d = v0; *(f32x4*)(d + 4) = v1; } }
                } }
    }
};
}

__device__ __forceinline__ void wt_transpose_item(const float* W, int K, int N, bf16* WT, int row_off, LAS float* scr, int item, int lane) {
    const int nblk = (N + 31) / 32, kb = item / nblk, nb = item % nblk, k0 = 64 * kb, n0 = 32 * nb;
    const bool okn = n0 + (lane & 31) < N;
#pragma unroll 8
    for (int i = 0; i < 32; ++i) { const int kk = 2 * i + (lane >> 5); scr[kk * 33 + (lane & 31)] = okn ? W[(size_t)(k0 + kk) * N + n0 + (lane & 31)] : 0.f; }
    LDS_WAIT(); asm volatile("" ::: "memory");
    const int c = lane & 7;
#pragma unroll
    for (int j = 0; j < 4; ++j) { const int n = (lane >> 3) + 8 * j; const LAS float* s = scr + (8 * c) * 33 + n;
        v4u o; o.x = pk2(s[0 * 33], s[1 * 33]); o.y = pk2(s[2 * 33], s[3 * 33]); o.z = pk2(s[4 * 33], s[5 * 33]); o.w = pk2(s[6 * 33], s[7 * 33]);
        *(GAS v4u*)(WT + (size_t)(row_off + n0 + n) * K + k0 + 8 * c) = o; }
    LDS_WAIT(); asm volatile("" ::: "memory");
}

namespace rg {
typedef short bf16x8 __attribute__((ext_vector_type(8)));
constexpr int TC = 128, NCHUNK = nv::SEQ / TC;
constexpr int A_STRIDE = 272;
constexpr int X_STRIDE = 132;
constexpr int LDS_A = 0, LDS_X = 128 * A_STRIDE;
constexpr int NUNIT_P = nv::BATCH * NCHUNK * 8, NUNIT_S = (nv::MS / 128) * 8;
static_assert(nv::RGB == 128 && nv::NRG == 8 && nv::MS % 128 == 0 && nv::SEQ % TC == 0, "rg geometry");

__device__ __forceinline__ float sigm(float x) { return __builtin_amdgcn_rcpf(1.0f + __expf(-x)); }

template <int PASS>
__device__ __forceinline__ void rg_pass(const nv::Params& p, LAS unsigned char* L, float* agg) {
    using namespace nv;
    const int tid = opaque_tid(), wave = __builtin_amdgcn_readfirstlane(tid >> 6), lane = tid & 63;
    const int n = blockIdx.x & 7;
    const int l15 = lane & 15, q = lane >> 4;
    const int cl = 16 * wave + l15, ch = n * 128 + cl;
    const float* u0 = p.ws + W_U0;
    LAS float* X = (LAS float*)(L + LDS_X);
    bf16x8 Br[4], Bi[4];
#pragma unroll
    for (int ks = 0; ks < 4; ++ks)
#pragma unroll
        for (int j = 0; j < 8; ++j) { const int k = 32 * ks + 8 * q + j;
            Br[ks][j] = (short)f2bf(p.in[I_WR][((size_t)n * 128 + k) * 128 + cl]); Bi[ks][j] = (short)f2bf(p.in[I_WI][((size_t)n * 128 + k) * 128 + cl]); }
    const float br = p.in[I_BR][ch], bi = p.in[I_BI][ch];
    const float lam = p.in[I_LAM][ch];
    const float sp8 = 8.0f * ((-lam > 20.f) ? -lam : log1pf(expf(-lam)));
    const int nunits = PASS == 1 ? NUNIT_P : NUNIT_P + NUNIT_S;
    for (int u = blockIdx.x; u < nunits; u += gridDim.x) {
        const bool samp = u >= NUNIT_P;
        int row0, b = 0, chunk = 0;
        if (!samp) { const int cidx = u >> 3; b = cidx / NCHUNK; chunk = cidx % NCHUNK; row0 = b * SEQ + chunk * TC; }
        else row0 = MP + ((u - NUNIT_P) >> 3) * 128;
        {
            const int c = tid & 127, rq = tid >> 7; const int chn = n * 128 + c;
            const float w0 = p.in[I_CONVW][chn], w1 = p.in[I_CONVW][D + chn], w2 = p.in[I_CONVW][2 * D + chn], w3 = p.in[I_CONVW][3 * D + chn], cb = p.in[I_CONVB][chn];
            LAS unsigned short* Abf = (LAS unsigned short*)(L + LDS_A);
            if (!samp) {
                float v[35];
                const int tq0 = chunk * TC + rq * 32 - 3; const float* xr = u0 + ((size_t)b * SEQ) * 2048 + chn;
#pragma unroll
                for (int j = 0; j < 35; ++j) { const int tt = tq0 + j; const float x = xr[(size_t)(tt < 0 ? 0 : tt) * 2048]; v[j] = tt < 0 ? 0.f : x; }
#pragma unroll
                for (int i = 0; i < 32; ++i) { const int rl = rq * 32 + i; const float acc = cb + v[i] * w0 + v[i + 1] * w1 + v[i + 2] * w2 + v[i + 3] * w3;
                    X[rl * X_STRIDE + c] = acc; Abf[rl * (A_STRIDE / 2) + c] = (unsigned short)f2bf(acc); }
            } else {
                float v[4][11];
#pragma unroll
                for (int s4 = 0; s4 < 4; ++s4) { const int rl0 = rq * 32 + 8 * s4; const size_t bs = (size_t)((row0 - MP + rl0) >> 3);
#pragma unroll
                    for (int j = 0; j < 3; ++j) v[s4][j] = p.in[I_STC][(bs * 3 + j) * D + chn];
#pragma unroll
                    for (int j = 0; j < 8; ++j) v[s4][3 + j] = u0[(size_t)(row0 + rl0 + j) * 2048 + chn]; }
#pragma unroll
                for (int s4 = 0; s4 < 4; ++s4)
#pragma unroll
                    for (int j = 0; j < 8; ++j) { const int rl = rq * 32 + 8 * s4 + j; const float acc = cb + v[s4][j] * w0 + v[s4][j + 1] * w1 + v[s4][j + 2] * w2 + v[s4][j + 3] * w3;
                        X[rl * X_STRIDE + c] = acc; Abf[rl * (A_STRIDE / 2) + c] = (unsigned short)f2bf(acc); }
            }
        }
        __syncthreads();
        float hin = 0.f;
        if (PASS == 2 && !samp) {
            float Ap = 1.f, Bp = 0.f;
            const float2* ag = (const float2*)agg + ((size_t)b * NCHUNK) * 1024 + ch;
#pragma unroll
            for (int i = 0; i < 16; ++i) { const int cc = 16 * q + i; const int cs = cc < chunk ? cc : 0; const float2 ab = ag[(size_t)cs * 1024];
                const float a_ = cc < chunk ? ab.x : 1.f, b_ = cc < chunk ? ab.y : 0.f; Bp = a_ * Bp + b_; Ap = a_ * Ap; }
#pragma unroll
            for (int qq = 0; qq < 4; ++qq) { const float a_ = __shfl(Ap, 16 * qq + l15), b_ = __shfl(Bp, 16 * qq + l15); hin = a_ * hin + b_; }
        }
        f32x4 accr[8], acci[8];
#pragma unroll
        for (int rt = 0; rt < 8; ++rt) { accr[rt] = (f32x4){0.f, 0.f, 0.f, 0.f}; acci[rt] = (f32x4){0.f, 0.f, 0.f, 0.f}; }
#pragma unroll
        for (int ks = 0; ks < 4; ++ks)
#pragma unroll
            for (int rt = 0; rt < 8; ++rt) { const bf16x8 a = *(const LAS bf16x8*)(L + LDS_A + (16 * rt + l15) * A_STRIDE + (32 * ks + 8 * q) * 2);
                accr[rt] = __builtin_amdgcn_mfma_f32_16x16x32_bf16(a, Br[ks], accr[rt], 0, 0, 0);
                acci[rt] = __builtin_amdgcn_mfma_f32_16x16x32_bf16(a, Bi[ks], acci[rt], 0, 0, 0); }
        float carA = 1.f, carB = hin;
#pragma unroll
        for (int rt = 0; rt < 8; ++rt) {
            float a[4], bb[4];
#pragma unroll
            for (int j = 0; j < 4; ++j) { const int rl = 16 * rt + 4 * q + j; const float xc = X[rl * X_STRIDE + cl];
                const float r = sigm(accr[rt][j] + br), ii = sigm(acci[rt][j] + bi);
                const float la = -sp8 * r; a[j] = __expf(la); const float gain = __builtin_amdgcn_sqrtf(fmaxf(1.0f - a[j] * a[j], 0.f)); bb[j] = gain * ii * xc; }
            float As = a[0], Bs = bb[0];
#pragma unroll
            for (int j = 1; j < 4; ++j) { Bs = a[j] * Bs + bb[j]; As *= a[j]; }
            if (!samp) {
                float Ai = As, Bq = Bs;
                { const float pa = __shfl_up(Ai, 16), pb = __shfl_up(Bq, 16); if (q >= 1) { Bq = Ai * pb + Bq; Ai = pa * Ai; } }
                { const float pa = __shfl_up(Ai, 32), pb = __shfl_up(Bq, 32); if (q >= 2) { Bq = Ai * pb + Bq; Ai = pa * Ai; } }
                float Ae = __shfl_up(Ai, 16), Be = __shfl_up(Bq, 16); if (q == 0) { Ae = 1.f; Be = 0.f; }
                const float At = __shfl(Ai, 48 + l15), Bt = __shfl(Bq, 48 + l15);
                if (PASS == 2) {
                    float h = Ae * carB + Be;
#pragma unroll
                    for (int j = 0; j < 4; ++j) { h = a[j] * h + bb[j]; X[(16 * rt + 4 * q + j) * X_STRIDE + cl] = h; }
                    if (rt == 7 && q == 3 && chunk == NCHUNK - 1) p.out[O_HP + (size_t)b * D + ch] = h;
                    carB = At * carB + Bt;
                } else { carB = At * carB + Bt; carA = At * carA; }
            } else if (PASS == 2) {
                const int bs = ((row0 - MP) >> 3) + 2 * rt + (q >> 1);
                const float h0 = p.in[I_STH][(size_t)bs * D + ch];
                const float pa = __shfl_up(As, 16), pb = __shfl_up(Bs, 16);
                float h = (q & 1) ? pa * h0 + pb : h0;
#pragma unroll
                for (int j = 0; j < 4; ++j) { h = a[j] * h + bb[j]; X[(16 * rt + 4 * q + j) * X_STRIDE + cl] = h; }
                if (q & 1) p.out[O_HS + (size_t)bs * D + ch] = h;
            }
        }
        if (PASS == 1) { if (q == 3) ((float2*)agg)[((size_t)b * NCHUNK + chunk) * 1024 + ch] = make_float2(carA, carB); }
        if (PASS == 2) {
            __syncthreads();
            bf16* gA = (bf16*)(p.ws + W_BFA);
            for (int it = tid; it < 2048; it += 512) { const int rl = it >> 4, g8 = it & 15;
                const f32x4 h0 = *(const LAS f32x4*)(X + rl * X_STRIDE + 8 * g8), h1 = *(const LAS f32x4*)(X + rl * X_STRIDE + 8 * g8 + 4);
                const float* zp = u0 + (size_t)(row0 + rl) * 2048 + 1024 + n * 128 + 8 * g8;
                const f32x4 z0 = *(const f32x4*)zp, z1 = *(const f32x4*)(zp + 4);
                v4u o; o.x = pk2(h0[0] * z0[0] * sigm(z0[0]), h0[1] * z0[1] * sigm(z0[1])); o.y = pk2(h0[2] * z0[2] * sigm(z0[2]), h0[3] * z0[3] * sigm(z0[3]));
                o.z = pk2(h1[0] * z1[0] * sigm(z1[0]), h1[1] * z1[1] * sigm(z1[1])); o.w = pk2(h1[2] * z1[2] * sigm(z1[2]), h1[3] * z1[3] * sigm(z1[3]));
                *(GAS v4u*)(gA + (size_t)(row0 + rl) * 1024 + n * 128 + 8 * g8) = o; }
        }
        __syncthreads();
    }
}
}

namespace at {
using namespace nv;
typedef short bf16x8 __attribute__((ext_vector_type(8)));
typedef short s16x4 __attribute__((ext_vector_type(4)));
typedef short v4i16_t __attribute__((ext_vector_type(4)));
typedef unsigned v2u __attribute__((ext_vector_type(2)));
constexpr float LOG2E = 1.4426950408889634f, C2 = 0.125f * LOG2E;
constexpr int KS = 144, VS = 160, KVB = 64 * KS + 64 * VS;
constexpr int TQ = 64;
constexpr int L_KV = 0, L_OT = 2 * KVB, OT_RS = 528, OT_W = 8 * OT_RS, L_UNI = L_OT + 8 * OT_W;
static_assert(L_UNI + 64 <= 131072, "attention LDS map");
constexpr float NEGF = -1.0e30f;
constexpr long W_QB = W_U0, W_ZB = W_U0 + (long)M * D / 2, W_GL = W_U0 + (long)M * D;
constexpr int NT_P = BATCH * NKV * (SEQ / TQ), NT_S = DECB * NKV;

__device__ __forceinline__ s16x4 vtr(const LAS unsigned char* p) { return __builtin_bit_cast(s16x4, __builtin_amdgcn_ds_read_tr16_b64_v4i16((LAS v4i16_t*)p)); }
__device__ __forceinline__ bf16x8 cvt8(const f32x4 a, const f32x4 b) { v4u o; o.x = pk2(a[0], a[1]); o.y = pk2(a[2], a[3]); o.z = pk2(b[0], b[1]); o.w = pk2(b[2], b[3]); return __builtin_bit_cast(bf16x8, o); }

struct TileCtx {
    int b, g, t0;
    size_t rowbase;
    size_t sn0;
};

template <int KIND> __device__ __forceinline__ void stage_load(const Params& p, const TileCtx& c, const bf16* kvb, int kb, int boff, bf16x8& kr, bf16x8& vr, int tid) {
    const int key = tid >> 3, chn = tid & 7;
    if constexpr (KIND == 0) {
        const bf16* s = kvb + ((size_t)c.b * SEQ + kb * 64 + key) * NKVC + boff + c.g * 128 + 8 * chn;
        kr = *(const bf16x8*)s; vr = *(const bf16x8*)(s + 64);
    } else {
        const float* s;
        if constexpr (KIND == 1) s = p.ws + W_COMP + ((c.sn0 + kb * 64 + key) * NKV + c.g) * 128;
        else if constexpr (KIND == 2) { const int pos = kb * 64 + key;
            if (pos < PAST) { const int pg = ((const int*)p.in[I_PT])[c.b * NPAGES + (pos >> 7)]; s = p.in[I_CSEL] + ((size_t)pg * PAGE + (pos & 127)) * KVG + c.g * 128; }
            else { int r = pos - PAST; r = r > DSEQ - 1 ? DSEQ - 1 : r; s = p.out + O_SELS + ((size_t)c.b * DSEQ + r) * KVG + c.g * 128; } }
        else { int j = kb * 64 + key; j = j > WIN + DSEQ - 1 ? WIN + DSEQ - 1 : j;
            if (j < WIN) s = p.in[I_SWIN] + ((size_t)c.b * WIN + j) * KVG + c.g * 128;
            else s = p.out + O_WINS + ((size_t)c.b * WIN + (WIN - DSEQ) + (j - WIN)) * KVG + c.g * 128; }
        const f32x4 k0 = *(const f32x4*)(s + 8 * chn), k1 = *(const f32x4*)(s + 8 * chn + 4), v0 = *(const f32x4*)(s + 64 + 8 * chn), v1 = *(const f32x4*)(s + 64 + 8 * chn + 4);
        kr = cvt8(k0, k1); vr = cvt8(v0, v1);
    }
}
__device__ __forceinline__ void stage_write(LAS unsigned char* buf, const bf16x8 kr, const bf16x8 vr, int tid) {
    const int key = tid >> 3, chn = tid & 7;
    *(LAS bf16x8*)(buf + key * KS + chn * 16) = kr; *(LAS bf16x8*)(buf + 64 * KS + key * VS + chn * 16) = vr;
}

__device__ __forceinline__ void qk_block(const LAS unsigned char* buf, const bf16x8 (&qf)[2][2], f32x4 (&s)[4][2], int l15, int qd) {
#pragma unroll
    for (int kt = 0; kt < 4; ++kt)
#pragma unroll
        for (int ct = 0; ct < 2; ++ct) s[kt][ct] = (f32x4){0.f, 0.f, 0.f, 0.f};
#pragma unroll
    for (int ks = 0; ks < 2; ++ks) {
        bf16x8 kf[4];
#pragma unroll
        for (int kt = 0; kt < 4; ++kt) kf[kt] = *(const LAS bf16x8*)(buf + (16 * kt + l15) * KS + (32 * ks + 8 * qd) * 2);
#pragma unroll
        for (int kt = 0; kt < 4; ++kt)
#pragma unroll
            for (int ct = 0; ct < 2; ++ct) s[kt][ct] = __builtin_amdgcn_mfma_f32_16x16x32_bf16(kf[kt], qf[ct][ks], s[kt][ct], 0, 0, 0);
    }
}
__device__ __forceinline__ void pv_block(const LAS unsigned char* buf, const bf16x8 (&pf)[2][2], f32x4 (&O)[4][2], int l15, int qd) {
    const LAS unsigned char* vb = buf + 64 * KS + (4 * qd + (l15 >> 2)) * VS + (l15 & 3) * 8;
#pragma unroll
    for (int kk = 0; kk < 2; ++kk)
#pragma unroll
        for (int dt = 0; dt < 4; ++dt) {
            const s16x4 lo = vtr(vb + (32 * kk) * VS + dt * 32), hi = vtr(vb + (32 * kk + 16) * VS + dt * 32);
            const bf16x8 vf = (bf16x8){lo[0], lo[1], lo[2], lo[3], hi[0], hi[1], hi[2], hi[3]};
#pragma unroll
            for (int ct = 0; ct < 2; ++ct) O[dt][ct] = __builtin_amdgcn_mfma_f32_16x16x32_bf16(vf, pf[ct][kk], O[dt][ct], 0, 0, 0);
        }
}

template <int BR> __device__ __forceinline__ void online_step(const LAS unsigned char* buf, const bf16x8 (&qf)[2][2], f32x4 (&O)[4][2], float (&m)[2], float (&l)[2],
                                                              const float (&sl2)[2], int t, int pos0, bool lane_on, int l15, int qd) {
    f32x4 s[4][2];
    qk_block(buf, qf, s, l15, qd);
    bf16x8 pf[2][2];
#pragma unroll
    for (int ct = 0; ct < 2; ++ct) {
        float mloc = NEGF;
#pragma unroll
        for (int kt = 0; kt < 4; ++kt)
#pragma unroll
            for (int r = 0; r < 4; ++r) { const int dist = t - (pos0 + 16 * kt + 4 * qd + r);
                const bool ok = lane_on && dist >= 0 && (BR == 2 ? dist <= WIN : true);
                const float v = ok ? s[kt][ct][r] - sl2[ct] * (float)dist : NEGF; s[kt][ct][r] = v; mloc = fmaxf(mloc, v); }
        mloc = fmaxf(mloc, __shfl_xor(mloc, 16)); mloc = fmaxf(mloc, __shfl_xor(mloc, 32));
        const float mn = fmaxf(m[ct], mloc), alpha = __builtin_amdgcn_exp2f(m[ct] - mn);
        m[ct] = mn; float ls = 0.f;
#pragma unroll
        for (int kt = 0; kt < 4; ++kt)
#pragma unroll
            for (int r = 0; r < 4; ++r) { const float v = s[kt][ct][r]; const float pe = v > -1.0e29f ? __builtin_amdgcn_exp2f(v - mn) : 0.f; s[kt][ct][r] = pe; ls += pe; }
        l[ct] = l[ct] * alpha + ls;
#pragma unroll
        for (int dt = 0; dt < 4; ++dt) O[dt][ct] *= alpha;
        pf[ct][0] = cvt8(s[0][ct], s[1][ct]); pf[ct][1] = cvt8(s[2][ct], s[3][ct]);
    }
    pv_block(buf, pf, O, l15, qd);
}

template <bool ACC> __device__ __forceinline__ void ot_merge(LAS unsigned char* ot, const f32x4 (&O)[4][2], const float (&sc)[2], int l15, int qd) {
    const int hs = l15 >> 3, tq8 = l15 & 7;
#pragma unroll
    for (int ct = 0; ct < 2; ++ct)
#pragma unroll
        for (int dt = 0; dt < 4; ++dt) { LAS v2u* q = (LAS v2u*)(ot + tq8 * OT_RS + ((2 * ct + hs) * 64 + 16 * dt + 4 * qd) * 2);
            f32x4 v = O[dt][ct] * sc[ct];
            if (ACC) { const v2u o = *q; v[0] += __uint_as_float(o.x << 16); v[1] += __uint_as_float(o.x & 0xffff0000u); v[2] += __uint_as_float(o.y << 16); v[3] += __uint_as_float(o.y & 0xffff0000u); }
            *q = (v2u){pk2(v[0], v[1]), pk2(v[2], v[3])}; }
}

#ifdef AT_PROBE
#define AT_T(i) do { if (blockIdx.x == 0 && threadIdx.x == 0) { const unsigned long long _n = __builtin_amdgcn_s_memrealtime(); at_acc[i] += _n - at_prev; at_prev = _n; } } while (0)
#define AT_CNT(i) do { if (blockIdx.x == 0 && threadIdx.x == 0) at_acc[i] += 1; } while (0)
#else
#define AT_T(i) do {} while (0)
#define AT_CNT(i) do {} while (0)
#endif
template <bool SAMP> __device__ __forceinline__ void attn_tile(const Params& p, LAS unsigned char* L, const TileCtx& c, const bf16* qb, const bf16* kvb, unsigned long long* at_acc) {
    unsigned long long at_prev = 0; (void)at_prev; (void)at_acc;
#ifdef AT_PROBE
    if (blockIdx.x == 0 && threadIdx.x == 0) at_prev = __builtin_amdgcn_s_memrealtime();
#endif
    const int tid = opaque_tid(), wave = __builtin_amdgcn_readfirstlane(tid >> 6), lane = tid & 63, l15 = lane & 15, qd = lane >> 4;
    const int hs = l15 >> 3, tq8 = l15 & 7;
    const bool wave_on = SAMP ? (wave == 0) : true;
    const int tq = SAMP ? tq8 : 8 * wave + tq8;
    const int t = c.t0 + tq;
    const size_t qrow = c.rowbase + tq;
    const float* gl = p.ws + W_GL; const bf16* zb = (const bf16*)(p.ws + W_ZB);
    LAS unsigned char* ot = L + L_OT + wave * OT_W;
    LAS unsigned* uni = (LAS unsigned*)(L + L_UNI);
    if (tid < 4) uni[tid] = 0u;
    bf16x8 qf[2][2]; float sl2[2];
#pragma unroll
    for (int ct = 0; ct < 2; ++ct) { const int H = c.g * 4 + 2 * ct + hs;
#pragma unroll
        for (int ks = 0; ks < 2; ++ks) qf[ct][ks] = *(const bf16x8*)(qb + qrow * 1024 + H * 64 + 32 * ks + 8 * qd);
        sl2[ct] = exp2f(-8.0f * (float)(H + 1) / (float)NH) * LOG2E; }
    auto gate = [&](int ct, int x) -> float { const int H = c.g * 4 + 2 * ct + hs; return __builtin_amdgcn_rcpf(1.0f + __expf(-(gl[qrow * (3 * NH) + H * 3 + x] + p.in[I_BGATE][H * 3 + x]))); };
    f32x4 O[4][2]; float m[2], l[2];
    LAS unsigned char* buf0 = L + L_KV; LAS unsigned char* buf1 = L + L_KV + KVB;
    { bf16x8 kr, vr; stage_load<1>(p, c, kvb, 0, 0, kr, vr, tid); stage_write(buf0, kr, vr, tid); stage_load<1>(p, c, kvb, 1, 0, kr, vr, tid); stage_write(buf1, kr, vr, tid); }
    __syncthreads();
    unsigned long long selLo = 0ull, selHi = 0ull;
#define AT_SETBIT(n) do { const int _n = (n); if (_n < 64) selLo |= 1ull << _n; else selHi |= 1ull << (_n - 64); } while (0)
    const int cb = t >> 6;
    if (wave_on) {
        const int nvalid = (t + 1) >> 6;
#pragma unroll
        for (int ct = 0; ct < 2; ++ct) { m[ct] = NEGF; l[ct] = 0.f; }
#pragma unroll
        for (int kb = 0; kb < 2; ++kb) { f32x4 s[4][2]; qk_block(kb ? buf1 : buf0, qf, s, l15, qd);
#pragma unroll
            for (int ct = 0; ct < 2; ++ct) { float mloc = NEGF;
#pragma unroll
                for (int kt = 0; kt < 4; ++kt)
#pragma unroll
                    for (int r = 0; r < 4; ++r) { const int n = 64 * kb + 16 * kt + 4 * qd + r; const bool ok = n < nvalid;
                        const float v = ok ? s[kt][ct][r] - sl2[ct] * (float)(t - (64 * n + 63)) : NEGF; s[kt][ct][r] = v; mloc = fmaxf(mloc, v); }
                mloc = fmaxf(mloc, __shfl_xor(mloc, 16)); mloc = fmaxf(mloc, __shfl_xor(mloc, 32));
                const float mn = fmaxf(m[ct], mloc); float ls = 0.f;
#pragma unroll
                for (int kt = 0; kt < 4; ++kt)
#pragma unroll
                    for (int r = 0; r < 4; ++r) { const float v = s[kt][ct][r]; ls += v > -1.0e29f ? __builtin_amdgcn_exp2f(v - mn) : 0.f; }
                l[ct] = l[ct] * __builtin_amdgcn_exp2f(m[ct] - mn) + ls; m[ct] = mn; } }
        float rl[2];
#pragma unroll
        for (int ct = 0; ct < 2; ++ct) { float ls = l[ct]; ls += __shfl_xor(ls, 16); ls += __shfl_xor(ls, 32); rl[ct] = ls > 0.f ? 1.0f / ls : 0.f; }
        float imp[2][4][4];
#pragma unroll
        for (int kb = 0; kb < 2; ++kb) { f32x4 s[4][2]; qk_block(kb ? buf1 : buf0, qf, s, l15, qd);
#pragma unroll
            for (int kt = 0; kt < 4; ++kt)
#pragma unroll
                for (int r = 0; r < 4; ++r) { const int n = 64 * kb + 16 * kt + 4 * qd + r; const bool ok = n < nvalid; const float dist = (float)(t - (64 * n + 63));
                    const float p0 = ok ? __builtin_amdgcn_exp2f(s[kt][0][r] - sl2[0] * dist - m[0]) * rl[0] : 0.f;
                    const float p1 = ok ? __builtin_amdgcn_exp2f(s[kt][1][r] - sl2[1] * dist - m[1]) * rl[1] : 0.f;
                    const float ps = p0 + p1; imp[kb][kt][r] = ps + __shfl_xor(ps, 8); } }
        int npick;
        if (SAMP) { selLo |= 1ull; selHi |= 1ull << 63; npick = NSEL - 3; }
        else { selLo |= 1ull; AT_SETBIT(cb); if (cb >= 1) AT_SETBIT(cb - 1); npick = NSEL - (cb == 0 ? 1 : (cb == 1 ? 2 : 3)); }
#pragma unroll
        for (int kb = 0; kb < 2; ++kb)
#pragma unroll
            for (int kt = 0; kt < 4; ++kt)
#pragma unroll
                for (int r = 0; r < 4; ++r) { const int n = 64 * kb + 16 * kt + 4 * qd + r;
                    const bool excl = (n == 0) || (n == cb) || (n == cb - 1) || (n > cb); if (excl) imp[kb][kt][r] = -2.f; }
        for (int it = 0; it < NSEL - 1; ++it) {
            float bv = -2.f; int bn = 1 << 20;
#pragma unroll
            for (int kb = 0; kb < 2; ++kb)
#pragma unroll
                for (int kt = 0; kt < 4; ++kt)
#pragma unroll
                    for (int r = 0; r < 4; ++r) { const int n = 64 * kb + 16 * kt + 4 * qd + r; const float v = imp[kb][kt][r]; if (v > bv) { bv = v; bn = n; } }
#pragma unroll
            for (int sh = 16; sh <= 32; sh <<= 1) { const float ov = __shfl_xor(bv, sh); const int on = __shfl_xor(bn, sh); if (ov > bv || (ov == bv && on < bn)) { bv = ov; bn = on; } }
            const bool take = it < npick && bv >= 0.f;
            if (take) AT_SETBIT(bn & 127);
#pragma unroll
            for (int kb = 0; kb < 2; ++kb)
#pragma unroll
                for (int kt = 0; kt < 4; ++kt)
#pragma unroll
                    for (int r = 0; r < 4; ++r) { const int n = 64 * kb + 16 * kt + 4 * qd + r; if (n == bn) imp[kb][kt][r] = -2.f; }
        }
        if (qd == 0 && hs == 0) { __hip_atomic_fetch_or(uni + 0, (unsigned)selLo, __ATOMIC_RELAXED, __HIP_MEMORY_SCOPE_WORKGROUP); __hip_atomic_fetch_or(uni + 1, (unsigned)(selLo >> 32), __ATOMIC_RELAXED, __HIP_MEMORY_SCOPE_WORKGROUP);
            __hip_atomic_fetch_or(uni + 2, (unsigned)selHi, __ATOMIC_RELAXED, __HIP_MEMORY_SCOPE_WORKGROUP); __hip_atomic_fetch_or(uni + 3, (unsigned)(selHi >> 32), __ATOMIC_RELAXED, __HIP_MEMORY_SCOPE_WORKGROUP); }
        {
#pragma unroll
            for (int ct = 0; ct < 2; ++ct) rl[ct] *= gate(ct, 0);
#pragma unroll
            for (int dt = 0; dt < 4; ++dt)
#pragma unroll
                for (int ct = 0; ct < 2; ++ct) O[dt][ct] = (f32x4){0.f, 0.f, 0.f, 0.f};
#pragma unroll
            for (int kb = 0; kb < 2; ++kb) { f32x4 s[4][2]; qk_block(kb ? buf1 : buf0, qf, s, l15, qd); bf16x8 pf[2][2];
#pragma unroll
                for (int ct = 0; ct < 2; ++ct) {
#pragma unroll
                    for (int kt = 0; kt < 4; ++kt)
#pragma unroll
                        for (int r = 0; r < 4; ++r) { const int n = 64 * kb + 16 * kt + 4 * qd + r; const bool ok = n < nvalid;
                            s[kt][ct][r] = ok ? __builtin_amdgcn_exp2f(s[kt][ct][r] - sl2[ct] * (float)(t - (64 * n + 63)) - m[ct]) * rl[ct] : 0.f; }
                    pf[ct][0] = cvt8(s[0][ct], s[1][ct]); pf[ct][1] = cvt8(s[2][ct], s[3][ct]); }
                pv_block(kb ? buf1 : buf0, pf, O, l15, qd); }
            const float one[2] = {1.f, 1.f}; ot_merge<false>(ot, O, one, l15, qd);
        }
    }
    __syncthreads();
    AT_T(SAMP ? 4 : 0);
    const unsigned long long unLo = ((unsigned long long)__builtin_amdgcn_readfirstlane(uni[1]) << 32) | (unsigned)__builtin_amdgcn_readfirstlane(uni[0]);
    const unsigned long long unHi = ((unsigned long long)__builtin_amdgcn_readfirstlane(uni[3]) << 32) | (unsigned)__builtin_amdgcn_readfirstlane(uni[2]);
#pragma unroll
    for (int ct = 0; ct < 2; ++ct) { m[ct] = NEGF; l[ct] = 0.f; }
#pragma unroll
    for (int dt = 0; dt < 4; ++dt)
#pragma unroll
        for (int ct = 0; ct < 2; ++ct) O[dt][ct] = (f32x4){0.f, 0.f, 0.f, 0.f};
    {
        auto next_bit = [&](int from) -> int {
            if (from < 64) { const unsigned long long x = unLo & (~0ull << from); if (x) return __builtin_ctzll(x); }
            const unsigned long long y = from <= 64 ? unHi : (from < 128 ? unHi & (~0ull << (from - 64)) : 0ull);
            return y ? 64 + __builtin_ctzll(y) : 128; };
        const int last = SAMP ? 129 : 128;
        auto nextb = [&](int cur) -> int { if (cur >= 128) return 129; const int n = next_bit(cur + 1); return (n == 128 && !SAMP) ? 129 : n; };
        int b0 = next_bit(0), b1 = nextb(b0), b2 = nextb(b1), pb = 0;
        bf16x8 krA, vrA, krB, vrB;
        if (b0 < last) { stage_load<SAMP ? 2 : 0>(p, c, kvb, b0, KVG, krA, vrA, tid); stage_write(buf0, krA, vrA, tid); }
        if (b1 < last) stage_load<SAMP ? 2 : 0>(p, c, kvb, b1, KVG, krA, vrA, tid);
        __syncthreads();
        auto sel_compute = [&](int blk, LAS unsigned char* buf) {
            if (wave_on) {
                const bool bit = blk >= 128 ? true : (((blk < 64 ? selLo >> blk : selHi >> (blk - 64)) & 1ull) != 0ull);
                if (__builtin_amdgcn_ballot_w64(bit) != 0ull) online_step<1>(buf, qf, O, m, l, sl2, t, blk * 64, bit, l15, qd);
            } };
        while (b0 < last) {
            if (b2 < last) stage_load<SAMP ? 2 : 0>(p, c, kvb, b2, KVG, krB, vrB, tid);
            sel_compute(b0, pb ? buf1 : buf0); AT_CNT(SAMP ? 9 : 8);
            if (b1 < last) stage_write(pb ? buf0 : buf1, krA, vrA, tid);
            __syncthreads();
            pb ^= 1; b0 = b1; b1 = b2; b2 = nextb(b2);
            if (!(b0 < last)) break;
            if (b2 < last) stage_load<SAMP ? 2 : 0>(p, c, kvb, b2, KVG, krA, vrA, tid);
            sel_compute(b0, pb ? buf1 : buf0); AT_CNT(SAMP ? 9 : 8);
            if (b1 < last) stage_write(pb ? buf0 : buf1, krB, vrB, tid);
            __syncthreads();
            pb ^= 1; b0 = b1; b1 = b2; b2 = nextb(b2);
        }
    }
    if (wave_on) { float sc[2];
#pragma unroll
        for (int ct = 0; ct < 2; ++ct) { float ls = l[ct]; ls += __shfl_xor(ls, 16); ls += __shfl_xor(ls, 32); sc[ct] = ls > 0.f ? gate(ct, 1) / ls : 0.f; }
        ot_merge<true>(ot, O, sc, l15, qd); }
    AT_T(SAMP ? 5 : 1);
#pragma unroll
    for (int ct = 0; ct < 2; ++ct) { m[ct] = NEGF; l[ct] = 0.f; }
#pragma unroll
    for (int dt = 0; dt < 4; ++dt)
#pragma unroll
        for (int ct = 0; ct < 2; ++ct) O[dt][ct] = (f32x4){0.f, 0.f, 0.f, 0.f};
    {
        const int kb0 = SAMP ? 0 : (c.t0 >= WIN ? (c.t0 - WIN) >> 6 : 0), kb1 = SAMP ? (WIN + DSEQ - 1) >> 6 : (c.t0 + TQ - 1) >> 6;
        const int wpos0 = SAMP ? PAST - WIN : 0;
        bf16x8 krA, vrA, krB, vrB; int pb = 0;
        stage_load<SAMP ? 3 : 0>(p, c, kvb, kb0, 2 * KVG, krA, vrA, tid); stage_write(buf0, krA, vrA, tid);
        if (kb0 + 1 <= kb1) stage_load<SAMP ? 3 : 0>(p, c, kvb, kb0 + 1, 2 * KVG, krA, vrA, tid);
        __syncthreads();
        auto win_compute = [&](int kb, LAS unsigned char* buf) {
            if (wave_on) {
                const int pos0 = wpos0 + kb * 64;
                const int tlo = c.t0 + (SAMP ? 0 : 8 * wave), thi = tlo + 7;
                if (pos0 <= thi && pos0 + 63 >= tlo - WIN) online_step<2>(buf, qf, O, m, l, sl2, t, pos0, true, l15, qd);
            } };
        for (int kb = kb0; kb <= kb1; kb += 2) {
            if (kb + 2 <= kb1) stage_load<SAMP ? 3 : 0>(p, c, kvb, kb + 2, 2 * KVG, krB, vrB, tid);
            win_compute(kb, pb ? buf1 : buf0);
            if (kb + 1 <= kb1) stage_write(pb ? buf0 : buf1, krA, vrA, tid);
            __syncthreads();
            pb ^= 1;
            if (kb + 1 > kb1) break;
            if (kb + 3 <= kb1) stage_load<SAMP ? 3 : 0>(p, c, kvb, kb + 3, 2 * KVG, krA, vrA, tid);
            win_compute(kb + 1, pb ? buf1 : buf0);
            if (kb + 2 <= kb1) stage_write(pb ? buf0 : buf1, krB, vrB, tid);
            __syncthreads();
            pb ^= 1;
        }
    }
    AT_T(SAMP ? 6 : 2);
    if (wave_on) { float sc[2];
#pragma unroll
        for (int ct = 0; ct < 2; ++ct) { float ls = l[ct]; ls += __shfl_xor(ls, 16); ls += __shfl_xor(ls, 32); sc[ct] = ls > 0.f ? gate(ct, 2) / ls : 0.f; }
        ot_merge<true>(ot, O, sc, l15, qd);
        asm volatile("s_waitcnt lgkmcnt(0)" ::: "memory");
        bf16* oA = (bf16*)(p.ws + W_BFA);
#pragma unroll
        for (int i = 0; i < 4; ++i) { const int it = lane + 64 * i; const int rr = it >> 5, ch = it & 31;
            const v4u ov = *(const LAS v4u*)(ot + rr * OT_RS + ch * 16);
            const size_t grow = c.rowbase + (SAMP ? rr : 8 * wave + rr); const int col = c.g * 256 + ch * 8;
            const v4u zv = *(const v4u*)(zb + grow * D + col);
            float o[8] = {__uint_as_float(ov.x << 16), __uint_as_float(ov.x & 0xffff0000u), __uint_as_float(ov.y << 16), __uint_as_float(ov.y & 0xffff0000u),
                          __uint_as_float(ov.z << 16), __uint_as_float(ov.z & 0xffff0000u), __uint_as_float(ov.w << 16), __uint_as_float(ov.w & 0xffff0000u)};
            const float zz[8] = {__uint_as_float(zv.x << 16), __uint_as_float(zv.x & 0xffff0000u), __uint_as_float(zv.y << 16), __uint_as_float(zv.y & 0xffff0000u),
                                 __uint_as_float(zv.z << 16), __uint_as_float(zv.z & 0xffff0000u), __uint_as_float(zv.w << 16), __uint_as_float(zv.w & 0xffff0000u)};
#pragma unroll
            for (int e = 0; e < 8; ++e) o[e] *= zz[e] * __builtin_amdgcn_rcpf(1.0f + __expf(-zz[e]));
            v4u w; w.x = pk2(o[0], o[1]); w.y = pk2(o[2], o[3]); w.z = pk2(o[4], o[5]); w.w = pk2(o[6], o[7]);
            *(GAS v4u*)(oA + grow * 1024 + col) = w; }
    }
    __syncthreads();
    AT_T(SAMP ? 7 : 3);
#undef AT_SETBIT
}

__device__ __forceinline__ void attn_phase(const Params& p, LAS unsigned char* L, const bf16* qb, const bf16* kvb, unsigned* queue, unsigned long long* at_acc = nullptr) {
    LAS int* slot = (LAS int*)(L + L_UNI + 32);
    constexpr int NQB = SEQ / TQ, PER_G = BATCH * NQB;
    for (;;) {
        if (threadIdx.x == 0) *slot = (int)__hip_atomic_fetch_add(queue, 1u, __ATOMIC_RELAXED, __HIP_MEMORY_SCOPE_AGENT);
        __syncthreads();
        const int i = __builtin_amdgcn_readfirstlane(*slot);
        __syncthreads();
        if (i >= NT_P + NT_S) break;
        TileCtx c;
        int j = i; bool samp = false; int g = 0;
        if (j < PER_G) g = NKV - 1; else { j -= PER_G; if (j < NT_S) samp = true; else { j -= NT_S; g = NKV - 2 - j / PER_G; j %= PER_G; } }
        if (samp) { c.b = j / NKV; c.g = j % NKV; c.t0 = PAST; c.rowbase = (size_t)MP + (size_t)c.b * DSEQ; c.sn0 = (size_t)BATCH * NCP + (size_t)c.b * NCS;
            attn_tile<true>(p, L, c, qb, kvb, at_acc); AT_CNT(11); }
        else { const int qblk = NQB - 1 - j / BATCH; c.b = j % BATCH; c.g = g; c.t0 = qblk * TQ; c.rowbase = (size_t)c.b * SEQ + c.t0; c.sn0 = (size_t)c.b * NCP;
            attn_tile<false>(p, L, c, qb, kvb, at_acc); AT_CNT(10); }
    }
}
}

namespace cp {
using namespace nv;
typedef short bf16x8 __attribute__((ext_vector_type(8)));
constexpr int AS = 144, HS = 272;
constexpr int L_A = 0, A_BUF = 2 * 64 * AS, L_H = 2 * A_BUF, L_END = L_H + 2 * 64 * HS;
static_assert(L_END <= 131072 && NCS * CMPB <= PAST, "compress geometry");

template <int NB>
__device__ __forceinline__ void comp_unit(const Params& p, LAS unsigned char* L, int sn_first, const bf16* w1t, const bf16* w2t, const float* bias1, int tid) {
    constexpr int RT = NB / 4, TPB = 512 / NB, NV4 = NB / 4;
    const int wave = __builtin_amdgcn_readfirstlane(tid >> 6), lane = tid & 63, l15 = lane & 15, qd = lane >> 4;
    const int c = wave >> 2, pq = wave & 3;
    const int blk = tid / TPB, ck = tid % TPB, eo = ck * NB;
    const int sg = eo >> 7, sc = (eo >> 6) & 1, sd0 = eo & 63;
    const float* src; size_t tstride;
    { const int sn = sn_first + blk;
      if (sn < BATCH * NCP) { const int b = sn / NCP, n = sn % NCP; src = p.out + O_CMPP + ((size_t)b * SEQ + (size_t)n * CMPB) * KVG + eo; tstride = KVG; }
      else { const int r = sn - BATCH * NCP, bs = r / NCS, n = r % NCS, pos0 = n * CMPB; const int pg = ((const int*)p.in[I_PT])[bs * NPAGES + (pos0 >> 7)];
             src = p.in[I_CCMP] + ((size_t)pg * PAGE + (pos0 & 127)) * KVG + eo; tstride = KVG; } }
    const unsigned dstoff = (unsigned)((sc * 64 + blk * 4 + sg) * AS + sd0 * 2);
    f32x4 ra[NV4], rb[NV4];
    auto ld = [&](f32x4 (&r)[NV4], int l) {
#pragma unroll
        for (int i = 0; i < NV4; ++i) r[i] = *(const f32x4*)(src + (size_t)l * tstride + 4 * i); };
    auto st = [&](const f32x4 (&r)[NV4], int buf) {
        LAS unsigned char* d = L + L_A + buf * A_BUF + dstoff;
        if constexpr (NB == 16) { *(LAS bf16x8*)d = at::cvt8(r[0], r[1]); *(LAS bf16x8*)(d + 16) = at::cvt8(r[2], r[3]); }
        else { *(LAS at::v2u*)d = (at::v2u){pk2(r[0][0], r[0][1]), pk2(r[0][2], r[0][3])}; } };
    const bf16* wb = w1t + (((size_t)c * 64) * 128 + 32 * pq + l15) * 64 + 8 * qd;
    auto ldb = [&](bf16x8 (&b)[2][2], int l) {
#pragma unroll
        for (int ct = 0; ct < 2; ++ct)
#pragma unroll
            for (int ks = 0; ks < 2; ++ks) b[ct][ks] = *(const bf16x8*)(wb + ((size_t)l * 128 + 16 * ct) * 64 + 32 * ks); };
    f32x4 acc[RT][2];
#pragma unroll
    for (int rt = 0; rt < RT; ++rt)
#pragma unroll
        for (int ct = 0; ct < 2; ++ct) acc[rt][ct] = (f32x4){0.f, 0.f, 0.f, 0.f};
    auto compute = [&](int buf, const bf16x8 (&b)[2][2]) {
        const LAS unsigned char* a0 = L + L_A + buf * A_BUF + (c * 64 + l15) * AS + 16 * qd;
#pragma unroll
        for (int ks = 0; ks < 2; ++ks)
#pragma unroll
            for (int rt = 0; rt < RT; ++rt) { const bf16x8 a = *(const LAS bf16x8*)(a0 + 16 * rt * AS + 64 * ks);
#pragma unroll
                for (int ct = 0; ct < 2; ++ct) acc[rt][ct] = __builtin_amdgcn_mfma_f32_16x16x32_bf16(a, b[ct][ks], acc[rt][ct], 0, 0, 0); } };
    bf16x8 b0[2][2], b1[2][2];
    ld(ra, 0); ld(rb, 1); ldb(b0, 0);
    st(ra, 0);
    __syncthreads();
    for (int l = 0; l < CMPB; l += 2) {
        if (l + 2 < CMPB) ld(ra, l + 2);
        ldb(b1, l + 1);
        compute(0, b0);
        st(rb, 1);
        __syncthreads();
        if (l + 3 < CMPB) ld(rb, l + 3);
        if (l + 2 < CMPB) ldb(b0, l + 2);
        compute(1, b1);
        if (l + 2 < CMPB) st(ra, 0);
        __syncthreads();
    }
    {
        LAS unsigned short* H = (LAS unsigned short*)(L + L_H);
#pragma unroll
        for (int ct = 0; ct < 2; ++ct) { const int pp = 32 * pq + 16 * ct + l15; const float bz = bias1[c * DPHI + pp];
#pragma unroll
            for (int rt = 0; rt < RT; ++rt)
#pragma unroll
                for (int r = 0; r < 4; ++r) { const float x = acc[rt][ct][r] + bz; const float hv = x / (1.0f + __expf(-x));
                    H[((c * 64 + 16 * rt + 4 * qd + r) * HS) / 2 + pp] = (unsigned short)f2bf(hv); } }
    }
    __syncthreads();
    {
        f32x4 o2[RT];
#pragma unroll
        for (int rt = 0; rt < RT; ++rt) o2[rt] = (f32x4){0.f, 0.f, 0.f, 0.f};
        const bf16* w2 = w2t + ((size_t)(c * 64 + 16 * pq + l15)) * 128 + 8 * qd;
#pragma unroll
        for (int ks = 0; ks < 4; ++ks) { const bf16x8 b = *(const bf16x8*)(w2 + 32 * ks);
#pragma unroll
            for (int rt = 0; rt < RT; ++rt) { const bf16x8 a = *(const LAS bf16x8*)(L + L_H + (c * 64 + 16 * rt + l15) * HS + (32 * ks + 8 * qd) * 2);
                o2[rt] = __builtin_amdgcn_mfma_f32_16x16x32_bf16(a, b, o2[rt], 0, 0, 0); } }
        const int dd = 16 * pq + l15; const float b2 = p.in[I_BPHI2][c * HD + dd];
        float* comp = p.ws + W_COMP;
#pragma unroll
        for (int rt = 0; rt < RT; ++rt)
#pragma unroll
            for (int r = 0; r < 4; ++r) { const int row = 16 * rt + 4 * qd + r; const int sn = sn_first + (row >> 2), g = row & 3;
                comp[((size_t)sn * NKV + g) * 128 + c * HD + dd] = o2[rt][r] + b2; }
    }
    __syncthreads();
}

__device__ __forceinline__ void comp_bias(const Params& p, float* bias1, int gw, int ngw, int lane) {
    for (int o = gw; o < 2 * DPHI; o += ngw) { const int c = o / DPHI, pp = o % DPHI; float s = 0.f;
        for (int i = lane; i < CMPB * HD; i += 64) { const int l = i >> 6, d = i & 63; s += p.in[I_PE][((size_t)l * 2 + c) * HD + d] * p.in[I_WPHI1][(((size_t)c * CMPB + l) * HD + d) * DPHI + pp]; }
#pragma unroll
        for (int sh = 1; sh < 64; sh <<= 1) s += __shfl_xor(s, sh);
        if (lane == 0) bias1[o] = s + p.in[I_BPHI1][o]; }
}
}

namespace ms {
using namespace nv;
__device__ __forceinline__ float wave_sum(float v) {
#pragma unroll
    for (int o = 1; o < 64; o <<= 1) v += __shfl_xor(v, o);
    return v;
}
constexpr int ADA_TILES = 2 * (3 * D / 64);
__device__ __forceinline__ void ada_phase(const Params& p, LAS unsigned char* L, int tid) {
    const int wave = __builtin_amdgcn_readfirstlane(tid >> 6), lane = tid & 63;
    LAS float* sc = (LAS float*)L;
    LAS float* red = (LAS float*)(L + 17 * 1024 * 4);
    static_assert(NC <= 34, "ada tile assumes at most 34 condition rows");
    float* mod = p.ws + W_MOD;
    for (int tile = blockIdx.x; tile < ADA_TILES; tile += gridDim.x) {
        const int layer = tile / (3 * D / 64), n = (tile % (3 * D / 64)) * 64 + lane;
        const float* w = p.in[I_WADA] + (size_t)layer * D * 3 * D + n;
        for (int half = 0; half < 2; ++half) {
            const int r0 = half * 17, nr = NC - r0 < 17 ? NC - r0 : 17;
            __syncthreads();
            for (int i = tid; i < nr * 1024; i += 512) { const int r = r0 + (i >> 10), k = i & 1023;
                const float cv = r < BATCH ? p.in[I_CP][(size_t)r * D + k] : p.in[I_CS][(size_t)(r - BATCH) * D + k]; sc[i] = cv / (1.0f + __expf(-cv)); }
            __syncthreads();
            float acc[17];
#pragma unroll
            for (int r = 0; r < 17; ++r) acc[r] = 0.f;
            for (int kk = 0; kk < 128; kk += 16) { float wv[16];
#pragma unroll
                for (int j = 0; j < 16; ++j) wv[j] = w[(size_t)(wave * 128 + kk + j) * 3 * D];
#pragma unroll
                for (int j = 0; j < 16; ++j)
#pragma unroll
                    for (int r = 0; r < 17; ++r) acc[r] += sc[r * 1024 + wave * 128 + kk + j] * wv[j]; }
#pragma unroll
            for (int r = 0; r < 17; ++r) red[(wave * 17 + r) * 64 + lane] = acc[r];
            __syncthreads();
            for (int i = tid; i < nr * 64; i += 512) { const int r = i >> 6, c = i & 63; float s = 0.f;
#pragma unroll
                for (int wv = 0; wv < 8; ++wv) s += red[(wv * 17 + r) * 64 + c];
                const int nn = (tile % (3 * D / 64)) * 64 + c;
                mod[((size_t)layer * NC + r0 + r) * 3 * D + nn] = s + p.in[I_BADA][layer * 3 * D + nn]; }
        }
    }
    __syncthreads();
}
__device__ __forceinline__ void mod0_phase(const Params& p, long gtid, long gsz) {
    const float* mod = p.ws + W_MOD; bf16* mA = (bf16*)(p.ws + W_BFA);
    for (long it = gtid; it < (long)M * 128; it += gsz) { const long row = it >> 7; const int c8 = (int)(it & 127) * 8; const int ci = cond_of((int)row);
        const float* x = row < MP ? p.in[I_XP] + row * D + c8 : p.in[I_XS] + (row - MP) * D + c8;
        const float* sh = mod + (size_t)ci * 3 * D + c8; const float* scl = sh + D;
        const f32x4 x0 = *(const f32x4*)x, x1 = *(const f32x4*)(x + 4), s0 = *(const f32x4*)scl, s1 = *(const f32x4*)(scl + 4), h0 = *(const f32x4*)sh, h1 = *(const f32x4*)(sh + 4);
        *(GAS v4u*)(mA + row * 1024 + c8) = __builtin_bit_cast(v4u, at::cvt8(x0 * (1.0f + s0) + h0, x1 * (1.0f + s1) + h1)); }
}
template <int LAYER> __device__ __forceinline__ void ln_phase(const Params& p, int tid) {
    const int wave = __builtin_amdgcn_readfirstlane(tid >> 6), lane = tid & 63;
    const float* f = p.ws + W_F; const float* lg = p.in[I_LNG] + LAYER * D; const float* lb = p.in[I_LNB] + LAYER * D;
    for (int row = blockIdx.x * 8 + wave; row < M; row += gridDim.x * 8) {
        const int ci = cond_of(row);
        const float* x = LAYER == 0 ? (row < MP ? p.in[I_XP] + (size_t)row * D : p.in[I_XS] + (size_t)(row - MP) * D) : p.ws + W_X1 + (size_t)row * D;
        const float* gt = p.ws + W_MOD + ((size_t)LAYER * NC + ci) * 3 * D + 2 * D;
        f32x4 v[4]; float s = 0.f;
#pragma unroll
        for (int j = 0; j < 4; ++j) { const int o = 4 * lane + 256 * j; const f32x4 xv = *(const f32x4*)(x + o), fv = *(const f32x4*)(f + (size_t)row * D + o), gv = *(const f32x4*)(gt + o);
            v[j] = ALPHA * xv + (1.0f + gv) * fv; s += (v[j][0] + v[j][1]) + (v[j][2] + v[j][3]); }
        const float mu = wave_sum(s) * (1.0f / D); float s2 = 0.f;
#pragma unroll
        for (int j = 0; j < 4; ++j) { v[j] = v[j] - mu; s2 += (v[j][0] * v[j][0] + v[j][1] * v[j][1]) + (v[j][2] * v[j][2] + v[j][3] * v[j][3]); }
        const float rstd = 1.0f / sqrtf(wave_sum(s2) * (1.0f / D) + LN_EPS);
#pragma unroll
        for (int j = 0; j < 4; ++j) { const int o = 4 * lane + 256 * j; const f32x4 y = v[j] * rstd * *(const f32x4*)(lg + o) + *(const f32x4*)(lb + o);
            if (LAYER == 0) {
                *(f32x4*)(p.ws + W_X1 + (size_t)row * D + o) = y;
                const float* sh = p.ws + W_MOD + ((size_t)NC + ci) * 3 * D + o; const f32x4 m1 = y * (1.0f + *(const f32x4*)(sh + D)) + *(const f32x4*)sh;
                *(GAS at::v2u*)((bf16*)(p.ws + W_BFB) + (size_t)row * D + o) = (at::v2u){pk2(y[0], y[1]), pk2(y[2], y[3])};
                *(GAS at::v2u*)((bf16*)(p.ws + W_BFA) + (size_t)row * D + o) = (at::v2u){pk2(m1[0], m1[1]), pk2(m1[2], m1[3])};
            } else {
                float* dst = row < MP ? p.out + O_YP + (size_t)row * D + o : p.out + O_YS + (size_t)(row - MP) * D + o;
                *(f32x4*)dst = y;
            } }
    }
}
__device__ __forceinline__ void copy_win_state(const Params& p, long gtid, long gsz) {
    for (long it = gtid; it < (long)DECB * (WIN - DSEQ) * KVG / 4; it += gsz) { const long e = it * 4; const long bs = e / ((long)(WIN - DSEQ) * KVG), r = e % ((long)(WIN - DSEQ) * KVG);
        *(f32x4*)(p.out + O_WINS + bs * WIN * KVG + r) = *(const f32x4*)(p.in[I_SWIN] + bs * WIN * KVG + (long)DSEQ * KVG + r); }
}
__device__ __forceinline__ void copy_conv_state(const Params& p, long gtid, long gsz) {
    const float* u0 = p.ws + W_U0;
    for (long it = gtid; it < (long)NC * 3 * D; it += gsz) { const int d = (int)(it % D); const int j = (int)((it / D) % 3); const int sq = (int)(it / (3 * D));
        if (sq < BATCH) p.out[O_CONVP + it] = u0[((size_t)sq * SEQ + SEQ - 3 + j) * 2 * D + d];
        else p.out[O_CONVS + (it - (long)BATCH * 3 * D)] = u0[((size_t)MP + (size_t)(sq - BATCH) * DSEQ + DSEQ - 3 + j) * 2 * D + d]; }
}
}

constexpr int NTHREADS = 512, NWAVES = 8;
constexpr int LDS_BYTES = 147456;
constexpr int RING_OFF = 0;
constexpr int MISC_OFF = 131072 + 320;
constexpr int NKVIN = 3840;
constexpr long W_WT_INA = nv::W_END2, W_WT_OUTA = W_WT_INA + 2048L * 1024 / 2, W_WT_KVIN = W_WT_OUTA + 1024L * 1024 / 2,
    W_WT_OUTB = W_WT_KVIN + (long)NKVIN * 1024 / 2, W_AGG = W_WT_OUTB + 1024L * 1024 / 2, W_W1T = W_AGG + 2L * nv::BATCH * (nv::SEQ / 128) * 1024, W_W2T = W_W1T + 2L * 64 * 128 * 64 / 2,
    W_B1 = W_W2T + 2L * 64 * 128 / 2, W_FAST_END = W_B1 + 256;
constexpr size_t CTL_BYTES = 1u << 20;
constexpr size_t WS_CTL_OFF = ((size_t)W_FAST_END * 4 + 4095) / 4096 * 4096;
constexpr int CW_BAR = 4096, CW_QUEUE = 1024;
struct Args { nv::Params p; unsigned char* ctl; };
static_assert(nv::D == 1024 && nv::M % 256 == 0, "fast GEMM path is built for d_model 1024 and M % 256 == 0");

__device__ __forceinline__ void p0_prologue(const nv::Params& p, LAS unsigned char* L, int wave, int lane) {
    LAS float* scr = (LAS float*)(L + RING_OFF + wave * 16384);
    const int gw = blockIdx.x * NWAVES + wave, NGW = gridDim.x * NWAVES;
    bf16* wt_ina = (bf16*)(p.ws + W_WT_INA); bf16* wt_outa = (bf16*)(p.ws + W_WT_OUTA); bf16* wt_kvin = (bf16*)(p.ws + W_WT_KVIN); bf16* wt_outb = (bf16*)(p.ws + W_WT_OUTB);
    constexpr int I_A = 16 * (2048 / 32), I_B = 16 * (1024 / 32), I_C = 16 * (1536 / 32), I_D = 16 * ((nv::NU + 31) / 32), I_E = 16 * (1024 / 32), I_F = 2 * 64 * 4, I_G = 2 * 4;
    bf16* w1t = (bf16*)(p.ws + W_W1T); bf16* w2t = (bf16*)(p.ws + W_W2T);
    for (int it = gw; it < I_A + I_B + I_C + I_D + I_E + I_F + I_G; it += NGW) {
        int r = it;
        if (r < I_A) { wt_transpose_item(p.in[nv::I_WINA], 1024, 2048, wt_ina, 0, scr, r, lane); continue; } r -= I_A;
        if (r < I_B) { wt_transpose_item(p.in[nv::I_WOUTA], 1024, 1024, wt_outa, 0, scr, r, lane); continue; } r -= I_B;
        if (r < I_C) { wt_transpose_item(p.in[nv::I_WKV], 1024, 1536, wt_kvin, 0, scr, r, lane); continue; } r -= I_C;
        if (r < I_D) { wt_transpose_item(p.in[nv::I_WINB], 1024, nv::NU, wt_kvin, 1536, scr, r, lane); continue; } r -= I_D;
        if (r < I_E) { wt_transpose_item(p.in[nv::I_WOUTB], 1024, 1024, wt_outb, 0, scr, r, lane); continue; } r -= I_E;
        if (r < I_F) { const int cl = r >> 2; wt_transpose_item(p.in[nv::I_WPHI1] + (size_t)cl * 64 * 128, 64, 128, w1t + (size_t)cl * 128 * 64, 0, scr, r & 3, lane); continue; } r -= I_F;
        { const int c = r >> 2; wt_transpose_item(p.in[nv::I_WPHI2] + (size_t)c * 128 * 64, 128, 64, w2t + (size_t)c * 64 * 128, 0, scr, r & 3, lane); }
    }
    cp::comp_bias(p, p.ws + W_B1, gw, NGW, lane);
    constexpr int ZR0 = 1536 + ((nv::NU + 31) / 32) * 32;
    for (long i = (long)blockIdx.x * NTHREADS + opaque_tid(); i < (long)(NKVIN - ZR0) * 1024 / 8; i += (long)gridDim.x * NTHREADS)
        ((GAS v4u*)(wt_kvin + (size_t)ZR0 * 1024))[i] = (v4u){0u, 0u, 0u, 0u};
}

__global__ void __launch_bounds__(NTHREADS, 2) mk_fwd(Args args) {
    extern __shared__ __attribute__((aligned(16))) unsigned char lds[];
    LAS unsigned char* L = (LAS unsigned char*)lds;
    volatile LAS unsigned* MISC = (volatile LAS unsigned*)(L + MISC_OFF);
    for (int u = threadIdx.x; u < 32; u += NTHREADS) MISC[u] = 0u;
    __syncthreads();
    XcdBarrier bar = xcd_barrier_post((unsigned*)(args.ctl) + CW_BAR, MISC + 8);
    const long gsz = (long)gridDim.x * NTHREADS;
    const nv::Params& p = args.p;
    const int G = gridDim.x;
#define NAIVE(k) nv::run_phase<k>(p, (long)blockIdx.x * NTHREADS + opaque_tid(), gsz)
#define BAR() xcd_barrier(bar)
    { const int t_ = opaque_tid(); p0_prologue(p, L, __builtin_amdgcn_readfirstlane(t_ >> 6), t_ & 63); } ms::ada_phase(p, L, opaque_tid()); ms::copy_win_state(p, (long)blockIdx.x * NTHREADS + opaque_tid(), gsz); BAR();
    ms::mod0_phase(p, (long)blockIdx.x * NTHREADS + opaque_tid(), gsz);
    { const int t_ = opaque_tid();
      for (int uu = blockIdx.x; uu < nv::DECB * nv::NCS / 16; uu += G) cp::comp_unit<16>(p, L, nv::BATCH * nv::NCP + uu * 16, (const bf16*)(p.ws + W_W1T), (const bf16*)(p.ws + W_W2T), p.ws + W_B1, t_); }
    BAR();
    {
        pg8::Gemm g{(const pg8::bf16_t*)(p.ws + nv::W_BFA), (const pg8::bf16_t*)(p.ws + W_WT_INA), nv::M, 2048, 1024, (const pg8::bf16_t*)(p.ws + nv::W_BFA), 1 << 30};
        pg8::StaticOrder S; S.init(nv::M, 2048, G, (int)blockIdx.x);
        pg8::EpiF32Split E{p.ws + nv::W_U0, 2048, 2048, nullptr, 0, 0};
        pg8::gemm_phase<pg8::EpiF32Split, pg8::StaticOrder, true, true>(L + RING_OFF, g, S, E);
    }
    BAR();
    rg::rg_pass<1>(p, L, p.ws + W_AGG); ms::copy_conv_state(p, (long)blockIdx.x * NTHREADS + opaque_tid(), gsz); BAR();
    rg::rg_pass<2>(p, L, p.ws + W_AGG); BAR();
    {
        pg8::Gemm g{(const pg8::bf16_t*)(p.ws + nv::W_BFA), (const pg8::bf16_t*)(p.ws + W_WT_OUTA), nv::M, 1024, 1024, (const pg8::bf16_t*)(p.ws + nv::W_BFA), 1 << 30};
        pg8::StaticOrder S; S.init(nv::M, 1024, G, (int)blockIdx.x);
        pg8::EpiF32Split E{p.ws + nv::W_F, 1024, 1024, nullptr, 0, 0};
        pg8::gemm_phase<pg8::EpiF32Split, pg8::StaticOrder, true, true>(L + RING_OFF, g, S, E);
    }
    BAR();
    ms::ln_phase<0>(p, opaque_tid()); BAR();
    {
        pg8::Gemm g{(const pg8::bf16_t*)(p.ws + nv::W_BFB), (const pg8::bf16_t*)(p.ws + W_WT_KVIN), nv::M, NKVIN, 1024, (const pg8::bf16_t*)(p.ws + nv::W_BFA), 6};
        pg8::StaticOrder S; S.init(nv::M, NKVIN, G, (int)blockIdx.x);
        pg8::EpiKvU E{p.out, (pg8::bf16_t*)(p.ws + nv::W_PC), (pg8::bf16_t*)(p.ws + at::W_QB), (pg8::bf16_t*)(p.ws + at::W_ZB), p.ws + at::W_GL};
        pg8::gemm_phase<pg8::EpiKvU, pg8::StaticOrder, true, true>(L + RING_OFF, g, S, E);
    }
    BAR();
    { const int t_ = opaque_tid();
      for (int uu = blockIdx.x; uu < nv::BATCH * nv::NCP / 4; uu += G) cp::comp_unit<4>(p, L, uu * 4, (const bf16*)(p.ws + W_W1T), (const bf16*)(p.ws + W_W2T), p.ws + W_B1, t_); }
    BAR();
    at::attn_phase(p, L, (const bf16*)(p.ws + at::W_QB), (const bf16*)(p.ws + nv::W_PC), (unsigned*)(args.ctl) + CW_QUEUE); BAR();
    {
        pg8::Gemm g{(const pg8::bf16_t*)(p.ws + nv::W_BFA), (const pg8::bf16_t*)(p.ws + W_WT_OUTB), nv::M, 1024, 1024, (const pg8::bf16_t*)(p.ws + nv::W_BFA), 1 << 30};
        pg8::StaticOrder S; S.init(nv::M, 1024, G, (int)blockIdx.x);
        pg8::EpiF32Split E{p.ws + nv::W_F, 1024, 1024, nullptr, 0, 0};
        pg8::gemm_phase<pg8::EpiF32Split, pg8::StaticOrder, true, true>(L + RING_OFF, g, S, E);
    }
    BAR();
    ms::ln_phase<1>(p, opaque_tid());
#undef NAIVE
#undef BAR
}

extern "C" void kernel_launch(void* const* d_in, const int* in_sizes, int n_in,
                              void* d_out, int out_size, void* d_ws, size_t ws_size,
                              hipStream_t stream) {
    static int grid = 0;
    if (grid == 0) {
        if (n_in != nv::I_N || out_size != (int)nv::O_END || ws_size < WS_CTL_OFF + CTL_BYTES) { fprintf(stderr, "kernel_launch: unexpected sizes n_in %d out %d ws %zu\n", n_in, out_size, ws_size); grid = -1; return; }
        int dev = 0, cus = 0, per_cu = 0;
        if (hipGetDevice(&dev) != hipSuccess || hipDeviceGetAttribute(&cus, hipDeviceAttributeMultiprocessorCount, dev) != hipSuccess) { grid = -1; return; }
        if (hipFuncSetAttribute((const void*)mk_fwd, hipFuncAttributeMaxDynamicSharedMemorySize, LDS_BYTES) != hipSuccess) { fprintf(stderr, "kernel_launch: hipFuncSetAttribute failed\n"); grid = -1; return; }
        if (hipOccupancyMaxActiveBlocksPerMultiprocessor(&per_cu, (const void*)mk_fwd, NTHREADS, LDS_BYTES) != hipSuccess || per_cu < 1) fprintf(stderr, "kernel_launch: occupancy query reports %d\n", per_cu);
        (void)hipGetLastError();
        grid = cus;
    }
    if (grid < 0) return;
    unsigned char* ctl = (unsigned char*)d_ws + WS_CTL_OFF;
    if (hipMemsetAsync(ctl, 0, CTL_BYTES, stream) != hipSuccess) return;
    Args a{};
    for (int i = 0; i < nv::I_N; ++i) a.p.in[i] = (const float*)d_in[i];
    a.p.out = (float*)d_out; a.p.ws = (float*)d_ws; a.ctl = ctl;
    hipLaunchKernelGGL(mk_fwd, dim3(grid), dim3(NTHREADS), LDS_BYTES, stream, a);
}
```

```cpp
#include <hip/hip_runtime.h>
#include <cstdio>
#include <cstdint>
#ifndef CFG_D
#define CFG_D 1024
#define CFG_BATCH 2
#define CFG_SEQ 8192
#define CFG_DECB 32
#define CFG_PAST 8192
#define CFG_NRG 8
#define CFG_NH 16
#define CFG_NKV 4
#endif
namespace nv {
constexpr int D = CFG_D, BATCH = CFG_BATCH, SEQ = CFG_SEQ, DECB = CFG_DECB, DSEQ = 8, PAST = CFG_PAST, PAGE = 128;
constexpr int NRG = CFG_NRG, RGB = D / NRG, NH = CFG_NH, HD = 64, NKV = CFG_NKV, HPG = NH / NKV;
static_assert(D == NH * HD && HPG == 4, "geometry");
constexpr int CMPB = 64, NSEL = 16, WIN = 512, DPHI = 128;
constexpr int MP = BATCH * SEQ, MS = DECB * DSEQ, M = MP + MS, NC = BATCH + DECB;
constexpr int NKVC = 3 * NKV * 2 * HD;
constexpr int KVG = NKV * 2 * HD;
constexpr int NU = 2 * D + 3 * NH;
constexpr int NCP = SEQ / CMPB, NCS = (PAST + DSEQ) / CMPB, NSBS = (PAST + DSEQ + CMPB - 1) / CMPB;
constexpr int NSBMAX = ((NCP > NSBS ? NCP : NSBS) + 7) / 8 * 8;
constexpr int NPAGES = PAST / PAGE;
constexpr int NSEQN = BATCH * NCP + DECB * NCS;
constexpr float ALPHA = 1.4142135623730951f;
constexpr float LN_EPS = 1e-5f;
static_assert(PAST >= WIN && SEQ >= WIN, "window geometry");

constexpr long O_YP = 0, O_YS = O_YP + (long)MP * D, O_CMPP = O_YS + (long)MS * D, O_SELP = O_CMPP + (long)MP * KVG,
    O_WINP = O_SELP + (long)MP * KVG, O_HP = O_WINP + (long)BATCH * WIN * KVG, O_CONVP = O_HP + (long)BATCH * D,
    O_CMPS = O_CONVP + (long)BATCH * 3 * D, O_SELS = O_CMPS + (long)MS * KVG, O_WINS = O_SELS + (long)MS * KVG,
    O_HS = O_WINS + (long)DECB * WIN * KVG, O_CONVS = O_HS + (long)DECB * D, O_END = O_CONVS + (long)DECB * 3 * D;

enum { I_XP, I_XS, I_CP, I_CS, I_STH, I_STC, I_CCMP, I_CSEL, I_SWIN, I_PT, I_WADA, I_BADA, I_LNG, I_LNB, I_WINA, I_CONVW, I_CONVB,
       I_WR, I_BR, I_WI, I_BI, I_LAM, I_WOUTA, I_WKV, I_PE, I_WPHI1, I_BPHI1, I_WPHI2, I_BPHI2, I_WINB, I_BGATE, I_WOUTB, I_N };

struct WS {
    float *mod, *mA, *u0, *xc, *ga, *gb, *fbuf, *x1, *kv, *u, *hid, *comp, *pc, *ocmp, *osel, *owin, *obuf; int* idx;
};
constexpr long al(long x) { return (x + 63) / 64 * 64; }
constexpr long W_MOD = 0, W_MA = W_MOD + al(2L * NC * 3 * D), W_U0 = W_MA + al((long)M * D), W_XC = W_U0 + al((long)M * 2 * D),
    W_GA = W_XC + al((long)M * D), W_GB = W_GA + al((long)M * D), W_F = W_GB + al((long)M * D), W_X1 = W_F + al((long)M * D),
    W_KV = W_X1 + al((long)M * D), W_U = W_KV + al((long)M * NKVC), W_HID = W_U + al((long)M * NU),
    W_COMP = W_HID + al((long)NSEQN * NKV * 2 * DPHI), W_PC = W_COMP + al((long)NSEQN * NKV * 2 * HD),
    W_OCMP = W_PC + al((long)M * NH * NSBMAX), W_OSEL = W_OCMP + al((long)M * D), W_OWIN = W_OSEL + al((long)M * D),
    W_OBUF = W_OWIN + al((long)M * D), W_IDX = W_OBUF + al((long)M * D), W_END = W_IDX + al((long)M * NKV * NSEL);

constexpr long W_BFA = W_END, W_BFB = W_BFA + al((long)M * D / 2), W_END2 = W_BFB + al((long)M * D / 2);
struct Params { const float* in[I_N]; float* out; float* ws; };
static inline
#ifndef HOST_EMU
__device__
#endif
unsigned short f2bf_rne(float f) { unsigned u; __builtin_memcpy(&u, &f, 4); return (unsigned short)((u + 0x7fffu + ((u >> 16) & 1u)) >> 16); }

#ifdef HOST_EMU
#define NV_DEV static inline
#else
#define NV_DEV __device__ __forceinline__
#endif

NV_DEV float silu_f(float x) { return x / (1.0f + expf(-x)); }
NV_DEV float sigm_f(float x) { return 1.0f / (1.0f + expf(-x)); }
NV_DEV int cond_of(int row) { return row < MP ? row / SEQ : BATCH + (row - MP) / DSEQ; }
NV_DEV int pos_of(int row) { return row < MP ? row % SEQ : PAST + (row - MP) % DSEQ; }
NV_DEV float slope_of(int H) { return exp2f(-8.0f * (float)(H + 1) / (float)NH); }

NV_DEV void ph_ada(const Params& p, long gtid, long gsz) {
    float* mod = p.ws + W_MOD;
    for (long it = gtid; it < 2L * NC * 3 * D; it += gsz) {
        const int n = (int)(it % (3 * D)); const int ci = (int)((it / (3 * D)) % NC); const int layer = (int)(it / (3L * D * NC));
        const float* c = ci < BATCH ? p.in[I_CP] + (long)ci * D : p.in[I_CS] + (long)(ci - BATCH) * D;
        const float* w = p.in[I_WADA] + (long)layer * D * 3 * D;
        float acc = 0.f;
        for (int k = 0; k < D; ++k) acc += silu_f(c[k]) * w[(long)k * 3 * D + n];
        mod[it] = acc + p.in[I_BADA][layer * 3 * D + n];
    }
}
NV_DEV void ph_mod(const Params& p, int layer, long gtid, long gsz) {
    const float* mod = p.ws + W_MOD + (long)layer * NC * 3 * D; float* mA = p.ws + W_MA;
    for (long it = gtid; it < (long)M * D; it += gsz) {
        const int row = (int)(it / D), k = (int)(it % D); const int ci = cond_of(row);
        float x;
        if (layer == 0) x = row < MP ? p.in[I_XP][it] : p.in[I_XS][it - (long)MP * D];
        else x = (p.ws + W_X1)[it];
        const float v = x * (1.0f + mod[(long)ci * 3 * D + D + k]) + mod[(long)ci * 3 * D + k];
        mA[it] = v; ((unsigned short*)(p.ws + W_BFA))[it] = f2bf_rne(v);
    }
}
NV_DEV void gemm_naive(const float* A, int lda, const float* W, int ldw, float* C, int ldc, int Mr, int N, int K, long gtid, long gsz) {
    for (long it = gtid; it < (long)(Mr / 4) * N; it += gsz) {
        const int n = (int)(it % N); const long r0 = (it / N) * 4;
        float a0 = 0.f, a1 = 0.f, a2 = 0.f, a3 = 0.f;
        const float* A0 = A + r0 * lda;
        for (int k = 0; k < K; ++k) { const float w = W[(long)k * ldw + n];
            a0 += A0[k] * w; a1 += A0[lda + k] * w; a2 += A0[2 * lda + k] * w; a3 += A0[3 * lda + k] * w; }
        C[r0 * ldc + n] = a0; C[(r0 + 1) * ldc + n] = a1; C[(r0 + 2) * ldc + n] = a2; C[(r0 + 3) * ldc + n] = a3;
    }
}
NV_DEV void ph_conv(const Params& p, long gtid, long gsz) {
    const float* u0 = p.ws + W_U0; float* xc = p.ws + W_XC;
    for (long it = gtid; it < (long)M * D; it += gsz) {
        const int row = (int)(it / D), d = (int)(it % D);
        const int t = row < MP ? row % SEQ : (row - MP) % DSEQ;
        float acc = p.in[I_CONVB][d];
        for (int k = 0; k < 4; ++k) { const int j = t - 3 + k;
            float v;
            if (j >= 0) v = u0[(long)(row - t + j) * 2 * D + d];
            else v = row < MP ? 0.f : p.in[I_STC][((long)((row - MP) / DSEQ) * 3 + (3 + j)) * D + d];
            acc += v * p.in[I_CONVW][k * D + d]; }
        xc[it] = acc;
    }
}
NV_DEV void ph_gates(const Params& p, long gtid, long gsz) {
    const float* xc = p.ws + W_XC; float* ga = p.ws + W_GA; float* gb = p.ws + W_GB;
    for (long it = gtid; it < (long)M * D; it += gsz) {
        const int row = (int)(it / D), d = (int)(it % D); const int n = d / RGB, dd = d % RGB;
        const float* x = xc + (long)row * D + n * RGB;
        const float* wr = p.in[I_WR] + (long)n * RGB * RGB + dd; const float* wi = p.in[I_WI] + (long)n * RGB * RGB + dd;
        float ar = 0.f, ai = 0.f;
        for (int c = 0; c < RGB; ++c) { ar += x[c] * wr[(long)c * RGB]; ai += x[c] * wi[(long)c * RGB]; }
        const float r = sigm_f(ar + p.in[I_BR][d]), i = sigm_f(ai + p.in[I_BI][d]);
        const float lam = p.in[I_LAM][d];
        const float sp = (-lam > 20.f) ? -lam : log1pf(expf(-lam));
        const float log_a = -8.0f * sp * r;
        const float a = expf(log_a);
        const float gain = sqrtf(fmaxf(-expm1f(2.0f * log_a), 0.f));
        float b = gain * i * xc[it];
        const int t = row < MP ? row % SEQ : (row - MP) % DSEQ;
        if (t == 0 && row >= MP) b += a * p.in[I_STH][(long)((row - MP) / DSEQ) * D + d];
        ga[it] = a; gb[it] = b;
    }
}
NV_DEV void ph_scan(const Params& p, long gtid, long gsz) {
    const float* ga = p.ws + W_GA; float* gb = p.ws + W_GB;
    for (long it = gtid; it < (long)NC * D; it += gsz) {
        const int sq = (int)(it / D), d = (int)(it % D);
        const long row0 = sq < BATCH ? (long)sq * SEQ : MP + (long)(sq - BATCH) * DSEQ; const int T = sq < BATCH ? SEQ : DSEQ;
        float h = 0.f;
        for (int t = 0; t < T; ++t) { const long o = (row0 + t) * D + d; h = ga[o] * h + gb[o]; gb[o] = h; }
        if (sq < BATCH) p.out[O_HP + (long)sq * D + d] = h; else p.out[O_HS + (long)(sq - BATCH) * D + d] = h;
    }
}
NV_DEV void ph_gated(const Params& p, long gtid, long gsz) {
    const float* hs = p.ws + W_GB; const float* u0 = p.ws + W_U0; float* mA = p.ws + W_MA;
    for (long it = gtid; it < (long)M * D; it += gsz) { const long row = it / D; const int d = (int)(it % D);
        const float v = hs[it] * silu_f(u0[row * 2 * D + D + d]); mA[it] = v; ((unsigned short*)(p.ws + W_BFA))[it] = f2bf_rne(v); }
}
NV_DEV void ph_ln(const Params& p, int layer, long gtid, long gsz) {
    const float* mod = p.ws + W_MOD + (long)layer * NC * 3 * D; const float* f = p.ws + W_F;
    for (long row = gtid; row < M; row += gsz) {
        const int ci = cond_of((int)row);
        const float* x = layer == 0 ? (row < MP ? p.in[I_XP] + row * D : p.in[I_XS] + (row - MP) * D) : p.ws + W_X1 + row * D;
        const float* gt = mod + (long)ci * 3 * D + 2 * D; const float* fr = f + row * D;
        float s = 0.f;
        for (int k = 0; k < D; ++k) s += ALPHA * x[k] + (1.0f + gt[k]) * fr[k];
        const float mu = s / D; float v = 0.f;
        for (int k = 0; k < D; ++k) { const float e = ALPHA * x[k] + (1.0f + gt[k]) * fr[k] - mu; v += e * e; }
        const float rstd = 1.0f / sqrtf(v / D + LN_EPS);
        float* dst = layer == 0 ? p.ws + W_X1 + row * D : (row < MP ? p.out + O_YP + row * D : p.out + O_YS + (row - MP) * D);
        const float* lg = p.in[I_LNG] + layer * D; const float* lb = p.in[I_LNB] + layer * D;
        for (int k = 0; k < D; ++k) { const float v = (ALPHA * x[k] + (1.0f + gt[k]) * fr[k] - mu) * rstd * lg[k] + lb[k]; dst[k] = v;
            if (layer == 0) ((unsigned short*)(p.ws + W_BFB))[row * D + k] = f2bf_rne(v); }
    }
}
NV_DEV void ph_outputs(const Params& p, long gtid, long gsz) {
    const float* kv = p.ws + W_KV; const float* u0 = p.ws + W_U0;
    for (long it = gtid; it < (long)MP * KVG; it += gsz) { const long row = it / KVG; const int c = (int)(it % KVG);
        p.out[O_CMPP + it] = kv[row * NKVC + c]; p.out[O_SELP + it] = kv[row * NKVC + KVG + c]; }
    for (long it = gtid; it < (long)BATCH * WIN * KVG; it += gsz) { const int c = (int)(it % KVG); const int j = (int)((it / KVG) % WIN); const int b = (int)(it / ((long)KVG * WIN));
        p.out[O_WINP + it] = kv[((long)b * SEQ + SEQ - WIN + j) * NKVC + 2 * KVG + c]; }
    for (long it = gtid; it < (long)MS * KVG; it += gsz) { const long row = MP + it / KVG; const int c = (int)(it % KVG);
        p.out[O_CMPS + it] = kv[row * NKVC + c]; p.out[O_SELS + it] = kv[row * NKVC + KVG + c]; }
    for (long it = gtid; it < (long)DECB * WIN * KVG; it += gsz) { const int c = (int)(it % KVG); const int j = (int)((it / KVG) % WIN); const int bs = (int)(it / ((long)KVG * WIN));
        const int jj = j + DSEQ;
        p.out[O_WINS + it] = jj < WIN ? p.in[I_SWIN][((long)bs * WIN + jj) * KVG + c] : kv[((long)MP + bs * DSEQ + (jj - WIN)) * NKVC + 2 * KVG + c]; }
    for (long it = gtid; it < (long)BATCH * 3 * D; it += gsz) { const int d = (int)(it % D); const int j = (int)((it / D) % 3); const int b = (int)(it / (3 * D));
        p.out[O_CONVP + it] = u0[((long)b * SEQ + SEQ - 3 + j) * 2 * D + d]; }
    for (long it = gtid; it < (long)DECB * 3 * D; it += gsz) { const int d = (int)(it % D); const int j = (int)((it / D) % 3); const int bs = (int)(it / (3 * D));
        p.out[O_CONVS + it] = u0[((long)MP + bs * DSEQ + DSEQ - 3 + j) * 2 * D + d]; }
}
NV_DEV const float* cmp_src_row(const Params& p, int sn, int l, int& ok) {
    ok = 1;
    if (sn < BATCH * NCP) { const int b = sn / NCP, n = sn % NCP; return p.ws + W_KV + ((long)b * SEQ + n * CMPB + l) * NKVC; }
    const int r = sn - BATCH * NCP; const int bs = r / NCS, n = r % NCS; const int pos = n * CMPB + l;
    if (pos < PAST) { const int pg = ((const int*)p.in[I_PT])[bs * NPAGES + pos / PAGE]; return p.in[I_CCMP] + ((long)pg * PAGE + pos % PAGE) * KVG; }
    return p.ws + W_KV + ((long)MP + bs * DSEQ + (pos - PAST)) * NKVC;
}
NV_DEV void ph_comp1(const Params& p, long gtid, long gsz) {
    float* hid = p.ws + W_HID;
    for (long it = gtid; it < (long)NSEQN * NKV * 2 * DPHI; it += gsz) {
        const int pp = (int)(it % DPHI); const int c = (int)((it / DPHI) % 2); const int g = (int)((it / (2 * DPHI)) % NKV); const int sn = (int)(it / (2L * DPHI * NKV));
        float acc = 0.f;
        for (int l = 0; l < CMPB; ++l) { int ok; const float* src = cmp_src_row(p, sn, l, ok) + g * 2 * HD + c * HD;
            const float* pe = p.in[I_PE] + ((long)l * 2 + c) * HD; const float* w = p.in[I_WPHI1] + (((long)c * CMPB + l) * HD) * DPHI + pp;
            for (int d = 0; d < HD; ++d) acc += (src[d] + pe[d]) * w[(long)d * DPHI]; }
        hid[it] = silu_f(acc + p.in[I_BPHI1][c * DPHI + pp]);
    }
}
NV_DEV void ph_comp2(const Params& p, long gtid, long gsz) {
    const float* hid = p.ws + W_HID; float* comp = p.ws + W_COMP;
    for (long it = gtid; it < (long)NSEQN * NKV * 2 * HD; it += gsz) {
        const int d = (int)(it % HD); const int c = (int)((it / HD) % 2); const long sgc = it / HD;
        const float* h = hid + sgc * DPHI; const float* w = p.in[I_WPHI2] + (long)c * DPHI * HD + d;
        float acc = 0.f;
        for (int q = 0; q < DPHI; ++q) acc += h[q] * w[(long)q * HD];
        comp[it] = acc + p.in[I_BPHI2][c * HD + d];
    }
}
NV_DEV void ph_cmp_attn(const Params& p, long gtid, long gsz) {
    const float* u = p.ws + W_U; const float* comp = p.ws + W_COMP; float* pc = p.ws + W_PC; float* ocmp = p.ws + W_OCMP;
    for (long it = gtid; it < (long)M * NH; it += gsz) {
        const int row = (int)(it / NH), H = (int)(it % NH); const int g = H / HPG; const int t = pos_of(row);
        const int nc = row < MP ? NCP : NCS; const long sn0 = row < MP ? (long)(row / SEQ) * NCP : (long)BATCH * NCP + (long)((row - MP) / DSEQ) * NCS;
        const float sl = slope_of(H);
        float q[HD];
        for (int d = 0; d < HD; ++d) q[d] = u[(long)row * NU + H * HD + d] * 0.125f;
        float* pr = pc + ((long)row * NH + H) * NSBMAX;
        float m = -3.0e38f; int nvalid = 0;
        for (int n = 0; n < nc; ++n) { const int ce = n * CMPB + CMPB - 1;
            if (ce <= t) { const float* k = comp + ((sn0 + n) * NKV + g) * 2 * HD; float s = 0.f;
                for (int d = 0; d < HD; ++d) s += q[d] * k[d];
                s -= sl * (float)(t - ce); pr[n] = s; m = fmaxf(m, s); ++nvalid; } }
        float l = 0.f;
        for (int n = 0; n < nvalid; ++n) l += expf(pr[n] - m);
        float o[HD];
        for (int d = 0; d < HD; ++d) o[d] = 0.f;
        for (int n = 0; n < nvalid; ++n) { const float pn = expf(pr[n] - m) / l; pr[n] = pn;
            const float* v = comp + ((sn0 + n) * NKV + g) * 2 * HD + HD;
            for (int d = 0; d < HD; ++d) o[d] += pn * v[d]; }
        for (int n = nvalid; n < NSBMAX; ++n) pr[n] = 0.f;
        for (int d = 0; d < HD; ++d) ocmp[(long)row * D + H * HD + d] = o[d];
    }
}
NV_DEV void ph_topk(const Params& p, long gtid, long gsz) {
    float* pc = p.ws + W_PC; int* idx = (int*)(p.ws + W_IDX);
    for (long it = gtid; it < (long)M * NKV; it += gsz) {
        const int row = (int)(it / NKV), g = (int)(it % NKV); const int t = pos_of(row); const int cb = t / CMPB;
        const int nsb = row < MP ? NCP : NSBS; const int kk = nsb < NSEL ? nsb : NSEL;
        float* p0 = pc + ((long)row * NH + g * HPG) * NSBMAX;
        for (int j = 0; j < nsb; ++j) { const float imp = ((p0[j] + p0[NSBMAX + j]) + p0[2 * NSBMAX + j]) + p0[3 * NSBMAX + j];
            const bool forced = (j == 0) || (j == cb) || (j == cb - 1);
            p0[j] = forced ? 1.0e6f : (j <= cb ? imp : -1.0f); }
        for (int k = 0; k < NSEL; ++k) {
            if (k >= kk) { idx[it * NSEL + k] = -1; continue; }
            float best = -4.0f; int bj = 0;
            for (int j = 0; j < nsb; ++j) if (p0[j] > best) { best = p0[j]; bj = j; }
            p0[bj] = -5.0f; idx[it * NSEL + k] = bj; }
    }
}
NV_DEV void ph_sel(const Params& p, long gtid, long gsz) {
    const float* u = p.ws + W_U; const float* kv = p.ws + W_KV; const int* idx = (const int*)(p.ws + W_IDX); float* osel = p.ws + W_OSEL;
    for (long it = gtid; it < (long)M * NH; it += gsz) {
        const int row = (int)(it / NH), H = (int)(it % NH); const int g = H / HPG; const int t = pos_of(row); const float sl = slope_of(H);
        float q[HD], o[HD];
        for (int d = 0; d < HD; ++d) { q[d] = u[(long)row * NU + H * HD + d] * 0.125f; o[d] = 0.f; }
        float m = -3.0e38f, l = 0.f;
        for (int k = 0; k < NSEL; ++k) { const int blk = idx[((long)row * NKV + g) * NSEL + k]; if (blk < 0) continue;
            for (int j = 0; j < CMPB; ++j) { const int pos = blk * CMPB + j; if (pos > t) continue;
                const float* kr;
                if (row < MP) kr = kv + ((long)(row / SEQ) * SEQ + pos) * NKVC + KVG + g * 2 * HD;
                else { const int bs = (row - MP) / DSEQ;
                    if (pos < PAST) { const int pg = ((const int*)p.in[I_PT])[bs * NPAGES + pos / PAGE]; kr = p.in[I_CSEL] + ((long)pg * PAGE + pos % PAGE) * KVG + g * 2 * HD; }
                    else { int r = pos - PAST; if (r > DSEQ - 1) r = DSEQ - 1; kr = kv + ((long)MP + bs * DSEQ + r) * NKVC + KVG + g * 2 * HD; } }
                float s = 0.f;
                for (int d = 0; d < HD; ++d) s += q[d] * kr[d];
                s -= sl * (float)(t - pos);
                const float mn = fmaxf(m, s); const float sc = expf(m - mn), pe = expf(s - mn);
                l = l * sc + pe;
                for (int d = 0; d < HD; ++d) o[d] = o[d] * sc + pe * kr[HD + d];
                m = mn; } }
        const float inv = 1.0f / l;
        for (int d = 0; d < HD; ++d) osel[(long)row * D + H * HD + d] = o[d] * inv;
    }
}
NV_DEV void ph_win(const Params& p, long gtid, long gsz) {
    const float* u = p.ws + W_U; const float* kv = p.ws + W_KV; float* owin = p.ws + W_OWIN;
    for (long it = gtid; it < (long)M * NH; it += gsz) {
        const int row = (int)(it / NH), H = (int)(it % NH); const int g = H / HPG; const int t = pos_of(row); const float sl = slope_of(H);
        float q[HD], o[HD];
        for (int d = 0; d < HD; ++d) { q[d] = u[(long)row * NU + H * HD + d] * 0.125f; o[d] = 0.f; }
        float m = -3.0e38f, l = 0.f;
        const int p0 = t - WIN > 0 ? t - WIN : 0;
        for (int pos = p0; pos <= t; ++pos) {
            const float* kr;
            if (row < MP) kr = kv + ((long)(row / SEQ) * SEQ + pos) * NKVC + 2 * KVG + g * 2 * HD;
            else { const int bs = (row - MP) / DSEQ; const int j = pos - (PAST - WIN);
                if (j < WIN) kr = p.in[I_SWIN] + ((long)bs * WIN + j) * KVG + g * 2 * HD;
                else kr = kv + ((long)MP + bs * DSEQ + (j - WIN)) * NKVC + 2 * KVG + g * 2 * HD; }
            float s = 0.f;
            for (int d = 0; d < HD; ++d) s += q[d] * kr[d];
            s -= sl * (float)(t - pos);
            const float mn = fmaxf(m, s); const float sc = expf(m - mn), pe = expf(s - mn);
            l = l * sc + pe;
            for (int d = 0; d < HD; ++d) o[d] = o[d] * sc + pe * kr[HD + d];
            m = mn; }
        const float inv = 1.0f / l;
        for (int d = 0; d < HD; ++d) owin[(long)row * D + H * HD + d] = o[d] * inv;
    }
}
NV_DEV void ph_combine(const Params& p, long gtid, long gsz) {
    const float* u = p.ws + W_U; float* obuf = p.ws + W_OBUF;
    for (long it = gtid; it < (long)M * D; it += gsz) { const long row = it / D; const int c = (int)(it % D); const int H = c / HD;
        const float* gl = u + row * NU + 2 * D + H * 3; const float* bg = p.in[I_BGATE] + H * 3;
        const float g0 = sigm_f(gl[0] + bg[0]), g1 = sigm_f(gl[1] + bg[1]), g2 = sigm_f(gl[2] + bg[2]);
        const float o = g0 * (p.ws + W_OCMP)[it] + g1 * (p.ws + W_OSEL)[it] + g2 * (p.ws + W_OWIN)[it];
        const float v = o * silu_f(u[row * NU + D + c]); obuf[it] = v; ((unsigned short*)(p.ws + W_BFA))[it] = f2bf_rne(v); }
}

constexpr int N_PH = 21;
template <int PH> NV_DEV void run_phase(const Params& p, long gtid, long gsz) {
    if constexpr (PH == 0) ph_ada(p, gtid, gsz);
    else if constexpr (PH == 1) ph_mod(p, 0, gtid, gsz);
    else if constexpr (PH == 2) gemm_naive(p.ws + W_MA, D, p.in[I_WINA], 2 * D, p.ws + W_U0, 2 * D, M, 2 * D, D, gtid, gsz);
    else if constexpr (PH == 3) ph_conv(p, gtid, gsz);
    else if constexpr (PH == 4) ph_gates(p, gtid, gsz);
    else if constexpr (PH == 5) ph_scan(p, gtid, gsz);
    else if constexpr (PH == 6) ph_gated(p, gtid, gsz);
    else if constexpr (PH == 7) gemm_naive(p.ws + W_MA, D, p.in[I_WOUTA], D, p.ws + W_F, D, M, D, D, gtid, gsz);
    else if constexpr (PH == 8) ph_ln(p, 0, gtid, gsz);
    else if constexpr (PH == 9) gemm_naive(p.ws + W_X1, D, p.in[I_WKV], NKVC, p.ws + W_KV, NKVC, M, NKVC, D, gtid, gsz);
    else if constexpr (PH == 10) ph_mod(p, 1, gtid, gsz);
    else if constexpr (PH == 11) gemm_naive(p.ws + W_MA, D, p.in[I_WINB], NU, p.ws + W_U, NU, M, NU, D, gtid, gsz);
    else if constexpr (PH == 12) { ph_outputs(p, gtid, gsz); ph_comp1(p, gtid, gsz); }
    else if constexpr (PH == 13) ph_comp2(p, gtid, gsz);
    else if constexpr (PH == 14) ph_cmp_attn(p, gtid, gsz);
    else if constexpr (PH == 15) ph_topk(p, gtid, gsz);
    else if constexpr (PH == 16) ph_sel(p, gtid, gsz);
    else if constexpr (PH == 17) ph_win(p, gtid, gsz);
    else if constexpr (PH == 18) ph_combine(p, gtid, gsz);
    else if constexpr (PH == 19) gemm_naive(p.ws + W_OBUF, D, p.in[I_WOUTB], D, p.ws + W_F, D, M, D, D, gtid, gsz);
    else if constexpr (PH == 20) ph_ln(p, 1, gtid, gsz);
}
}

#define XB_TMO      128
#define XB_XCNT(j)  (256  + 64 * (j))
#define XB_XSUB(j)  (1280 + 64 * (j))
#define XB_XGEN(j)  (2304 + 64 * (j))
#define XB_TOP      3328
#define XB_TOPGEN   3392
#define XCD_BAR_WORDS 3456
#define XB_SPIN_CAP (1u << 18)
#define LAS __attribute__((address_space(3)))

__device__ __forceinline__ unsigned xb_ld(unsigned* p)              { return __hip_atomic_load(p, __ATOMIC_RELAXED, __HIP_MEMORY_SCOPE_AGENT); }
__device__ __forceinline__ unsigned xb_add(unsigned* p, unsigned v) { return __hip_atomic_fetch_add(p, v, __ATOMIC_RELAXED, __HIP_MEMORY_SCOPE_AGENT); }
__device__ __forceinline__ unsigned xb_xcc_id() { return (unsigned)__builtin_amdgcn_s_getreg((3 << 11) | 20) & 0xFu; }
#define XB_SPIN(cond, bar) do { unsigned _sp = 0; while (cond) { __builtin_amdgcn_s_sleep(1); \
    if ((++_sp & 255u) == 0u) { if (xb_ld(&(bar)[XB_TMO])) break; if (_sp > XB_SPIN_CAP) { atomicAdd(&(bar)[XB_TMO], 1u); break; } } } } while (0)

struct XcdBarrier {
    unsigned* bar; unsigned x;
    volatile LAS unsigned* st;
};

__device__ __forceinline__ XcdBarrier xcd_barrier_post(unsigned* bar, volatile LAS unsigned* st) {
    XcdBarrier b; b.bar = bar; b.x = xb_xcc_id(); b.st = st;
    if (threadIdx.x == 0) (void)xb_add(&bar[XB_XCNT(b.x)], 1u);
    return b;
}
__device__ __forceinline__ void xcd_barrier_complete(unsigned* bar, unsigned x, unsigned& nloc, unsigned& nx) {
    const unsigned G = gridDim.x * gridDim.y * gridDim.z;
    unsigned sum, cnt, mine, sp = 0u;
    for (;;) {
        sum = 0u; cnt = 0u; mine = 0u;
#pragma unroll
        for (unsigned j = 0; j < 16; ++j) { const unsigned c = xb_ld(&bar[XB_XCNT(j)]); sum += c; cnt += (c > 0u) ? 1u : 0u; mine = (j == x) ? c : mine; }
        if (sum == G) break;
        __builtin_amdgcn_s_sleep(1);
        if ((++sp & 255u) == 0u) { if (xb_ld(&bar[XB_TMO])) break; if (sp > XB_SPIN_CAP) { atomicAdd(&bar[XB_TMO], 1u); break; } }
    }
    nloc = mine > 0u ? mine : 1u; nx = cnt > 0u ? cnt : 1u;
}

__device__ __forceinline__ void xcd_barrier(const XcdBarrier& b) {
    asm volatile("s_waitcnt vmcnt(0)" ::: "memory");
    __syncthreads();
    if (threadIdx.x == 0) {
        unsigned* bar = b.bar;
        __builtin_amdgcn_s_waitcnt(0);
        unsigned nloc = b.st[0], nx = b.st[1];
        if (nloc == 0u) { xcd_barrier_complete(bar, b.x, nloc, nx); b.st[0] = nloc; b.st[1] = nx; }
        const unsigned old = xb_add(&bar[XB_XSUB(b.x)], 1u);
        const unsigned gen = old / nloc;
        if (old + 1u == (gen + 1u) * nloc) {
            __builtin_amdgcn_fence(__ATOMIC_RELEASE, "agent");
            asm volatile("s_waitcnt vmcnt(0)" ::: "memory");
            const unsigned og = xb_add(&bar[XB_TOP], 1u);
            const unsigned tg = og / nx;
            if (og + 1u == (tg + 1u) * nx) xb_add(&bar[XB_TOPGEN], 1u);
            else XB_SPIN(xb_ld(&bar[XB_TOPGEN]) == tg, bar);
            __builtin_amdgcn_fence(__ATOMIC_ACQUIRE, "agent");
            xb_add(&bar[XB_XGEN(b.x)], 1u);
            asm volatile("s_waitcnt vmcnt(0)" ::: "memory");
        } else {
            XB_SPIN(xb_ld(&bar[XB_XGEN(b.x)]) == gen, bar);
            __builtin_amdgcn_fence(__ATOMIC_ACQUIRE, "agent");
            asm volatile("s_waitcnt vmcnt(0)" ::: "memory");
        }
    }
    __syncthreads();
}

__device__ __forceinline__ int opaque_tid() { int t = threadIdx.x; asm volatile("" : "+v"(t)); return t; }

namespace pg8 {
#define PG8_LAS __attribute__((address_space(3)))
typedef unsigned short bf16_t;
typedef short bf16x8 __attribute__((ext_vector_type(8)));
typedef float f32x4 __attribute__((ext_vector_type(4)));
typedef unsigned u32x4 __attribute__((ext_vector_type(4)));
constexpr int BM = 256, BK = 64, HALF = 128, HTB = HALF * BK * 2  , STAGE_BYTES = 8 * HTB, NXCD = 8, WGM = 8;

__host__ __device__ __forceinline__ int lds_byte(int r, int c) { const int st = (r >> 4) * 2 + (c >> 5), rr = r & 15, cc = c & 31, ob = rr * 64 + cc * 2; return st * 1024 + (ob ^ (((ob >> 9) & 1) << 5)); }
__host__ __device__ __forceinline__ void stage_rc(int b, int& R, int& C) { const int st = b / 1024, sb = b % 1024, swz = sb ^ (((sb >> 9) & 1) << 5); R = (st >> 1) * 16 + swz / 64; C = (st & 1) * 32 + (swz % 64) / 2; }
__host__ __device__ __forceinline__ int perm32(int rho) { const int n = rho >> 4, i = rho & 15; return 8 * (i >> 2) + 4 * n + (i & 3); }

struct Unit { int pm, pn; };
struct Gemm { const bf16_t* A; const bf16_t* Bt; int M, N, K; const bf16_t* A2; int nsplit; };

struct StaticOrder {
    int nM, nN, nwg, G, c;
    __host__ __device__ void init(int M, int N, int G_, int c_) { nM = M / BM; nN = N / BM; nwg = nM * nN; G = G_; c = c_; }
    __host__ __device__ bool next(int i, Unit& u) const {
        const long L = (long)i * G + c; if (L >= nwg) return false;
        int wgid = (int)L; { const int q = nwg / NXCD, r = nwg % NXCD, xcd = wgid % NXCD, off = wgid / NXCD; wgid = (xcd < r ? xcd * (q + 1) : r * (q + 1) + (xcd - r) * q) + off; }
        const int nig = WGM * nN, gid = wgid / nig, fm = gid * WGM, gsz = (nM - fm) < WGM ? (nM - fm) : WGM;
        u.pm = fm + ((wgid % nig) % gsz); u.pn = (wgid % nig) / gsz; return true;
    }
    __device__ __forceinline__ void a_ready(const Unit&) const {}
    __device__ __forceinline__ void done(const Unit&) const {}
};

__device__ __forceinline__ unsigned cvt_pk_bf16(float lo, float hi) { unsigned r; asm volatile("v_cvt_pk_bf16_f32 %0, %1, %2" : "=v"(r) : "v"(lo), "v"(hi)); return r; }
typedef float f32x2 __attribute__((ext_vector_type(2)));
template <class Epi, class Sched, bool ALIGN_EPI = false, bool SP2 = false>
__device__ __forceinline__ void gemm_phase(PG8_LAS unsigned char* lds, const Gemm g, const Sched& S, const Epi& E) {
    const int tid = opaque_tid(), wid = __builtin_amdgcn_readfirstlane(tid >> 6), lane = tid & 63, wr = wid >> 2, wc = wid & 3, fr = lane & 15, fq = lane >> 4;
    const int K = g.K, nt = K / BK;
    unsigned voffA[2], voffB[2];
#pragma unroll
    for (int i = 0; i < 2; ++i) { int R, C; stage_rc(tid * 16 + i * 8192, R, C); const int Rb = Epi::PERM ? ((R & ~31) + perm32(R & 31)) : R;
        voffA[i] = (unsigned)(R * K + C) * 2u; voffB[i] = (unsigned)(Rb * K + C) * 2u; }
    const size_t kstep = (size_t)(BK * 2);
    const size_t hstep = (size_t)HALF * K * 2;
    const size_t tstep = 2 * hstep;
    const unsigned ldsw = (unsigned)wid * 1024u;
    const int aoff = lds_byte(wr * 64 + fr, fq * 8), boff = lds_byte(wc * 32 + fr, fq * 8);
#define PG8_SA(b, h) (((b) * 2 + (h)) * HTB)
#define PG8_SB(b, h) ((4 + (b) * 2 + (h)) * HTB)
#define PG8_STAGE(bufoff, gbase, voff) do { _Pragma("unroll") for (int _i = 0; _i < 2; ++_i) \
        __builtin_amdgcn_global_load_lds((const unsigned*)((const char*)(gbase) + (voff)[_i]), (PG8_LAS unsigned*)(lds + (bufoff) + ldsw + _i * 8192), 16, 0, 0); } while (0)
#define PG8_LDA(dst, b, h) do { _Pragma("unroll") for (int m = 0; m < 4; ++m) _Pragma("unroll") for (int k = 0; k < 2; ++k) dst[m][k] = *(const PG8_LAS bf16x8*)(lds + PG8_SA(b, h) + aoff + m * 2048 + k * 1024); } while (0)
#define PG8_LDB(dst, b, h) do { _Pragma("unroll") for (int n = 0; n < 2; ++n) _Pragma("unroll") for (int k = 0; k < 2; ++k) dst[n][k] = *(const PG8_LAS bf16x8*)(lds + PG8_SB(b, h) + boff + n * 2048 + k * 1024); } while (0)
#define PG8_MMA(ai, bj, At, Bt) do { __builtin_amdgcn_s_setprio(1); _Pragma("unroll") for (int m = 0; m < 4; ++m) _Pragma("unroll") for (int n = 0; n < 2; ++n) _Pragma("unroll") for (int k = 0; k < 2; ++k) \
        acc[ai][bj][m][n] = __builtin_amdgcn_mfma_f32_16x16x32_bf16(Bt[n][k], At[m][k], acc[ai][bj][m][n], 0, 0, 0); __builtin_amdgcn_s_setprio(0); } while (0)
#define PG8_WAIT_V(n) asm volatile("s_waitcnt vmcnt(" #n ")" ::: "memory")
#define PG8_WAIT_L(n) asm volatile("s_waitcnt lgkmcnt(" #n ")" ::: "memory")
#define PG8_BAR __builtin_amdgcn_s_barrier()
#define PG8_SCHED __builtin_amdgcn_sched_barrier(0)
    Unit cur, nxt; int ui = 0;
    if (!S.next(0, cur)) return;
    f32x4 acc[2][2][4][2];
#pragma unroll
    for (int a = 0; a < 2; ++a)
#pragma unroll
        for (int b = 0; b < 2; ++b)
#pragma unroll
            for (int m = 0; m < 4; ++m)
#pragma unroll
                for (int n = 0; n < 2; ++n) acc[a][b][m][n] = (f32x4){0.f, 0.f, 0.f, 0.f};
    bf16x8 At[4][2], B0[2][2], B1[2][2];
    const char* cA = (const char*)(cur.pn < g.nsplit ? g.A : g.A2) + (size_t)cur.pm * tstep; const char* cB = (const char*)g.Bt + (size_t)cur.pn * tstep;
    S.a_ready(cur);
    if constexpr (SP2) {
        PG8_STAGE(PG8_SB(0, 0), cB, voffB); PG8_STAGE(PG8_SB(0, 1), cB + hstep, voffB); PG8_STAGE(PG8_SA(0, 0), cA, voffA); PG8_STAGE(PG8_SA(0, 1), cA + hstep, voffA);
        if (wr == 1) PG8_BAR;
        PG8_WAIT_V(2); PG8_BAR;
        PG8_STAGE(PG8_SB(1, 0), cB + kstep, voffB); PG8_STAGE(PG8_SA(1, 0), cA + kstep, voffA); PG8_STAGE(PG8_SB(1, 1), cB + hstep + kstep, voffB);
        PG8_WAIT_V(6); PG8_BAR;
    } else {
        PG8_STAGE(PG8_SB(0, 0), cB, voffB); PG8_STAGE(PG8_SA(0, 0), cA, voffA); PG8_STAGE(PG8_SB(0, 1), cB + hstep, voffB); PG8_STAGE(PG8_SA(0, 1), cA + hstep, voffA);
        if (wr == 1) PG8_BAR;
        PG8_WAIT_V(4); PG8_BAR;
        PG8_STAGE(PG8_SB(1, 0), cB + kstep, voffB); PG8_STAGE(PG8_SA(1, 0), cA + kstep, voffA); PG8_STAGE(PG8_SB(1, 1), cB + hstep + kstep, voffB);
        PG8_WAIT_V(6); PG8_BAR;
    }
    for (;;) {
        const bool has_next = S.next(ui + 1, nxt);
        const char* nA = has_next ? (const char*)(nxt.pn < g.nsplit ? g.A : g.A2) + (size_t)nxt.pm * tstep : cA; const char* nB = has_next ? (const char*)g.Bt + (size_t)nxt.pn * tstep : cB;
        for (int t = 0; t < nt; t += 2) {
            const bool last = (t == nt - 2);
            const char* a1 = cA + (size_t)(t + 1) * kstep;
            const char* a2 = last ? nA : cA + (size_t)(t + 2) * kstep; const char* b2 = last ? nB : cB + (size_t)(t + 2) * kstep;
            const char* a3 = a2 + kstep; const char* b3 = b2 + kstep;
            if (last && has_next) S.a_ready(nxt);
            if constexpr (SP2) {
            PG8_LDB(B0, 0, 0); PG8_LDB(B1, 0, 1); PG8_SCHED; PG8_LDA(At, 0, 0); PG8_STAGE(PG8_SA(1, 1), a1 + hstep, voffA);
            PG8_WAIT_V(8); PG8_WAIT_L(0); PG8_BAR; PG8_MMA(0, 0, At, B0); PG8_MMA(0, 1, At, B1); PG8_BAR; PG8_SCHED;
            PG8_LDA(At, 0, 1); PG8_STAGE(PG8_SB(0, 0), b2, voffB); PG8_STAGE(PG8_SB(0, 1), b2 + hstep, voffB); PG8_STAGE(PG8_SA(0, 0), a2, voffA);
            PG8_WAIT_V(8); PG8_WAIT_L(0); PG8_BAR; PG8_MMA(1, 0, At, B0); PG8_MMA(1, 1, At, B1); PG8_BAR; PG8_SCHED;
            PG8_LDB(B0, 1, 0); PG8_LDB(B1, 1, 1); PG8_SCHED; PG8_LDA(At, 1, 0); PG8_STAGE(PG8_SA(0, 1), a2 + hstep, voffA);
            PG8_WAIT_V(8); PG8_WAIT_L(0); PG8_BAR; PG8_MMA(0, 0, At, B0); PG8_MMA(0, 1, At, B1); PG8_BAR; PG8_SCHED;
            PG8_LDA(At, 1, 1); PG8_STAGE(PG8_SB(1, 0), b3, voffB); PG8_STAGE(PG8_SB(1, 1), b3 + hstep, voffB); PG8_STAGE(PG8_SA(1, 0), a3, voffA);
            PG8_WAIT_V(8); PG8_WAIT_L(0); PG8_BAR; PG8_MMA(1, 0, At, B0); PG8_MMA(1, 1, At, B1); PG8_BAR; PG8_SCHED;
            } else {
            PG8_LDB(B0, 0, 0); PG8_SCHED; PG8_LDA(At, 0, 0); PG8_STAGE(PG8_SA(1, 1), a1 + hstep, voffA);
            PG8_WAIT_L(8); PG8_BAR; PG8_WAIT_L(0); PG8_MMA(0, 0, At, B0); PG8_BAR; PG8_SCHED;
            PG8_LDB(B1, 0, 1); PG8_STAGE(PG8_SB(0, 0), b2, voffB);
            PG8_BAR; PG8_WAIT_L(0); PG8_MMA(0, 1, At, B1); PG8_BAR;
            PG8_LDA(At, 0, 1); PG8_STAGE(PG8_SA(0, 0), a2, voffA);
            PG8_BAR; PG8_WAIT_L(0); PG8_MMA(1, 0, At, B0); PG8_BAR; PG8_SCHED;
            PG8_STAGE(PG8_SB(0, 1), b2 + hstep, voffB);
            PG8_WAIT_V(6); PG8_BAR; PG8_MMA(1, 1, At, B1); PG8_BAR;
            PG8_LDB(B0, 1, 0); PG8_SCHED; PG8_LDA(At, 1, 0); PG8_STAGE(PG8_SA(0, 1), a2 + hstep, voffA);
            PG8_WAIT_L(8); PG8_BAR; PG8_WAIT_L(0); PG8_MMA(0, 0, At, B0); PG8_BAR; PG8_SCHED;
            PG8_LDB(B1, 1, 1); PG8_STAGE(PG8_SB(1, 0), b3, voffB);
            PG8_BAR; PG8_WAIT_L(0); PG8_MMA(0, 1, At, B1); PG8_BAR;
            PG8_LDA(At, 1, 1); PG8_STAGE(PG8_SA(1, 0), a3, voffA);
            PG8_BAR; PG8_WAIT_L(0); PG8_MMA(1, 0, At, B0); PG8_BAR; PG8_SCHED;
            PG8_STAGE(PG8_SB(1, 1), b3 + hstep, voffB);
            PG8_WAIT_V(6); PG8_BAR; PG8_MMA(1, 1, At, B1); PG8_BAR;
            }
        }
        if constexpr (ALIGN_EPI) { if (wr == 0) PG8_BAR; }
        if constexpr (!Epi::AFTER_DRAIN) { E(acc, cur, wr, wc, fr, fq); S.done(cur); }
        if (!has_next) break;
#pragma unroll
        for (int a = 0; a < 2; ++a)
#pragma unroll
            for (int b = 0; b < 2; ++b)
#pragma unroll
                for (int m = 0; m < 4; ++m)
#pragma unroll
                    for (int n = 0; n < 2; ++n) acc[a][b][m][n] = (f32x4){0.f, 0.f, 0.f, 0.f};
        cur = nxt; cA = nA; cB = nB; ++ui;
        if constexpr (ALIGN_EPI) { if (wr == 1) PG8_BAR; }
    }
    PG8_WAIT_V(0);
    if constexpr (!ALIGN_EPI) { if (wr == 0) PG8_BAR; }
    PG8_BAR;
    if constexpr (Epi::AFTER_DRAIN) { E.fused(acc, cur, wr, wc, fr, fq, lds, wid, lane); S.done(cur); }
#undef PG8_SA
#undef PG8_SB
#undef PG8_STAGE
#undef PG8_LDA
#undef PG8_LDB
#undef PG8_MMA
#undef PG8_WAIT_V
#undef PG8_WAIT_L
#undef PG8_BAR
#undef PG8_SCHED
}
}

#define GAS __attribute__((address_space(1)))
typedef unsigned short bf16;
typedef unsigned v4u __attribute__((ext_vector_type(4)));
typedef float f32x4 __attribute__((ext_vector_type(4)));
#define LDS_WAIT() asm volatile("s_waitcnt lgkmcnt(0)" ::: "memory")
#define VM_WAIT() asm volatile("s_waitcnt vmcnt(0)" ::: "memory")
__device__ __forceinline__ unsigned f2bf(float f) { unsigned u = __builtin_bit_cast(unsigned, f); return (u + 0x7fffu + ((u >> 16) & 1u)) >> 16; }
typedef float f32x2_t __attribute__((ext_vector_type(2))); typedef __bf16 bf16x2_t __attribute__((ext_vector_type(2)));
__device__ __forceinline__ unsigned pk2(float lo, float hi) { const f32x2_t v = {lo, hi}; const bf16x2_t b = __builtin_convertvector(v, bf16x2_t); return __builtin_bit_cast(unsigned, b); }

namespace pg8 {
struct EpiF32Split {
    static constexpr bool PERM = false, AFTER_DRAIN = false;
    float* C0; int ldc0, n0; float* C1; int ldc1, n1;
    __device__ __forceinline__ void operator()(const f32x4 (&acc)[2][2][4][2], const Unit& u, int wr, int wc, int fr, int fq) const {
#pragma unroll
        for (int ai = 0; ai < 2; ++ai)
#pragma unroll
            for (int m = 0; m < 4; ++m) { const size_t row = (size_t)u.pm * BM + ai * HALF + wr * 64 + m * 16 + fr;
#pragma unroll
                for (int bj = 0; bj < 2; ++bj)
#pragma unroll
                    for (int n = 0; n < 2; ++n) { const int col = u.pn * BM + bj * HALF + wc * 32 + n * 16 + 4 * fq;
                        if (col < n0) *(f32x4*)(C0 + row * ldc0 + col) = acc[ai][bj][m][n];
                        else if (col - n0 < n1) *(f32x4*)(C1 + row * ldc1 + (col - n0)) = acc[ai][bj][m][n]; } }
    }
};
struct EpiKvU {
    static constexpr bool PERM = true, AFTER_DRAIN = false;
    float* out; bf16_t* kvb; bf16_t* qb; bf16_t* zb; float* gl;
    __device__ __forceinline__ void operator()(const f32x4 (&acc)[2][2][4][2], const Unit& u, int wr, int wc, int fr, int fq) const {
        using namespace nv;
        const bool samp = u.pm == MP / BM; const int pn = u.pn;
#pragma unroll
        for (int ai = 0; ai < 2; ++ai)
#pragma unroll
            for (int m = 0; m < 4; ++m) { const size_t row = (size_t)u.pm * BM + ai * HALF + wr * 64 + m * 16 + fr;
#pragma unroll
                for (int bj = 0; bj < 2; ++bj) { const int col = pn * BM + bj * HALF + wc * 32 + 8 * fq; const f32x4 v0 = acc[ai][bj][m][0], v1 = acc[ai][bj][m][1];
                    if (pn < 6) { const int br = pn >> 1, cc = col & 511; float* dst = nullptr;
                        if (br < 2) dst = samp ? out + (br == 0 ? O_CMPS : O_SELS) + (row - MP) * KVG + cc : out + (br == 0 ? O_CMPP : O_SELP) + row * KVG + cc;
                        else if (samp) dst = out + O_WINS + (((row - MP) >> 3) * WIN + (WIN - DSEQ) + ((row - MP) & 7)) * KVG + cc;
                        else { const int t = (int)(row % SEQ); if (t >= SEQ - WIN) dst = out + O_WINP + ((row / SEQ) * WIN + (t - (SEQ - WIN))) * KVG + cc; }
                        if (dst) { *(f32x4*)dst = v0; *(f32x4*)(dst + 4) = v1; }
                        if (br >= 1 && !samp) { u32x4 w; w.x = cvt_pk_bf16(v0[0], v0[1]); w.y = cvt_pk_bf16(v0[2], v0[3]); w.z = cvt_pk_bf16(v1[0], v1[1]); w.w = cvt_pk_bf16(v1[2], v1[3]); *(u32x4*)(kvb + row * NKVC + col) = w; }
                    } else if (pn < 14) { const float sc = pn < 10 ? 0.125f * 1.4426950408889634f : 1.0f; bf16_t* d = pn < 10 ? qb + row * D + (col - NKVC) : zb + row * D + (col - NKVC - D);
                        const f32x4 a = v0 * sc, b = v1 * sc; u32x4 w; w.x = cvt_pk_bf16(a[0], a[1]); w.y = cvt_pk_bf16(a[2], a[3]); w.z = cvt_pk_bf16(b[0], b[1]); w.w = cvt_pk_bf16(b[2], b[3]); *(u32x4*)d = w;
                    } else { const int cc = col - NKVC - 2 * D; if (cc < 3 * NH) { float* d = gl + row * (3 * NH) + cc; *(f32x4*)d = v0; *(f32x4*)(d + 4) = v1; } }
                } }
    }
};
}

__device__ __forceinline__ void wt_transpose_item(const float* W, int K, int N, bf16* WT, int row_off, LAS float* scr, int item, int lane) {
    const int nblk = (N + 31) / 32, kb = item / nblk, nb = item % nblk, k0 = 64 * kb, n0 = 32 * nb;
    const bool okn = n0 + (lane & 31) < N;
#pragma unroll 8
    for (int i = 0; i < 32; ++i) { const int kk = 2 * i + (lane >> 5); scr[kk * 33 + (lane & 31)] = okn ? W[(size_t)(k0 + kk) * N + n0 + (lane & 31)] : 0.f; }
    LDS_WAIT(); asm volatile("" ::: "memory");
    const int c = lane & 7;
#pragma unroll
    for (int j = 0; j < 4; ++j) { const int n = (lane >> 3) + 8 * j; const LAS float* s = scr + (8 * c) * 33 + n;
        v4u o; o.x = pk2(s[0 * 33], s[1 * 33]); o.y = pk2(s[2 * 33], s[3 * 33]); o.z = pk2(s[4 * 33], s[5 * 33]); o.w = pk2(s[6 * 33], s[7 * 33]);
        *(GAS v4u*)(WT + (size_t)(row_off + n0 + n) * K + k0 + 8 * c) = o; }
    LDS_WAIT(); asm volatile("" ::: "memory");
}

namespace rg {
typedef short bf16x8 __attribute__((ext_vector_type(8)));
constexpr int TC = 128, NCHUNK = nv::SEQ / TC;
constexpr int A_STRIDE = 272;
constexpr int X_STRIDE = 132;
constexpr int LDS_A = 0, LDS_X = 128 * A_STRIDE;
constexpr int NUNIT_P = nv::BATCH * NCHUNK * 8, NUNIT_S = (nv::MS / 128) * 8;
static_assert(nv::RGB == 128 && nv::NRG == 8 && nv::MS % 128 == 0 && nv::SEQ % TC == 0, "rg geometry");

__device__ __forceinline__ float sigm(float x) { return __builtin_amdgcn_rcpf(1.0f + __expf(-x)); }

template <int PASS>
__device__ __forceinline__ void rg_pass(const nv::Params& p, LAS unsigned char* L, float* agg) {
    using namespace nv;
    const int tid = opaque_tid(), wave = __builtin_amdgcn_readfirstlane(tid >> 6), lane = tid & 63;
    const int n = blockIdx.x & 7;
    const int l15 = lane & 15, q = lane >> 4;
    const int cl = 16 * wave + l15, ch = n * 128 + cl;
    const float* u0 = p.ws + W_U0;
    LAS float* X = (LAS float*)(L + LDS_X);
    bf16x8 Br[4], Bi[4];
#pragma unroll
    for (int ks = 0; ks < 4; ++ks)
#pragma unroll
        for (int j = 0; j < 8; ++j) { const int k = 32 * ks + 8 * q + j;
            Br[ks][j] = (short)f2bf(p.in[I_WR][((size_t)n * 128 + k) * 128 + cl]); Bi[ks][j] = (short)f2bf(p.in[I_WI][((size_t)n * 128 + k) * 128 + cl]); }
    const float br = p.in[I_BR][ch], bi = p.in[I_BI][ch];
    const float lam = p.in[I_LAM][ch];
    const float sp8 = 8.0f * ((-lam > 20.f) ? -lam : log1pf(expf(-lam)));
    const int nunits = PASS == 1 ? NUNIT_P : NUNIT_P + NUNIT_S;
    for (int u = blockIdx.x; u < nunits; u += gridDim.x) {
        const bool samp = u >= NUNIT_P;
        int row0, b = 0, chunk = 0;
        if (!samp) { const int cidx = u >> 3; b = cidx / NCHUNK; chunk = cidx % NCHUNK; row0 = b * SEQ + chunk * TC; }
        else row0 = MP + ((u - NUNIT_P) >> 3) * 128;
        {
            const int c = tid & 127, rq = tid >> 7; const int chn = n * 128 + c;
            const float w0 = p.in[I_CONVW][chn], w1 = p.in[I_CONVW][D + chn], w2 = p.in[I_CONVW][2 * D + chn], w3 = p.in[I_CONVW][3 * D + chn], cb = p.in[I_CONVB][chn];
            LAS unsigned short* Abf = (LAS unsigned short*)(L + LDS_A);
            if (!samp) {
                float v[35];
                const int tq0 = chunk * TC + rq * 32 - 3; const float* xr = u0 + ((size_t)b * SEQ) * 2048 + chn;
#pragma unroll
                for (int j = 0; j < 35; ++j) { const int tt = tq0 + j; const float x = xr[(size_t)(tt < 0 ? 0 : tt) * 2048]; v[j] = tt < 0 ? 0.f : x; }
#pragma unroll
                for (int i = 0; i < 32; ++i) { const int rl = rq * 32 + i; const float acc = cb + v[i] * w0 + v[i + 1] * w1 + v[i + 2] * w2 + v[i + 3] * w3;
                    X[rl * X_STRIDE + c] = acc; Abf[rl * (A_STRIDE / 2) + c] = (unsigned short)f2bf(acc); }
            } else {
                float v[4][11];
#pragma unroll
                for (int s4 = 0; s4 < 4; ++s4) { const int rl0 = rq * 32 + 8 * s4; const size_t bs = (size_t)((row0 - MP + rl0) >> 3);
#pragma unroll
                    for (int j = 0; j < 3; ++j) v[s4][j] = p.in[I_STC][(bs * 3 + j) * D + chn];
#pragma unroll
                    for (int j = 0; j < 8; ++j) v[s4][3 + j] = u0[(size_t)(row0 + rl0 + j) * 2048 + chn]; }
#pragma unroll
                for (int s4 = 0; s4 < 4; ++s4)
#pragma unroll
                    for (int j = 0; j < 8; ++j) { const int rl = rq * 32 + 8 * s4 + j; const float acc = cb + v[s4][j] * w0 + v[s4][j + 1] * w1 + v[s4][j + 2] * w2 + v[s4][j + 3] * w3;
                        X[rl * X_STRIDE + c] = acc; Abf[rl * (A_STRIDE / 2) + c] = (unsigned short)f2bf(acc); }
            }
        }
        __syncthreads();
        float hin = 0.f;
        if (PASS == 2 && !samp) {
            float Ap = 1.f, Bp = 0.f;
            const float2* ag = (const float2*)agg + ((size_t)b * NCHUNK) * 1024 + ch;
#pragma unroll
            for (int i = 0; i < 16; ++i) { const int cc = 16 * q + i; const int cs = cc < chunk ? cc : 0; const float2 ab = ag[(size_t)cs * 1024];
                const float a_ = cc < chunk ? ab.x : 1.f, b_ = cc < chunk ? ab.y : 0.f; Bp = a_ * Bp + b_; Ap = a_ * Ap; }
#pragma unroll
            for (int qq = 0; qq < 4; ++qq) { const float a_ = __shfl(Ap, 16 * qq + l15), b_ = __shfl(Bp, 16 * qq + l15); hin = a_ * hin + b_; }
        }
        f32x4 accr[8], acci[8];
#pragma unroll
        for (int rt = 0; rt < 8; ++rt) { accr[rt] = (f32x4){0.f, 0.f, 0.f, 0.f}; acci[rt] = (f32x4){0.f, 0.f, 0.f, 0.f}; }
#pragma unroll
        for (int ks = 0; ks < 4; ++ks)
#pragma unroll
            for (int rt = 0; rt < 8; ++rt) { const bf16x8 a = *(const LAS bf16x8*)(L + LDS_A + (16 * rt + l15) * A_STRIDE + (32 * ks + 8 * q) * 2);
                accr[rt] = __builtin_amdgcn_mfma_f32_16x16x32_bf16(a, Br[ks], accr[rt], 0, 0, 0);
                acci[rt] = __builtin_amdgcn_mfma_f32_16x16x32_bf16(a, Bi[ks], acci[rt], 0, 0, 0); }
        float carA = 1.f, carB = hin;
#pragma unroll
        for (int rt = 0; rt < 8; ++rt) {
            float a[4], bb[4];
#pragma unroll
            for (int j = 0; j < 4; ++j) { const int rl = 16 * rt + 4 * q + j; const float xc = X[rl * X_STRIDE + cl];
                const float r = sigm(accr[rt][j] + br), ii = sigm(acci[rt][j] + bi);
                const float la = -sp8 * r; a[j] = __expf(la); const float gain = __builtin_amdgcn_sqrtf(fmaxf(1.0f - a[j] * a[j], 0.f)); bb[j] = gain * ii * xc; }
            float As = a[0], Bs = bb[0];
#pragma unroll
            for (int j = 1; j < 4; ++j) { Bs = a[j] * Bs + bb[j]; As *= a[j]; }
            if (!samp) {
                float Ai = As, Bq = Bs;
                { const float pa = __shfl_up(Ai, 16), pb = __shfl_up(Bq, 16); if (q >= 1) { Bq = Ai * pb + Bq; Ai = pa * Ai; } }
                { const float pa = __shfl_up(Ai, 32), pb = __shfl_up(Bq, 32); if (q >= 2) { Bq = Ai * pb + Bq; Ai = pa * Ai; } }
                float Ae = __shfl_up(Ai, 16), Be = __shfl_up(Bq, 16); if (q == 0) { Ae = 1.f; Be = 0.f; }
                const float At = __shfl(Ai, 48 + l15), Bt = __shfl(Bq, 48 + l15);
                if (PASS == 2) {
                    float h = Ae * carB + Be;
#pragma unroll
                    for (int j = 0; j < 4; ++j) { h = a[j] * h + bb[j]; X[(16 * rt + 4 * q + j) * X_STRIDE + cl] = h; }
                    if (rt == 7 && q == 3 && chunk == NCHUNK - 1) p.out[O_HP + (size_t)b * D + ch] = h;
                    carB = At * carB + Bt;
                } else { carB = At * carB + Bt; carA = At * carA; }
            } else if (PASS == 2) {
                const int bs = ((row0 - MP) >> 3) + 2 * rt + (q >> 1);
                const float h0 = p.in[I_STH][(size_t)bs * D + ch];
                const float pa = __shfl_up(As, 16), pb = __shfl_up(Bs, 16);
                float h = (q & 1) ? pa * h0 + pb : h0;
#pragma unroll
                for (int j = 0; j < 4; ++j) { h = a[j] * h + bb[j]; X[(16 * rt + 4 * q + j) * X_STRIDE + cl] = h; }
                if (q & 1) p.out[O_HS + (size_t)bs * D + ch] = h;
            }
        }
        if (PASS == 1) { if (q == 3) ((float2*)agg)[((size_t)b * NCHUNK + chunk) * 1024 + ch] = make_float2(carA, carB); }
        if (PASS == 2) {
            __syncthreads();
            bf16* gA = (bf16*)(p.ws + W_BFA);
            for (int it = tid; it < 2048; it += 512) { const int rl = it >> 4, g8 = it & 15;
                const f32x4 h0 = *(const LAS f32x4*)(X + rl * X_STRIDE + 8 * g8), h1 = *(const LAS f32x4*)(X + rl * X_STRIDE + 8 * g8 + 4);
                const float* zp = u0 + (size_t)(row0 + rl) * 2048 + 1024 + n * 128 + 8 * g8;
                const f32x4 z0 = *(const f32x4*)zp, z1 = *(const f32x4*)(zp + 4);
                v4u o; o.x = pk2(h0[0] * z0[0] * sigm(z0[0]), h0[1] * z0[1] * sigm(z0[1])); o.y = pk2(h0[2] * z0[2] * sigm(z0[2]), h0[3] * z0[3] * sigm(z0[3]));
                o.z = pk2(h1[0] * z1[0] * sigm(z1[0]), h1[1] * z1[1] * sigm(z1[1])); o.w = pk2(h1[2] * z1[2] * sigm(z1[2]), h1[3] * z1[3] * sigm(z1[3]));
                *(GAS v4u*)(gA + (size_t)(row0 + rl) * 1024 + n * 128 + 8 * g8) = o; }
        }
        __syncthreads();
    }
}
}

namespace at {
using namespace nv;
typedef short bf16x8 __attribute__((ext_vector_type(8)));
typedef short s16x4 __attribute__((ext_vector_type(4)));
typedef short v4i16_t __attribute__((ext_vector_type(4)));
typedef unsigned v2u __attribute__((ext_vector_type(2)));
constexpr float LOG2E = 1.4426950408889634f, C2 = 0.125f * LOG2E;
constexpr int KS = 160, VS = 160, KVB = 64 * KS + 64 * VS;
constexpr int TQ = 64;
constexpr int L_KV = 0, L_OT = 2 * KVB, OT_RS = 528, OT_W = 8 * OT_RS, L_UNI = L_OT + 8 * OT_W;
static_assert(L_UNI + 64 <= 131072, "attention LDS map");
constexpr float NEGF = -1.0e30f;
constexpr long W_QB = W_U0, W_ZB = W_U0 + (long)M * D / 2, W_GL = W_U0 + (long)M * D;
constexpr int NT_P = BATCH * NKV * (SEQ / TQ), NT_S = DECB * NKV;

__device__ __forceinline__ float qmax(float v) {
    auto a = __builtin_amdgcn_permlane16_swap(__float_as_uint(v), __float_as_uint(v), false, false); v = fmaxf(__uint_as_float(a[0]), __uint_as_float(a[1]));
    auto b = __builtin_amdgcn_permlane32_swap(__float_as_uint(v), __float_as_uint(v), false, false); return fmaxf(__uint_as_float(b[0]), __uint_as_float(b[1])); }
__device__ __forceinline__ float qsum(float v) {
    auto a = __builtin_amdgcn_permlane16_swap(__float_as_uint(v), __float_as_uint(v), false, false); v = __uint_as_float(a[0]) + __uint_as_float(a[1]);
    auto b = __builtin_amdgcn_permlane32_swap(__float_as_uint(v), __float_as_uint(v), false, false); return __uint_as_float(b[0]) + __uint_as_float(b[1]); }
__device__ __forceinline__ float ror8(float v) { return __int_as_float(__builtin_amdgcn_update_dpp(0, __float_as_int(v), 0x128, 0xf, 0xf, false)); }
__device__ __forceinline__ int ror8i(int v) { return __builtin_amdgcn_update_dpp(0, v, 0x128, 0xf, 0xf, false); }
__device__ __forceinline__ s16x4 vtr(const LAS unsigned char* p) { return __builtin_bit_cast(s16x4, __builtin_amdgcn_ds_read_tr16_b64_v4i16((LAS v4i16_t*)p)); }
__device__ __forceinline__ bf16x8 cvt8(const f32x4 a, const f32x4 b) { v4u o; o.x = pk2(a[0], a[1]); o.y = pk2(a[2], a[3]); o.z = pk2(b[0], b[1]); o.w = pk2(b[2], b[3]); return __builtin_bit_cast(bf16x8, o); }

struct TileCtx {
    int b, g, t0;
    size_t rowbase;
    size_t sn0;
};

template <int KIND> __device__ __forceinline__ void stage_load(const Params& p, const TileCtx& c, const bf16* kvb, int kb, int boff, bf16x8& kr, bf16x8& vr, int tid) {
    const int key = tid >> 3, chn = tid & 7;
    if constexpr (KIND == 0) {
        const bf16* s = kvb + ((size_t)c.b * SEQ + kb * 64 + key) * NKVC + boff + c.g * 128 + 8 * chn;
        kr = *(const bf16x8*)s; vr = *(const bf16x8*)(s + 64);
    } else {
        const float* s;
        if constexpr (KIND == 1) s = p.ws + W_COMP + ((c.sn0 + kb * 64 + key) * NKV + c.g) * 128;
        else if constexpr (KIND == 2) { const int pos = kb * 64 + key;
            if (pos < PAST) { const int pg = ((const int*)p.in[I_PT])[c.b * NPAGES + (pos >> 7)]; s = p.in[I_CSEL] + ((size_t)pg * PAGE + (pos & 127)) * KVG + c.g * 128; }
            else { int r = pos - PAST; r = r > DSEQ - 1 ? DSEQ - 1 : r; s = p.out + O_SELS + ((size_t)c.b * DSEQ + r) * KVG + c.g * 128; } }
        else { int j = kb * 64 + key; j = j > WIN + DSEQ - 1 ? WIN + DSEQ - 1 : j;
            if (j < WIN) s = p.in[I_SWIN] + ((size_t)c.b * WIN + j) * KVG + c.g * 128;
            else s = p.out + O_WINS + ((size_t)c.b * WIN + (WIN - DSEQ) + (j - WIN)) * KVG + c.g * 128; }
        const f32x4 k0 = *(const f32x4*)(s + 8 * chn), k1 = *(const f32x4*)(s + 8 * chn + 4), v0 = *(const f32x4*)(s + 64 + 8 * chn), v1 = *(const f32x4*)(s + 64 + 8 * chn + 4);
        kr = cvt8(k0, k1); vr = cvt8(v0, v1);
    }
}
__device__ __forceinline__ void stage_write(LAS unsigned char* buf, const bf16x8 kr, const bf16x8 vr, int tid) {
    const int key = tid >> 3, chn = tid & 7;
    *(LAS bf16x8*)(buf + key * KS + chn * 16) = kr; *(LAS bf16x8*)(buf + 64 * KS + key * VS + chn * 16) = vr;
}

__device__ __forceinline__ void qk_block(const LAS unsigned char* buf, const bf16x8 (&qf)[2][2], f32x4 (&s)[4][2], int l15, int qd) {
#pragma unroll
    for (int kt = 0; kt < 4; ++kt)
#pragma unroll
        for (int ct = 0; ct < 2; ++ct) s[kt][ct] = (f32x4){0.f, 0.f, 0.f, 0.f};
#pragma unroll
    for (int ks = 0; ks < 2; ++ks) {
        bf16x8 kf[4];
#pragma unroll
        for (int kt = 0; kt < 4; ++kt) kf[kt] = *(const LAS bf16x8*)(buf + (16 * kt + l15) * KS + (32 * ks + 8 * qd) * 2);
#pragma unroll
        for (int kt = 0; kt < 4; ++kt)
#pragma unroll
            for (int ct = 0; ct < 2; ++ct) s[kt][ct] = __builtin_amdgcn_mfma_f32_16x16x32_bf16(kf[kt], qf[ct][ks], s[kt][ct], 0, 0, 0);
    }
}
__device__ __forceinline__ void pv_block(const LAS unsigned char* buf, const bf16x8 (&pf)[2][2], f32x4 (&O)[4][2], int l15, int qd) {
    const LAS unsigned char* vb = buf + 64 * KS + (4 * qd + (l15 >> 2)) * VS + (l15 & 3) * 8;
#pragma unroll
    for (int kk = 0; kk < 2; ++kk)
#pragma unroll
        for (int dt = 0; dt < 4; ++dt) {
            const s16x4 lo = vtr(vb + (32 * kk) * VS + dt * 32), hi = vtr(vb + (32 * kk + 16) * VS + dt * 32);
            const bf16x8 vf = (bf16x8){lo[0], lo[1], lo[2], lo[3], hi[0], hi[1], hi[2], hi[3]};
#pragma unroll
            for (int ct = 0; ct < 2; ++ct) O[dt][ct] = __builtin_amdgcn_mfma_f32_16x16x32_bf16(vf, pf[ct][kk], O[dt][ct], 0, 0, 0);
        }
}

template <int BR, bool FAST> __device__ __forceinline__ void online_step(const LAS unsigned char* buf, const bf16x8 (&qf)[2][2], f32x4 (&O)[4][2], float (&m)[2], float (&l)[2],
                                                                         const float (&sl2)[2], int t, int pos0, bool lane_on, int l15, int qd) {
    f32x4 s[4][2];
    qk_block(buf, qf, s, l15, qd);
    bf16x8 pf[2][2]; float alpha[2];
#pragma unroll
    for (int ct = 0; ct < 2; ++ct) {
        float mloc = NEGF;
        if (FAST) {
            const float base = lane_on ? sl2[ct] * (float)(pos0 + 4 * qd - t) : NEGF;
#pragma unroll
            for (int kt = 0; kt < 4; ++kt)
#pragma unroll
                for (int r = 0; r < 4; ++r) { const float v = s[kt][ct][r] + __builtin_fmaf(sl2[ct], (float)(16 * kt + r), base); s[kt][ct][r] = v; mloc = fmaxf(mloc, v); }
        } else {
#pragma unroll
            for (int kt = 0; kt < 4; ++kt)
#pragma unroll
                for (int r = 0; r < 4; ++r) { const int dist = t - (pos0 + 16 * kt + 4 * qd + r);
                    const bool ok = lane_on && dist >= 0 && (BR == 2 ? dist <= WIN : true);
                    const float v = ok ? s[kt][ct][r] - sl2[ct] * (float)dist : NEGF; s[kt][ct][r] = v; mloc = fmaxf(mloc, v); }
        }
        mloc = qmax(mloc);
        const float mn = fmaxf(m[ct], mloc); alpha[ct] = __builtin_amdgcn_exp2f(m[ct] - mn);
        m[ct] = mn; float ls = 0.f;
#pragma unroll
        for (int kt = 0; kt < 4; ++kt)
#pragma unroll
            for (int r = 0; r < 4; ++r) { const float v = s[kt][ct][r]; float pe = __builtin_amdgcn_exp2f(v - mn); if (!FAST) pe = v > -1.0e29f ? pe : 0.f; s[kt][ct][r] = pe; ls += pe; }
        l[ct] = l[ct] * alpha[ct] + ls;
        pf[ct][0] = cvt8(s[0][ct], s[1][ct]); pf[ct][1] = cvt8(s[2][ct], s[3][ct]);
    }
    if (__builtin_amdgcn_ballot_w64(alpha[0] != 1.0f || alpha[1] != 1.0f) != 0ull) {
#pragma unroll
        for (int ct = 0; ct < 2; ++ct)
#pragma unroll
            for (int dt = 0; dt < 4; ++dt) O[dt][ct] *= alpha[ct];
    }
    pv_block(buf, pf, O, l15, qd);
}

template <bool ACC> __device__ __forceinline__ void ot_merge(LAS unsigned char* ot, const f32x4 (&O)[4][2], const float (&sc)[2], int l15, int qd) {
    const int hs = l15 >> 3, tq8 = l15 & 7;
#pragma unroll
    for (int ct = 0; ct < 2; ++ct)
#pragma unroll
        for (int dt = 0; dt < 4; ++dt) { LAS v2u* q = (LAS v2u*)(ot + tq8 * OT_RS + ((2 * ct + hs) * 64 + 16 * dt + 4 * qd) * 2);
            f32x4 v = O[dt][ct] * sc[ct];
            if (ACC) { const v2u o = *q; v[0] += __uint_as_float(o.x << 16); v[1] += __uint_as_float(o.x & 0xffff0000u); v[2] += __uint_as_float(o.y << 16); v[3] += __uint_as_float(o.y & 0xffff0000u); }
            *q = (v2u){pk2(v[0], v[1]), pk2(v[2], v[3])}; }
}

#ifdef AT_PROBE
#define AT_T(i) do { if (blockIdx.x == 0 && threadIdx.x == 0) { const unsigned long long _n = __builtin_amdgcn_s_memrealtime(); at_acc[i] += _n - at_prev; at_prev = _n; } } while (0)
#define AT_CNT(i) do { if (blockIdx.x == 0 && threadIdx.x == 0) at_acc[i] += 1; } while (0)
#else
#define AT_T(i) do {} while (0)
#define AT_CNT(i) do {} while (0)
#endif
template <bool SAMP> __device__ __forceinline__ void attn_tile(const Params& p, LAS unsigned char* L, const TileCtx& c, const bf16* qb, const bf16* kvb, unsigned long long* at_acc) {
    unsigned long long at_prev = 0; (void)at_prev; (void)at_acc;
#ifdef AT_PROBE
    if (blockIdx.x == 0 && threadIdx.x == 0) at_prev = __builtin_amdgcn_s_memrealtime();
#endif
    const int tid = opaque_tid(), wave = __builtin_amdgcn_readfirstlane(tid >> 6), lane = tid & 63, l15 = lane & 15, qd = lane >> 4;
    const int hs = l15 >> 3, tq8 = l15 & 7;
    const bool wave_on = SAMP ? (wave == 0) : true;
    const int tq = SAMP ? tq8 : 8 * wave + tq8;
    const int t = c.t0 + tq;
    const size_t qrow = c.rowbase + tq;
    const float* gl = p.ws + W_GL; const bf16* zb = (const bf16*)(p.ws + W_ZB);
    LAS unsigned char* ot = L + L_OT + wave * OT_W;
    LAS unsigned* uni = (LAS unsigned*)(L + L_UNI);
    if (tid < 4) uni[tid] = 0u;
    bf16x8 qf[2][2]; float sl2[2];
#pragma unroll
    for (int ct = 0; ct < 2; ++ct) { const int H = c.g * 4 + 2 * ct + hs;
#pragma unroll
        for (int ks = 0; ks < 2; ++ks) qf[ct][ks] = *(const bf16x8*)(qb + qrow * 1024 + H * 64 + 32 * ks + 8 * qd);
        sl2[ct] = exp2f(-8.0f * (float)(H + 1) / (float)NH) * LOG2E; }
    auto gate = [&](int ct, int x) -> float { const int H = c.g * 4 + 2 * ct + hs; return __builtin_amdgcn_rcpf(1.0f + __expf(-(gl[qrow * (3 * NH) + H * 3 + x] + p.in[I_BGATE][H * 3 + x]))); };
    f32x4 O[4][2]; float m[2], l[2];
    LAS unsigned char* buf0 = L + L_KV; LAS unsigned char* buf1 = L + L_KV + KVB;
    { bf16x8 kr, vr; stage_load<1>(p, c, kvb, 0, 0, kr, vr, tid); stage_write(buf0, kr, vr, tid); stage_load<1>(p, c, kvb, 1, 0, kr, vr, tid); stage_write(buf1, kr, vr, tid); }
    __syncthreads();
    unsigned long long selLo = 0ull, selHi = 0ull;
#define AT_SETBIT(n) do { const int _n = (n); if (_n < 64) selLo |= 1ull << _n; else selHi |= 1ull << (_n - 64); } while (0)
    const int cb = t >> 6;
    if (wave_on) {
        const int nvalid = (t + 1) >> 6;
#pragma unroll
        for (int ct = 0; ct < 2; ++ct) { m[ct] = NEGF; l[ct] = 0.f; }
#pragma unroll
        for (int kb = 0; kb < 2; ++kb) { f32x4 s[4][2]; qk_block(kb ? buf1 : buf0, qf, s, l15, qd);
#pragma unroll
            for (int ct = 0; ct < 2; ++ct) { float mloc = NEGF;
#pragma unroll
                for (int kt = 0; kt < 4; ++kt)
#pragma unroll
                    for (int r = 0; r < 4; ++r) { const int n = 64 * kb + 16 * kt + 4 * qd + r; const bool ok = n < nvalid;
                        const float v = ok ? s[kt][ct][r] - sl2[ct] * (float)(t - (64 * n + 63)) : NEGF; s[kt][ct][r] = v; mloc = fmaxf(mloc, v); }
                mloc = qmax(mloc);
                const float mn = fmaxf(m[ct], mloc); float ls = 0.f;
#pragma unroll
                for (int kt = 0; kt < 4; ++kt)
#pragma unroll
                    for (int r = 0; r < 4; ++r) { const float v = s[kt][ct][r]; ls += v > -1.0e29f ? __builtin_amdgcn_exp2f(v - mn) : 0.f; }
                l[ct] = l[ct] * __builtin_amdgcn_exp2f(m[ct] - mn) + ls; m[ct] = mn; } }
        float rl[2];
#pragma unroll
        for (int ct = 0; ct < 2; ++ct) { const float ls = qsum(l[ct]); rl[ct] = ls > 0.f ? 1.0f / ls : 0.f; }
        float cand[4][4];
#pragma unroll
        for (int kb = 0; kb < 2; ++kb) { f32x4 s[4][2]; qk_block(kb ? buf1 : buf0, qf, s, l15, qd);
#pragma unroll
            for (int kt = 0; kt < 4; ++kt)
#pragma unroll
                for (int r = 0; r < 4; ++r) { const int n = 64 * kb + 16 * kt + 4 * qd + r; const bool ok = n < nvalid; const float dist = (float)(t - (64 * n + 63));
                    const float p0 = ok ? __builtin_amdgcn_exp2f(s[kt][0][r] - sl2[0] * dist - m[0]) * rl[0] : 0.f;
                    const float p1 = ok ? __builtin_amdgcn_exp2f(s[kt][1][r] - sl2[1] * dist - m[1]) * rl[1] : 0.f;
                    const float ps = p0 + p1, tot = ps + ror8(ps);
                    const bool excl = (n == 0) || (n == cb) || (n == cb - 1) || (n > cb);
                    if (kb == hs) cand[kt][r] = excl ? -2.f : tot; } }
        int npick;
        if (SAMP) { selLo |= 1ull; selHi |= 1ull << 63; npick = NSEL - 3; }
        else { selLo |= 1ull; AT_SETBIT(cb); if (cb >= 1) AT_SETBIT(cb - 1); npick = NSEL - (cb == 0 ? 1 : (cb == 1 ? 2 : 3)); }
        for (int it = 0; it < NSEL - 1; ++it) {
            float bv = -2.f; int bn = 1 << 20;
#pragma unroll
            for (int kt = 0; kt < 4; ++kt)
#pragma unroll
                for (int r = 0; r < 4; ++r) { const int n = 64 * hs + 16 * kt + 4 * qd + r; const float v = cand[kt][r]; if (v > bv) { bv = v; bn = n; } }
            { const float ov = ror8(bv); const int on = ror8i(bn); if (ov > bv || (ov == bv && on < bn)) { bv = ov; bn = on; } }
            { auto av = __builtin_amdgcn_permlane16_swap(__float_as_uint(bv), __float_as_uint(bv), false, false); auto an = __builtin_amdgcn_permlane16_swap((unsigned)bn, (unsigned)bn, false, false);
              const float v0 = __uint_as_float(av[0]), v1 = __uint_as_float(av[1]); const int n0 = (int)an[0], n1 = (int)an[1];
              const bool t1 = v1 > v0 || (v1 == v0 && n1 < n0); bv = t1 ? v1 : v0; bn = t1 ? n1 : n0; }
            { auto av = __builtin_amdgcn_permlane32_swap(__float_as_uint(bv), __float_as_uint(bv), false, false); auto an = __builtin_amdgcn_permlane32_swap((unsigned)bn, (unsigned)bn, false, false);
              const float v0 = __uint_as_float(av[0]), v1 = __uint_as_float(av[1]); const int n0 = (int)an[0], n1 = (int)an[1];
              const bool t1 = v1 > v0 || (v1 == v0 && n1 < n0); bv = t1 ? v1 : v0; bn = t1 ? n1 : n0; }
            const bool take = it < npick && bv >= 0.f;
            if (take) AT_SETBIT(bn & 127);
#pragma unroll
            for (int kt = 0; kt < 4; ++kt)
#pragma unroll
                for (int r = 0; r < 4; ++r) { const int n = 64 * hs + 16 * kt + 4 * qd + r; if (n == bn) cand[kt][r] = -2.f; }
        }
        if (qd == 0 && hs == 0) { __hip_atomic_fetch_or(uni + 0, (unsigned)selLo, __ATOMIC_RELAXED, __HIP_MEMORY_SCOPE_WORKGROUP); __hip_atomic_fetch_or(uni + 1, (unsigned)(selLo >> 32), __ATOMIC_RELAXED, __HIP_MEMORY_SCOPE_WORKGROUP);
            __hip_atomic_fetch_or(uni + 2, (unsigned)selHi, __ATOMIC_RELAXED, __HIP_MEMORY_SCOPE_WORKGROUP); __hip_atomic_fetch_or(uni + 3, (unsigned)(selHi >> 32), __ATOMIC_RELAXED, __HIP_MEMORY_SCOPE_WORKGROUP); }
        {
#pragma unroll
            for (int ct = 0; ct < 2; ++ct) rl[ct] *= gate(ct, 0);
#pragma unroll
            for (int dt = 0; dt < 4; ++dt)
#pragma unroll
                for (int ct = 0; ct < 2; ++ct) O[dt][ct] = (f32x4){0.f, 0.f, 0.f, 0.f};
#pragma unroll
            for (int kb = 0; kb < 2; ++kb) { f32x4 s[4][2]; qk_block(kb ? buf1 : buf0, qf, s, l15, qd); bf16x8 pf[2][2];
#pragma unroll
                for (int ct = 0; ct < 2; ++ct) {
#pragma unroll
                    for (int kt = 0; kt < 4; ++kt)
#pragma unroll
                        for (int r = 0; r < 4; ++r) { const int n = 64 * kb + 16 * kt + 4 * qd + r; const bool ok = n < nvalid;
                            s[kt][ct][r] = ok ? __builtin_amdgcn_exp2f(s[kt][ct][r] - sl2[ct] * (float)(t - (64 * n + 63)) - m[ct]) * rl[ct] : 0.f; }
                    pf[ct][0] = cvt8(s[0][ct], s[1][ct]); pf[ct][1] = cvt8(s[2][ct], s[3][ct]); }
                pv_block(kb ? buf1 : buf0, pf, O, l15, qd); }
            const float one[2] = {1.f, 1.f}; ot_merge<false>(ot, O, one, l15, qd);
        }
    }
    __syncthreads();
    AT_T(SAMP ? 4 : 0);
    const unsigned long long unLo = ((unsigned long long)__builtin_amdgcn_readfirstlane(uni[1]) << 32) | (unsigned)__builtin_amdgcn_readfirstlane(uni[0]);
    const unsigned long long unHi = ((unsigned long long)__builtin_amdgcn_readfirstlane(uni[3]) << 32) | (unsigned)__builtin_amdgcn_readfirstlane(uni[2]);
#pragma unroll
    for (int ct = 0; ct < 2; ++ct) { m[ct] = NEGF; l[ct] = 0.f; }
#pragma unroll
    for (int dt = 0; dt < 4; ++dt)
#pragma unroll
        for (int ct = 0; ct < 2; ++ct) O[dt][ct] = (f32x4){0.f, 0.f, 0.f, 0.f};
    {
        auto prev_bit = [&](int from) -> int {
            if (from >= 64) { const unsigned long long y = from >= 127 ? unHi : unHi & ((2ull << (from - 64)) - 1ull); if (y) return 127 - __builtin_clzll(y); from = 63; }
            if (from < 0) return -1;
            const unsigned long long x = from >= 63 ? unLo : unLo & ((2ull << from) - 1ull);
            return x ? 63 - __builtin_clzll(x) : -1; };
        auto nextb = [&](int cur) -> int { return cur <= 0 ? -1 : prev_bit(cur > 128 ? 127 : cur - 1); };
        int b0 = SAMP ? 128 : prev_bit(127), b1 = nextb(b0), b2 = nextb(b1), pb = 0;
        bf16x8 krA, vrA, krB, vrB;
        if (b0 >= 0) { stage_load<SAMP ? 2 : 0>(p, c, kvb, b0, KVG, krA, vrA, tid); stage_write(buf0, krA, vrA, tid); }
        if (b1 >= 0) stage_load<SAMP ? 2 : 0>(p, c, kvb, b1, KVG, krA, vrA, tid);
        __syncthreads();
        const int cbt = c.t0 >> 6;
        auto sel_compute = [&](int blk, LAS unsigned char* buf) {
            if (wave_on) {
                const bool bit = blk >= 128 ? true : (((blk < 64 ? selLo >> blk : selHi >> (blk - 64)) & 1ull) != 0ull);
                if (__builtin_amdgcn_ballot_w64(bit) != 0ull) {
                    if (blk < cbt) online_step<1, true>(buf, qf, O, m, l, sl2, t, blk * 64, bit, l15, qd);
                    else online_step<1, false>(buf, qf, O, m, l, sl2, t, blk * 64, bit, l15, qd); }
            } };
        while (b0 >= 0) {
            if (b2 >= 0) stage_load<SAMP ? 2 : 0>(p, c, kvb, b2, KVG, krB, vrB, tid);
            sel_compute(b0, pb ? buf1 : buf0); AT_CNT(SAMP ? 9 : 8);
            if (b1 >= 0) stage_write(pb ? buf0 : buf1, krA, vrA, tid);
            __syncthreads();
            pb ^= 1; b0 = b1; b1 = b2; b2 = nextb(b2);
            if (b0 < 0) break;
            if (b2 >= 0) stage_load<SAMP ? 2 : 0>(p, c, kvb, b2, KVG, krA, vrA, tid);
            sel_compute(b0, pb ? buf1 : buf0); AT_CNT(SAMP ? 9 : 8);
            if (b1 >= 0) stage_write(pb ? buf0 : buf1, krB, vrB, tid);
            __syncthreads();
            pb ^= 1; b0 = b1; b1 = b2; b2 = nextb(b2);
        }
    }
    if (wave_on) { float sc[2];
#pragma unroll
        for (int ct = 0; ct < 2; ++ct) { const float ls = qsum(l[ct]); sc[ct] = ls > 0.f ? gate(ct, 1) / ls : 0.f; }
        ot_merge<true>(ot, O, sc, l15, qd); }
    AT_T(SAMP ? 5 : 1);
#pragma unroll
    for (int ct = 0; ct < 2; ++ct) { m[ct] = NEGF; l[ct] = 0.f; }
#pragma unroll
    for (int dt = 0; dt < 4; ++dt)
#pragma unroll
        for (int ct = 0; ct < 2; ++ct) O[dt][ct] = (f32x4){0.f, 0.f, 0.f, 0.f};
    {
        const int kb0 = SAMP ? 0 : (c.t0 >= WIN ? (c.t0 - WIN) >> 6 : 0), kb1 = SAMP ? (WIN + DSEQ - 1) >> 6 : (c.t0 + TQ - 1) >> 6;
        const int wpos0 = SAMP ? PAST - WIN : 0;
        bf16x8 krA, vrA, krB, vrB; int pb = 0;
        stage_load<SAMP ? 3 : 0>(p, c, kvb, kb1, 2 * KVG, krA, vrA, tid); stage_write(buf0, krA, vrA, tid);
        if (kb1 - 1 >= kb0) stage_load<SAMP ? 3 : 0>(p, c, kvb, kb1 - 1, 2 * KVG, krA, vrA, tid);
        __syncthreads();
        auto win_compute = [&](int kb, LAS unsigned char* buf) {
            if (wave_on) {
                const int pos0 = wpos0 + kb * 64;
                const int tlo = c.t0 + (SAMP ? 0 : 8 * wave), thi = tlo + 7;
                if (pos0 <= thi && pos0 + 63 >= tlo - WIN) {
                    if (pos0 + 63 <= tlo && pos0 >= thi - WIN) online_step<2, true>(buf, qf, O, m, l, sl2, t, pos0, true, l15, qd);
                    else online_step<2, false>(buf, qf, O, m, l, sl2, t, pos0, true, l15, qd); }
            } };
        for (int kb = kb1; kb >= kb0; kb -= 2) {
            if (kb - 2 >= kb0) stage_load<SAMP ? 3 : 0>(p, c, kvb, kb - 2, 2 * KVG, krB, vrB, tid);
            win_compute(kb, pb ? buf1 : buf0);
            if (kb - 1 >= kb0) stage_write(pb ? buf0 : buf1, krA, vrA, tid);
            __syncthreads();
            pb ^= 1;
            if (kb - 1 < kb0) break;
            if (kb - 3 >= kb0) stage_load<SAMP ? 3 : 0>(p, c, kvb, kb - 3, 2 * KVG, krA, vrA, tid);
            win_compute(kb - 1, pb ? buf1 : buf0);
            if (kb - 2 >= kb0) stage_write(pb ? buf0 : buf1, krB, vrB, tid);
            __syncthreads();
            pb ^= 1;
        }
    }
    AT_T(SAMP ? 6 : 2);
    if (wave_on) { float sc[2];
#pragma unroll
        for (int ct = 0; ct < 2; ++ct) { const float ls = qsum(l[ct]); sc[ct] = ls > 0.f ? gate(ct, 2) / ls : 0.f; }
        ot_merge<true>(ot, O, sc, l15, qd);
        asm volatile("s_waitcnt lgkmcnt(0)" ::: "memory");
        bf16* oA = (bf16*)(p.ws + W_BFA);
#pragma unroll
        for (int i = 0; i < 4; ++i) { const int it = lane + 64 * i; const int rr = it >> 5, ch = it & 31;
            const v4u ov = *(const LAS v4u*)(ot + rr * OT_RS + ch * 16);
            const size_t grow = c.rowbase + (SAMP ? rr : 8 * wave + rr); const int col = c.g * 256 + ch * 8;
            const v4u zv = *(const v4u*)(zb + grow * D + col);
            float o[8] = {__uint_as_float(ov.x << 16), __uint_as_float(ov.x & 0xffff0000u), __uint_as_float(ov.y << 16), __uint_as_float(ov.y & 0xffff0000u),
                          __uint_as_float(ov.z << 16), __uint_as_float(ov.z & 0xffff0000u), __uint_as_float(ov.w << 16), __uint_as_float(ov.w & 0xffff0000u)};
            const float zz[8] = {__uint_as_float(zv.x << 16), __uint_as_float(zv.x & 0xffff0000u), __uint_as_float(zv.y << 16), __uint_as_float(zv.y & 0xffff0000u),
                                 __uint_as_float(zv.z << 16), __uint_as_float(zv.z & 0xffff0000u), __uint_as_float(zv.w << 16), __uint_as_float(zv.w & 0xffff0000u)};
#pragma unroll
            for (int e = 0; e < 8; ++e) o[e] *= zz[e] * __builtin_amdgcn_rcpf(1.0f + __expf(-zz[e]));
            v4u w; w.x = pk2(o[0], o[1]); w.y = pk2(o[2], o[3]); w.z = pk2(o[4], o[5]); w.w = pk2(o[6], o[7]);
            *(GAS v4u*)(oA + grow * 1024 + col) = w; }
    }
    __syncthreads();
    AT_T(SAMP ? 7 : 3);
#undef AT_SETBIT
}

__device__ __forceinline__ void attn_phase(const Params& p, LAS unsigned char* L, const bf16* qb, const bf16* kvb, unsigned* queue, unsigned long long* at_acc = nullptr) {
    LAS int* slot = (LAS int*)(L + L_UNI + 32);
    constexpr int NQB = SEQ / TQ, PER_G = BATCH * NQB;
    for (;;) {
        if (threadIdx.x == 0) *slot = (int)__hip_atomic_fetch_add(queue, 1u, __ATOMIC_RELAXED, __HIP_MEMORY_SCOPE_AGENT);
        __syncthreads();
        const int i = __builtin_amdgcn_readfirstlane(*slot);
        __syncthreads();
        if (i >= NT_P + NT_S) break;
        TileCtx c;
        int j = i; bool samp = false; int g = 0;
        if (j < PER_G) g = NKV - 1; else { j -= PER_G; if (j < NT_S) samp = true; else { j -= NT_S; g = NKV - 2 - j / PER_G; j %= PER_G; } }
        if (samp) { c.b = j / NKV; c.g = j % NKV; c.t0 = PAST; c.rowbase = (size_t)MP + (size_t)c.b * DSEQ; c.sn0 = (size_t)BATCH * NCP + (size_t)c.b * NCS;
            attn_tile<true>(p, L, c, qb, kvb, at_acc); AT_CNT(11); }
        else { const int qblk = NQB - 1 - j / BATCH; c.b = j % BATCH; c.g = g; c.t0 = qblk * TQ; c.rowbase = (size_t)c.b * SEQ + c.t0; c.sn0 = (size_t)c.b * NCP;
            attn_tile<false>(p, L, c, qb, kvb, at_acc); AT_CNT(10); }
    }
}
}

namespace cp {
using namespace nv;
typedef short bf16x8 __attribute__((ext_vector_type(8)));
constexpr int AS = 144, HS = 272;
constexpr int L_A = 0, A_BUF = 2 * 64 * AS, L_H = 2 * A_BUF, L_END = L_H + 2 * 64 * HS;
static_assert(L_END <= 131072 && NCS * CMPB <= PAST, "compress geometry");

template <int NB>
__device__ __forceinline__ void comp_unit(const Params& p, LAS unsigned char* L, int sn_first, const bf16* w1t, const bf16* w2t, const float* bias1, int tid) {
    constexpr int RT = NB / 4, TPB = 512 / NB, NV4 = NB / 4;
    const int wave = __builtin_amdgcn_readfirstlane(tid >> 6), lane = tid & 63, l15 = lane & 15, qd = lane >> 4;
    const int c = wave >> 2, pq = wave & 3;
    const int blk = tid / TPB, ck = tid % TPB, eo = ck * NB;
    const int sg = eo >> 7, sc = (eo >> 6) & 1, sd0 = eo & 63;
    const float* src; size_t tstride;
    { const int sn = sn_first + blk;
      if (sn < BATCH * NCP) { const int b = sn / NCP, n = sn % NCP; src = p.out + O_CMPP + ((size_t)b * SEQ + (size_t)n * CMPB) * KVG + eo; tstride = KVG; }
      else { const int r = sn - BATCH * NCP, bs = r / NCS, n = r % NCS, pos0 = n * CMPB; const int pg = ((const int*)p.in[I_PT])[bs * NPAGES + (pos0 >> 7)];
             src = p.in[I_CCMP] + ((size_t)pg * PAGE + (pos0 & 127)) * KVG + eo; tstride = KVG; } }
    const unsigned dstoff = (unsigned)((sc * 64 + blk * 4 + sg) * AS + sd0 * 2);
    f32x4 ra[NV4], rb[NV4];
    auto ld = [&](f32x4 (&r)[NV4], int l) {
#pragma unroll
        for (int i = 0; i < NV4; ++i) r[i] = *(const f32x4*)(src + (size_t)l * tstride + 4 * i); };
    auto st = [&](const f32x4 (&r)[NV4], int buf) {
        LAS unsigned char* d = L + L_A + buf * A_BUF + dstoff;
        if constexpr (NB == 16) { *(LAS bf16x8*)d = at::cvt8(r[0], r[1]); *(LAS bf16x8*)(d + 16) = at::cvt8(r[2], r[3]); }
        else { *(LAS at::v2u*)d = (at::v2u){pk2(r[0][0], r[0][1]), pk2(r[0][2], r[0][3])}; } };
    const bf16* wb = w1t + (((size_t)c * 64) * 128 + 32 * pq + l15) * 64 + 8 * qd;
    auto ldb = [&](bf16x8 (&b)[2][2], int l) {
#pragma unroll
        for (int ct = 0; ct < 2; ++ct)
#pragma unroll
            for (int ks = 0; ks < 2; ++ks) b[ct][ks] = *(const bf16x8*)(wb + ((size_t)l * 128 + 16 * ct) * 64 + 32 * ks); };
    f32x4 acc[RT][2];
#pragma unroll
    for (int rt = 0; rt < RT; ++rt)
#pragma unroll
        for (int ct = 0; ct < 2; ++ct) acc[rt][ct] = (f32x4){0.f, 0.f, 0.f, 0.f};
    auto compute = [&](int buf, const bf16x8 (&b)[2][2]) {
        const LAS unsigned char* a0 = L + L_A + buf * A_BUF + (c * 64 + l15) * AS + 16 * qd;
#pragma unroll
        for (int ks = 0; ks < 2; ++ks)
#pragma unroll
            for (int rt = 0; rt < RT; ++rt) { const bf16x8 a = *(const LAS bf16x8*)(a0 + 16 * rt * AS + 64 * ks);
#pragma unroll
                for (int ct = 0; ct < 2; ++ct) acc[rt][ct] = __builtin_amdgcn_mfma_f32_16x16x32_bf16(a, b[ct][ks], acc[rt][ct], 0, 0, 0); } };
    bf16x8 b0[2][2], b1[2][2];
    ld(ra, 0); ld(rb, 1); ldb(b0, 0);
    st(ra, 0);
    __syncthreads();
    for (int l = 0; l < CMPB; l += 2) {
        if (l + 2 < CMPB) ld(ra, l + 2);
        ldb(b1, l + 1);
        compute(0, b0);
        st(rb, 1);
        __syncthreads();
        if (l + 3 < CMPB) ld(rb, l + 3);
        if (l + 2 < CMPB) ldb(b0, l + 2);
        compute(1, b1);
        if (l + 2 < CMPB) st(ra, 0);
        __syncthreads();
    }
    {
        LAS unsigned short* H = (LAS unsigned short*)(L + L_H);
#pragma unroll
        for (int ct = 0; ct < 2; ++ct) { const int pp = 32 * pq + 16 * ct + l15; const float bz = bias1[c * DPHI + pp];
#pragma unroll
            for (int rt = 0; rt < RT; ++rt)
#pragma unroll
                for (int r = 0; r < 4; ++r) { const float x = acc[rt][ct][r] + bz; const float hv = x / (1.0f + __expf(-x));
                    H[((c * 64 + 16 * rt + 4 * qd + r) * HS) / 2 + pp] = (unsigned short)f2bf(hv); } }
    }
    __syncthreads();
    {
        f32x4 o2[RT];
#pragma unroll
        for (int rt = 0; rt < RT; ++rt) o2[rt] = (f32x4){0.f, 0.f, 0.f, 0.f};
        const bf16* w2 = w2t + ((size_t)(c * 64 + 16 * pq + l15)) * 128 + 8 * qd;
#pragma unroll
        for (int ks = 0; ks < 4; ++ks) { const bf16x8 b = *(const bf16x8*)(w2 + 32 * ks);
#pragma unroll
            for (int rt = 0; rt < RT; ++rt) { const bf16x8 a = *(const LAS bf16x8*)(L + L_H + (c * 64 + 16 * rt + l15) * HS + (32 * ks + 8 * qd) * 2);
                o2[rt] = __builtin_amdgcn_mfma_f32_16x16x32_bf16(a, b, o2[rt], 0, 0, 0); } }
        const int dd = 16 * pq + l15; const float b2 = p.in[I_BPHI2][c * HD + dd];
        float* comp = p.ws + W_COMP;
#pragma unroll
        for (int rt = 0; rt < RT; ++rt)
#pragma unroll
            for (int r = 0; r < 4; ++r) { const int row = 16 * rt + 4 * qd + r; const int sn = sn_first + (row >> 2), g = row & 3;
                comp[((size_t)sn * NKV + g) * 128 + c * HD + dd] = o2[rt][r] + b2; }
    }
    __syncthreads();
}

__device__ __forceinline__ void comp_bias(const Params& p, float* bias1, int gw, int ngw, int lane) {
    for (int o = gw; o < 2 * DPHI; o += ngw) { const int c = o / DPHI, pp = o % DPHI; float s = 0.f;
        for (int i = lane; i < CMPB * HD; i += 64) { const int l = i >> 6, d = i & 63; s += p.in[I_PE][((size_t)l * 2 + c) * HD + d] * p.in[I_WPHI1][(((size_t)c * CMPB + l) * HD + d) * DPHI + pp]; }
#pragma unroll
        for (int sh = 1; sh < 64; sh <<= 1) s += __shfl_xor(s, sh);
        if (lane == 0) bias1[o] = s + p.in[I_BPHI1][o]; }
}
}

namespace ms {
using namespace nv;
__device__ __forceinline__ float wave_sum(float v) {
#pragma unroll
    for (int o = 1; o < 64; o <<= 1) v += __shfl_xor(v, o);
    return v;
}
constexpr int ADA_TILES = 2 * (3 * D / 64);
__device__ __forceinline__ void ada_phase(const Params& p, LAS unsigned char* L, int tid) {
    const int wave = __builtin_amdgcn_readfirstlane(tid >> 6), lane = tid & 63;
    LAS float* sc = (LAS float*)L;
    LAS float* red = (LAS float*)(L + 17 * 1024 * 4);
    static_assert(NC <= 34, "ada tile assumes at most 34 condition rows");
    float* mod = p.ws + W_MOD;
    for (int tile = blockIdx.x; tile < ADA_TILES; tile += gridDim.x) {
        const int layer = tile / (3 * D / 64), n = (tile % (3 * D / 64)) * 64 + lane;
        const float* w = p.in[I_WADA] + (size_t)layer * D * 3 * D + n;
        for (int half = 0; half < 2; ++half) {
            const int r0 = half * 17, nr = NC - r0 < 17 ? NC - r0 : 17;
            __syncthreads();
            for (int i = tid; i < nr * 1024; i += 512) { const int r = r0 + (i >> 10), k = i & 1023;
                const float cv = r < BATCH ? p.in[I_CP][(size_t)r * D + k] : p.in[I_CS][(size_t)(r - BATCH) * D + k]; sc[i] = cv / (1.0f + __expf(-cv)); }
            __syncthreads();
            float acc[17];
#pragma unroll
            for (int r = 0; r < 17; ++r) acc[r] = 0.f;
            for (int kk = 0; kk < 128; kk += 16) { float wv[16];
#pragma unroll
                for (int j = 0; j < 16; ++j) wv[j] = w[(size_t)(wave * 128 + kk + j) * 3 * D];
#pragma unroll
                for (int j = 0; j < 16; ++j)
#pragma unroll
                    for (int r = 0; r < 17; ++r) acc[r] += sc[r * 1024 + wave * 128 + kk + j] * wv[j]; }
#pragma unroll
            for (int r = 0; r < 17; ++r) red[(wave * 17 + r) * 64 + lane] = acc[r];
            __syncthreads();
            for (int i = tid; i < nr * 64; i += 512) { const int r = i >> 6, c = i & 63; float s = 0.f;
#pragma unroll
                for (int wv = 0; wv < 8; ++wv) s += red[(wv * 17 + r) * 64 + c];
                const int nn = (tile % (3 * D / 64)) * 64 + c;
                mod[((size_t)layer * NC + r0 + r) * 3 * D + nn] = s + p.in[I_BADA][layer * 3 * D + nn]; }
        }
    }
    __syncthreads();
}
__device__ __forceinline__ void mod0_phase(const Params& p, long gtid, long gsz) {
    const float* mod = p.ws + W_MOD; bf16* mA = (bf16*)(p.ws + W_BFA);
    for (long it = gtid; it < (long)M * 128; it += gsz) { const long row = it >> 7; const int c8 = (int)(it & 127) * 8; const int ci = cond_of((int)row);
        const float* x = row < MP ? p.in[I_XP] + row * D + c8 : p.in[I_XS] + (row - MP) * D + c8;
        const float* sh = mod + (size_t)ci * 3 * D + c8; const float* scl = sh + D;
        const f32x4 x0 = *(const f32x4*)x, x1 = *(const f32x4*)(x + 4), s0 = *(const f32x4*)scl, s1 = *(const f32x4*)(scl + 4), h0 = *(const f32x4*)sh, h1 = *(const f32x4*)(sh + 4);
        *(GAS v4u*)(mA + row * 1024 + c8) = __builtin_bit_cast(v4u, at::cvt8(x0 * (1.0f + s0) + h0, x1 * (1.0f + s1) + h1)); }
}
template <int LAYER> __device__ __forceinline__ void ln_phase(const Params& p, int tid) {
    const int wave = __builtin_amdgcn_readfirstlane(tid >> 6), lane = tid & 63;
    const float* f = p.ws + W_F; const float* lg = p.in[I_LNG] + LAYER * D; const float* lb = p.in[I_LNB] + LAYER * D;
    for (int row = blockIdx.x * 8 + wave; row < M; row += gridDim.x * 8) {
        const int ci = cond_of(row);
        const float* x = LAYER == 0 ? (row < MP ? p.in[I_XP] + (size_t)row * D : p.in[I_XS] + (size_t)(row - MP) * D) : p.ws + W_X1 + (size_t)row * D;
        const float* gt = p.ws + W_MOD + ((size_t)LAYER * NC + ci) * 3 * D + 2 * D;
        f32x4 v[4]; float s = 0.f;
#pragma unroll
        for (int j = 0; j < 4; ++j) { const int o = 4 * lane + 256 * j; const f32x4 xv = *(const f32x4*)(x + o), fv = *(const f32x4*)(f + (size_t)row * D + o), gv = *(const f32x4*)(gt + o);
            v[j] = ALPHA * xv + (1.0f + gv) * fv; s += (v[j][0] + v[j][1]) + (v[j][2] + v[j][3]); }
        const float mu = wave_sum(s) * (1.0f / D); float s2 = 0.f;
#pragma unroll
        for (int j = 0; j < 4; ++j) { v[j] = v[j] - mu; s2 += (v[j][0] * v[j][0] + v[j][1] * v[j][1]) + (v[j][2] * v[j][2] + v[j][3] * v[j][3]); }
        const float rstd = 1.0f / sqrtf(wave_sum(s2) * (1.0f / D) + LN_EPS);
#pragma unroll
        for (int j = 0; j < 4; ++j) { const int o = 4 * lane + 256 * j; const f32x4 y = v[j] * rstd * *(const f32x4*)(lg + o) + *(const f32x4*)(lb + o);
            if (LAYER == 0) {
                *(f32x4*)(p.ws + W_X1 + (size_t)row * D + o) = y;
                const float* sh = p.ws + W_MOD + ((size_t)NC + ci) * 3 * D + o; const f32x4 m1 = y * (1.0f + *(const f32x4*)(sh + D)) + *(const f32x4*)sh;
                *(GAS at::v2u*)((bf16*)(p.ws + W_BFB) + (size_t)row * D + o) = (at::v2u){pk2(y[0], y[1]), pk2(y[2], y[3])};
                *(GAS at::v2u*)((bf16*)(p.ws + W_BFA) + (size_t)row * D + o) = (at::v2u){pk2(m1[0], m1[1]), pk2(m1[2], m1[3])};
            } else {
                float* dst = row < MP ? p.out + O_YP + (size_t)row * D + o : p.out + O_YS + (size_t)(row - MP) * D + o;
                *(f32x4*)dst = y;
            } }
    }
}
__device__ __forceinline__ void copy_win_state(const Params& p, long gtid, long gsz) {
    for (long it = gtid; it < (long)DECB * (WIN - DSEQ) * KVG / 4; it += gsz) { const long e = it * 4; const long bs = e / ((long)(WIN - DSEQ) * KVG), r = e % ((long)(WIN - DSEQ) * KVG);
        *(f32x4*)(p.out + O_WINS + bs * WIN * KVG + r) = *(const f32x4*)(p.in[I_SWIN] + bs * WIN * KVG + (long)DSEQ * KVG + r); }
}
__device__ __forceinline__ void copy_conv_state(const Params& p, long gtid, long gsz) {
    const float* u0 = p.ws + W_U0;
    for (long it = gtid; it < (long)NC * 3 * D; it += gsz) { const int d = (int)(it % D); const int j = (int)((it / D) % 3); const int sq = (int)(it / (3 * D));
        if (sq < BATCH) p.out[O_CONVP + it] = u0[((size_t)sq * SEQ + SEQ - 3 + j) * 2 * D + d];
        else p.out[O_CONVS + (it - (long)BATCH * 3 * D)] = u0[((size_t)MP + (size_t)(sq - BATCH) * DSEQ + DSEQ - 3 + j) * 2 * D + d]; }
}
}

constexpr int NTHREADS = 512, NWAVES = 8;
constexpr int LDS_BYTES = 147456;
constexpr int RING_OFF = 0;
constexpr int MISC_OFF = 131072 + 320;
constexpr int NKVIN = 3840;
constexpr long W_WT_INA = nv::W_END2, W_WT_OUTA = W_WT_INA + 2048L * 1024 / 2, W_WT_KVIN = W_WT_OUTA + 1024L * 1024 / 2,
    W_WT_OUTB = W_WT_KVIN + (long)NKVIN * 1024 / 2, W_AGG = W_WT_OUTB + 1024L * 1024 / 2, W_W1T = W_AGG + 2L * nv::BATCH * (nv::SEQ / 128) * 1024, W_W2T = W_W1T + 2L * 64 * 128 * 64 / 2,
    W_B1 = W_W2T + 2L * 64 * 128 / 2, W_FAST_END = W_B1 + 256;
constexpr size_t CTL_BYTES = 1u << 20;
constexpr size_t WS_CTL_OFF = ((size_t)W_FAST_END * 4 + 4095) / 4096 * 4096;
constexpr int CW_BAR = 4096, CW_QUEUE = 1024;
struct Args { nv::Params p; unsigned char* ctl; };
static_assert(nv::D == 1024 && nv::M % 256 == 0, "fast GEMM path is built for d_model 1024 and M % 256 == 0");

__device__ __forceinline__ void p0_prologue(const nv::Params& p, LAS unsigned char* L, int wave, int lane) {
    LAS float* scr = (LAS float*)(L + RING_OFF + wave * 16384);
    const int gw = blockIdx.x * NWAVES + wave, NGW = gridDim.x * NWAVES;
    bf16* wt_ina = (bf16*)(p.ws + W_WT_INA); bf16* wt_outa = (bf16*)(p.ws + W_WT_OUTA); bf16* wt_kvin = (bf16*)(p.ws + W_WT_KVIN); bf16* wt_outb = (bf16*)(p.ws + W_WT_OUTB);
    constexpr int I_A = 16 * (2048 / 32), I_B = 16 * (1024 / 32), I_C = 16 * (1536 / 32), I_D = 16 * ((nv::NU + 31) / 32), I_E = 16 * (1024 / 32), I_F = 2 * 64 * 4, I_G = 2 * 4;
    bf16* w1t = (bf16*)(p.ws + W_W1T); bf16* w2t = (bf16*)(p.ws + W_W2T);
    for (int it = gw; it < I_A + I_B + I_C + I_D + I_E + I_F + I_G; it += NGW) {
        int r = it;
        if (r < I_A) { wt_transpose_item(p.in[nv::I_WINA], 1024, 2048, wt_ina, 0, scr, r, lane); continue; } r -= I_A;
        if (r < I_B) { wt_transpose_item(p.in[nv::I_WOUTA], 1024, 1024, wt_outa, 0, scr, r, lane); continue; } r -= I_B;
        if (r < I_C) { wt_transpose_item(p.in[nv::I_WKV], 1024, 1536, wt_kvin, 0, scr, r, lane); continue; } r -= I_C;
        if (r < I_D) { wt_transpose_item(p.in[nv::I_WINB], 1024, nv::NU, wt_kvin, 1536, scr, r, lane); continue; } r -= I_D;
        if (r < I_E) { wt_transpose_item(p.in[nv::I_WOUTB], 1024, 1024, wt_outb, 0, scr, r, lane); continue; } r -= I_E;
        if (r < I_F) { const int cl = r >> 2; wt_transpose_item(p.in[nv::I_WPHI1] + (size_t)cl * 64 * 128, 64, 128, w1t + (size_t)cl * 128 * 64, 0, scr, r & 3, lane); continue; } r -= I_F;
        { const int c = r >> 2; wt_transpose_item(p.in[nv::I_WPHI2] + (size_t)c * 128 * 64, 128, 64, w2t + (size_t)c * 64 * 128, 0, scr, r & 3, lane); }
    }
    cp::comp_bias(p, p.ws + W_B1, gw, NGW, lane);
    constexpr int ZR0 = 1536 + ((nv::NU + 31) / 32) * 32;
    for (long i = (long)blockIdx.x * NTHREADS + opaque_tid(); i < (long)(NKVIN - ZR0) * 1024 / 8; i += (long)gridDim.x * NTHREADS)
        ((GAS v4u*)(wt_kvin + (size_t)ZR0 * 1024))[i] = (v4u){0u, 0u, 0u, 0u};
}

__global__ void __launch_bounds__(NTHREADS, 2) mk_fwd(Args args) {
    extern __shared__ __attribute__((aligned(16))) unsigned char lds[];
    LAS unsigned char* L = (LAS unsigned char*)lds;
    volatile LAS unsigned* MISC = (volatile LAS unsigned*)(L + MISC_OFF);
    for (int u = threadIdx.x; u < 32; u += NTHREADS) MISC[u] = 0u;
    __syncthreads();
    XcdBarrier bar = xcd_barrier_post((unsigned*)(args.ctl) + CW_BAR, MISC + 8);
    const long gsz = (long)gridDim.x * NTHREADS;
    const nv::Params& p = args.p;
    const int G = gridDim.x;
#define NAIVE(k) nv::run_phase<k>(p, (long)blockIdx.x * NTHREADS + opaque_tid(), gsz)
#define BAR() xcd_barrier(bar)
    { const int t_ = opaque_tid(); p0_prologue(p, L, __builtin_amdgcn_readfirstlane(t_ >> 6), t_ & 63); } ms::ada_phase(p, L, opaque_tid()); ms::copy_win_state(p, (long)blockIdx.x * NTHREADS + opaque_tid(), gsz); BAR();
    ms::mod0_phase(p, (long)blockIdx.x * NTHREADS + opaque_tid(), gsz);
    { const int t_ = opaque_tid();
      for (int uu = blockIdx.x; uu < nv::DECB * nv::NCS / 16; uu += G) cp::comp_unit<16>(p, L, nv::BATCH * nv::NCP + uu * 16, (const bf16*)(p.ws + W_W1T), (const bf16*)(p.ws + W_W2T), p.ws + W_B1, t_); }
    BAR();
    {
        pg8::Gemm g{(const pg8::bf16_t*)(p.ws + nv::W_BFA), (const pg8::bf16_t*)(p.ws + W_WT_INA), nv::M, 2048, 1024, (const pg8::bf16_t*)(p.ws + nv::W_BFA), 1 << 30};
        pg8::StaticOrder S; S.init(nv::M, 2048, G, (int)blockIdx.x);
        pg8::EpiF32Split E{p.ws + nv::W_U0, 2048, 2048, nullptr, 0, 0};
        pg8::gemm_phase<pg8::EpiF32Split, pg8::StaticOrder, true, true>(L + RING_OFF, g, S, E);
    }
    BAR();
    rg::rg_pass<1>(p, L, p.ws + W_AGG); ms::copy_conv_state(p, (long)blockIdx.x * NTHREADS + opaque_tid(), gsz); BAR();
    rg::rg_pass<2>(p, L, p.ws + W_AGG); BAR();
    {
        pg8::Gemm g{(const pg8::bf16_t*)(p.ws + nv::W_BFA), (const pg8::bf16_t*)(p.ws + W_WT_OUTA), nv::M, 1024, 1024, (const pg8::bf16_t*)(p.ws + nv::W_BFA), 1 << 30};
        pg8::StaticOrder S; S.init(nv::M, 1024, G, (int)blockIdx.x);
        pg8::EpiF32Split E{p.ws + nv::W_F, 1024, 1024, nullptr, 0, 0};
        pg8::gemm_phase<pg8::EpiF32Split, pg8::StaticOrder, true, true>(L + RING_OFF, g, S, E);
    }
    BAR();
    ms::ln_phase<0>(p, opaque_tid()); BAR();
    {
        pg8::Gemm g{(const pg8::bf16_t*)(p.ws + nv::W_BFB), (const pg8::bf16_t*)(p.ws + W_WT_KVIN), nv::M, NKVIN, 1024, (const pg8::bf16_t*)(p.ws + nv::W_BFA), 6};
        pg8::StaticOrder S; S.init(nv::M, NKVIN, G, (int)blockIdx.x);
        pg8::EpiKvU E{p.out, (pg8::bf16_t*)(p.ws + nv::W_PC), (pg8::bf16_t*)(p.ws + at::W_QB), (pg8::bf16_t*)(p.ws + at::W_ZB), p.ws + at::W_GL};
        pg8::gemm_phase<pg8::EpiKvU, pg8::StaticOrder, true, true>(L + RING_OFF, g, S, E);
    }
    BAR();
    { const int t_ = opaque_tid();
      for (int uu = blockIdx.x; uu < nv::BATCH * nv::NCP / 4; uu += G) cp::comp_unit<4>(p, L, uu * 4, (const bf16*)(p.ws + W_W1T), (const bf16*)(p.ws + W_W2T), p.ws + W_B1, t_); }
    BAR();
    at::attn_phase(p, L, (const bf16*)(p.ws + at::W_QB), (const bf16*)(p.ws + nv::W_PC), (unsigned*)(args.ctl) + CW_QUEUE); BAR();
    {
        pg8::Gemm g{(const pg8::bf16_t*)(p.ws + nv::W_BFA), (const pg8::bf16_t*)(p.ws + W_WT_OUTB), nv::M, 1024, 1024, (const pg8::bf16_t*)(p.ws + nv::W_BFA), 1 << 30};
        pg8::StaticOrder S; S.init(nv::M, 1024, G, (int)blockIdx.x);
        pg8::EpiF32Split E{p.ws + nv::W_F, 1024, 1024, nullptr, 0, 0};
        pg8::gemm_phase<pg8::EpiF32Split, pg8::StaticOrder, true, true>(L + RING_OFF, g, S, E);
    }
    BAR();
    ms::ln_phase<1>(p, opaque_tid());
#undef NAIVE
#undef BAR
}

extern "C" void kernel_launch(void* const* d_in, const int* in_sizes, int n_in,
                              void* d_out, int out_size, void* d_ws, size_t ws_size,
                              hipStream_t stream) {
    static int grid = 0;
    if (grid == 0) {
        if (n_in != nv::I_N || out_size != (int)nv::O_END || ws_size < WS_CTL_OFF + CTL_BYTES) { fprintf(stderr, "kernel_launch: unexpected sizes n_in %d out %d ws %zu\n", n_in, out_size, ws_size); grid = -1; return; }
        int dev = 0, cus = 0, per_cu = 0;
        if (hipGetDevice(&dev) != hipSuccess || hipDeviceGetAttribute(&cus, hipDeviceAttributeMultiprocessorCount, dev) != hipSuccess) { grid = -1; return; }
        if (hipFuncSetAttribute((const void*)mk_fwd, hipFuncAttributeMaxDynamicSharedMemorySize, LDS_BYTES) != hipSuccess) { fprintf(stderr, "kernel_launch: hipFuncSetAttribute failed\n"); grid = -1; return; }
        if (hipOccupancyMaxActiveBlocksPerMultiprocessor(&per_cu, (const void*)mk_fwd, NTHREADS, LDS_BYTES) != hipSuccess || per_cu < 1) fprintf(stderr, "kernel_launch: occupancy query reports %d\n", per_cu);
        (void)hipGetLastError();
        grid = cus;
    }
    if (grid < 0) return;
    unsigned char* ctl = (unsigned char*)d_ws + WS_CTL_OFF;
    if (hipMemsetAsync(ctl, 0, CTL_BYTES, stream) != hipSuccess) return;
    Args a{};
    for (int i = 0; i < nv::I_N; ++i) a.p.in[i] = (const float*)d_in[i];
    a.p.out = (float*)d_out; a.p.ws = (float*)d_ws; a.ctl = ctl;
    hipLaunchKernelGGL(mk_fwd, dim3(grid), dim3(NTHREADS), LDS_BYTES, stream, a);
}
```
